# Optimizing an MI355X kernel written in HIP

```python
import math, functools
import jax, jax.numpy as jnp
from jax import lax
import numpy as np

D_MODEL = 4096
BATCH = 8
SEQ = 2048
DEPTH = 2

HEAD_DIM = 128
A_W = D_MODEL // 4
A_HEADS = A_W // HEAD_DIM
HG_CHUNK = 64
B_W = D_MODEL // 4
B_BLOCKS = B_W // HEAD_DIM
B_BD = B_W // B_BLOCKS
RG_CONV = 4
RG_C = 8.0
C_HEADS = D_MODEL // 2 // HEAD_DIM
C_KV = C_HEADS // 4
C_GROUP = C_HEADS // C_KV
C_W = C_HEADS * HEAD_DIM
Q_BLOCK = 128
ROPE_THETA = 10000.0
ROPE_HALF = HEAD_DIM // 2
GRID_W = 64
D_MIX = A_W + B_W + C_W
A_COLS = 5 * A_W
B_COLS = 2 * B_W
C_COLS = C_W + 2 * C_KV * HEAD_DIM
IN_COLS = A_COLS + B_COLS + C_COLS
D_FF = ((8 * D_MODEL // 3 + 255) // 256) * 256
FFN_CONV = 3
DEEPNORM_ALPHA = (2.0 * DEPTH) ** 0.25
DEEPNORM_BETA = (8.0 * DEPTH) ** -0.25
LN_EPS = 1e-5
RMS_EPS = 1e-6

kernel_name = "hybrid_hgrn2_rglru_axialgqa_encoder"


def layer_norm(x, w, b):
    xf = x.astype(jnp.float32)
    mu = jnp.mean(xf, axis=-1, keepdims=True)
    var = jnp.mean(jnp.square(xf - mu), axis=-1, keepdims=True)
    y = (xf - mu) * lax.rsqrt(var + LN_EPS)
    return (y * w.astype(jnp.float32) + b.astype(jnp.float32)).astype(x.dtype)


def rms_norm(x, w):
    xf = x.astype(jnp.float32)
    y = xf * lax.rsqrt(jnp.mean(jnp.square(xf), axis=-1, keepdims=True) + RMS_EPS)
    return y * w.astype(jnp.float32)


def dwconv(x, w, b, left):
    k_w = w.shape[0]
    s = x.shape[1]
    xp = jnp.pad(x, ((0, 0), (left, k_w - 1 - left), (0, 0)))
    y = b
    for k in range(k_w):
        y = y + xp[:, k:k + s, :] * w[k]
    return y


def hgrn2_scan(q, logf, k, v):
    bsz, s, h, dk = q.shape
    dv = v.shape[-1]
    n_chunks = s // HG_CHUNK

    def to_chunks(t):
        return t.reshape(bsz, n_chunks, HG_CHUNK, h, t.shape[-1]).transpose(1, 0, 3, 2, 4)

    tri = jnp.tril(jnp.ones((HG_CHUNK, HG_CHUNK), dtype=bool))

    def step(state, xs):
        qc, lfc, kc, vc = xs
        b = jnp.cumsum(lfc, axis=2)
        b_last = b[:, :, -1:, :]
        o_inter = jnp.einsum('bhcd,bhde->bhce', qc * jnp.exp(b), state)
        diff = b[:, :, :, None, :] - b[:, :, None, :, :]
        decay = jnp.exp(jnp.where(tri[:, :, None], diff, -jnp.inf))
        scores = jnp.einsum('bhid,bhijd,bhjd->bhij', qc, decay, kc)
        o_intra = jnp.einsum('bhij,bhje->bhie', scores, vc)
        new_state = (jnp.exp(b_last)[:, :, 0, :, None] * state
                     + jnp.einsum('bhjd,bhje->bhde', kc * jnp.exp(b_last - b), vc))
        return new_state, o_inter + o_intra

    state0 = jnp.zeros((bsz, h, dk, dv), jnp.float32)
    _, out = lax.scan(step, state0, (to_chunks(q), to_chunks(logf), to_chunks(k), to_chunks(v)))
    return out.transpose(1, 0, 3, 2, 4).reshape(bsz, s, h, dv)


def hgrn2_mixer(u, lb, norm_w):
    bsz, s, _ = u.shape
    heads = lambda t: t.reshape(bsz, s, A_HEADS, HEAD_DIM).astype(jnp.float32)
    q = heads(u[..., 0 * A_W:1 * A_W])
    zf_fwd = heads(u[..., 1 * A_W:2 * A_W])
    zf_bwd = heads(u[..., 2 * A_W:3 * A_W])
    iv = heads(u[..., 3 * A_W:4 * A_W])
    g = u[..., 4 * A_W:5 * A_W]

    def gates(z, lb_dir):
        lbd = lb_dir.reshape(A_HEADS, HEAD_DIM)
        logf = jnp.logaddexp(jnp.log(lbd), jnp.log1p(-lbd) + jax.nn.log_sigmoid(z))
        kk = (1.0 - lbd) * jax.nn.sigmoid(-z)
        return logf, kk

    lf_f, k_f = gates(zf_fwd, lb[0])
    lf_b, k_b = gates(zf_bwd, lb[1])
    flip = lambda t: jnp.flip(t, axis=1)
    o_f = hgrn2_scan(q, lf_f, k_f, iv)
    o_b = flip(hgrn2_scan(flip(q), flip(lf_b), flip(k_b), flip(iv)))
    o = rms_norm(o_f + o_b, norm_w.reshape(A_HEADS, HEAD_DIM)).reshape(bsz, s, A_W)
    return (o * jax.nn.silu(g.astype(jnp.float32))).astype(u.dtype)


def _linear_rec_combine(left, right):
    a1, b1 = left
    a2, b2 = right
    return a1 * a2, a2 * b1 + b2


def rglru_mixer(u, conv_w, conv_b, wa, ba, wx, bx, lam):
    bsz, s, _ = u.shape
    xb = u[..., :B_W]
    gate = u[..., B_W:]
    xc = dwconv(xb, conv_w, conv_b, left=RG_CONV // 2).astype(jnp.float32)
    xh = xc.reshape(bsz, s, B_BLOCKS, B_BD)

    def direction(d, reverse):
        r = jax.nn.sigmoid(jnp.einsum('bsnd,nde->bsne', xh, wa[d].astype(jnp.float32)).reshape(bsz, s, B_W)
                           + ba[d].astype(jnp.float32))
        ig = jax.nn.sigmoid(jnp.einsum('bsnd,nde->bsne', xh, wx[d].astype(jnp.float32)).reshape(bsz, s, B_W)
                            + bx[d].astype(jnp.float32))
        log_a = -RG_C * r * jax.nn.softplus(-lam[d].astype(jnp.float32))
        a = jnp.exp(log_a)
        bterm = jnp.sqrt(-jnp.expm1(2.0 * log_a)) * (ig * xc)
        _, hs = lax.associative_scan(_linear_rec_combine, (a, bterm), axis=1, reverse=reverse)
        return hs

    hsum = direction(0, False) + direction(1, True)
    return (jax.nn.gelu(gate.astype(jnp.float32)) * hsum).astype(u.dtype)


def axial_rope(t, cos, sin):
    q4 = ROPE_HALF // 2
    tr = t[..., :ROPE_HALF]
    tc = t[..., ROPE_HALF:]
    rot = jnp.concatenate([-tr[..., q4:], tr[..., :q4], -tc[..., q4:], tc[..., :q4]], axis=-1)
    return t * cos[:, None, :] + rot * sin[:, None, :]


def gqa_mixer(u, qn_w, kn_w, cos, sin):
    bsz, s, _ = u.shape
    kv_w = C_KV * HEAD_DIM
    q = u[..., :C_W].reshape(bsz, s, C_HEADS, HEAD_DIM)
    k = u[..., C_W:C_W + kv_w].reshape(bsz, s, C_KV, HEAD_DIM)
    v = u[..., C_W + kv_w:].reshape(bsz, s, C_KV, HEAD_DIM).astype(jnp.float32)
    q = axial_rope(rms_norm(q, qn_w), cos, sin)
    k = axial_rope(rms_norm(k, kn_w), cos, sin)
    scale = HEAD_DIM ** -0.5
    n_blk = s // Q_BLOCK
    qb = q.reshape(bsz, n_blk, Q_BLOCK, C_KV, C_GROUP, HEAD_DIM).transpose(1, 0, 2, 3, 4, 5)

    def attend(q_blk):
        sc = jnp.einsum('bqkgd,bskd->bkgqs', q_blk, k) * scale
        p = jax.nn.softmax(sc, axis=-1)
        return jnp.einsum('bkgqs,bskd->bqkgd', p, v)

    out = lax.map(attend, qb)
    return out.transpose(1, 0, 2, 3, 4, 5).reshape(bsz, s, C_W).astype(u.dtype)


def setup_inputs(seed: int = 0) -> dict:
    key = jax.random.key(seed)
    ks = jax.random.split(key, 28)
    f32 = jnp.float32

    def nrm(k, shape, scale):
        return jax.random.normal(k, shape, f32) * scale

    a8 = jax.random.uniform(ks[12], (DEPTH, 2, B_W), f32, 0.9, 0.999)
    a_base = a8 ** (1.0 / RG_C)
    rglru_lambda = jnp.log(a_base) - jnp.log1p(-a_base)
    return {
        "x": nrm(ks[0], (BATCH, SEQ, D_MODEL), 1.0),
        "emb_ln_w": 1.0 + nrm(ks[1], (D_MODEL,), 0.02),
        "emb_ln_b": nrm(ks[2], (D_MODEL,), 0.02),
        "w_in": nrm(ks[3], (DEPTH, D_MODEL, IN_COLS), D_MODEL ** -0.5),
        "hgrn_lb_logits": nrm(ks[4], (DEPTH, 2, A_W), 0.5),
        "hgrn_norm_w": 1.0 + nrm(ks[5], (DEPTH, A_W), 0.02),
        "rglru_conv_w": nrm(ks[6], (DEPTH, RG_CONV, B_W), RG_CONV ** -0.5),
        "rglru_conv_b": nrm(ks[7], (DEPTH, B_W), 0.02),
        "rglru_wa": nrm(ks[8], (DEPTH, 2, B_BLOCKS, B_BD, B_BD), B_BD ** -0.5),
        "rglru_ba": nrm(ks[9], (DEPTH, 2, B_W), 0.02),
        "rglru_wx": nrm(ks[10], (DEPTH, 2, B_BLOCKS, B_BD, B_BD), B_BD ** -0.5),
        "rglru_bx": nrm(ks[11], (DEPTH, 2, B_W), 0.02),
        "rglru_lambda": rglru_lambda,
        "attn_q_norm_w": 1.0 + nrm(ks[13], (DEPTH, HEAD_DIM), 0.02),
        "attn_k_norm_w": 1.0 + nrm(ks[14], (DEPTH, HEAD_DIM), 0.02),
        "w_out": nrm(ks[15], (DEPTH, D_MIX, D_MODEL), D_MIX ** -0.5 * DEEPNORM_BETA),
        "ln1_w": 1.0 + nrm(ks[16], (DEPTH, D_MODEL), 0.02),
        "ln1_b": nrm(ks[17], (DEPTH, D_MODEL), 0.02),
        "ffn_w_up": nrm(ks[18], (DEPTH, D_MODEL, 2 * D_FF), D_MODEL ** -0.5),
        "ffn_conv_w": nrm(ks[19], (DEPTH, FFN_CONV, D_FF), FFN_CONV ** -0.5),
        "ffn_conv_b": nrm(ks[20], (DEPTH, D_FF), 0.02),
        "ffn_w_down": nrm(ks[21], (DEPTH, D_FF, D_MODEL), D_FF ** -0.5 * DEEPNORM_BETA),
        "ln2_w": 1.0 + nrm(ks[22], (DEPTH, D_MODEL), 0.02),
        "ln2_b": nrm(ks[23], (DEPTH, D_MODEL), 0.02),
    }


def reference(x, emb_ln_w, emb_ln_b, w_in, hgrn_lb_logits, hgrn_norm_w, rglru_conv_w, rglru_conv_b,
              rglru_wa, rglru_ba, rglru_wx, rglru_bx, rglru_lambda, attn_q_norm_w, attn_k_norm_w,
              w_out, ln1_w, ln1_b, ffn_w_up, ffn_conv_w, ffn_conv_b, ffn_w_down, ln2_w, ln2_b):
    s = x.shape[1]
    rows = s // GRID_W
    g_r, g_c = jnp.meshgrid(jnp.arange(rows), jnp.arange(GRID_W), indexing='ij')
    row = g_r.reshape(s).astype(jnp.float32)
    col = g_c.reshape(s).astype(jnp.float32)
    inv_freq = ROPE_THETA ** (-jnp.arange(0, ROPE_HALF, 2, dtype=jnp.float32) / ROPE_HALF)
    ang_r = row[:, None] * inv_freq[None, :]
    ang_c = col[:, None] * inv_freq[None, :]
    ang = jnp.concatenate([ang_r, ang_r, ang_c, ang_c], axis=-1)
    cos, sin = jnp.cos(ang), jnp.sin(ang)

    lb_cs = jnp.cumsum(jax.nn.softmax(hgrn_lb_logits.astype(jnp.float32), axis=0), axis=0)
    lower_bounds = lb_cs - lb_cs[0:1]

    h = layer_norm(x, emb_ln_w, emb_ln_b)
    for l in range(DEPTH):
        u = h @ w_in[l]
        u_a = u[..., :A_COLS]
        u_b = u[..., A_COLS:A_COLS + B_COLS]
        u_c = u[..., A_COLS + B_COLS:]
        y_a = hgrn2_mixer(u_a, lower_bounds[l], hgrn_norm_w[l])
        y_b = rglru_mixer(u_b, rglru_conv_w[l], rglru_conv_b[l], rglru_wa[l], rglru_ba[l],
                          rglru_wx[l], rglru_bx[l], rglru_lambda[l])
        y_c = gqa_mixer(u_c, attn_q_norm_w[l], attn_k_norm_w[l], cos, sin)
        mix = jnp.concatenate([y_a, y_b, y_c], axis=-1) @ w_out[l]
        h = layer_norm(DEEPNORM_ALPHA * h + mix, ln1_w[l], ln1_b[l])
        gu = h @ ffn_w_up[l]
        gate = jax.nn.silu(dwconv(gu[..., :D_FF], ffn_conv_w[l], ffn_conv_b[l], left=FFN_CONV // 2))
        ffn = (gate * gu[..., D_FF:]) @ ffn_w_down[l]
        h = layer_norm(DEEPNORM_ALPHA * h + ffn, ln2_w[l], ln2_b[l])
    return h
```

```cpp
#include <hip/hip_runtime.h>
#include <hip/hip_bf16.h>
#include <cstdio>
#include <cstdint>
#define MK_SINGLE 0
namespace pg8 {
#define PG8_LAS __attribute__((address_space(3)))
typedef unsigned short bf16_t;
typedef short bf16x8 __attribute__((ext_vector_type(8)));
typedef float f32x4 __attribute__((ext_vector_type(4)));
typedef unsigned u32x4 __attribute__((ext_vector_type(4)));
constexpr int BM = 256, BK = 64, HALF = 128, HTB = HALF * BK * 2  , STAGE_BYTES = 8 * HTB, NXCD = 8, WGM = 8;

__host__ __device__ __forceinline__ int lds_byte(int r, int c) { const int st = (r >> 4) * 2 + (c >> 5), rr = r & 15, cc = c & 31, ob = rr * 64 + cc * 2; return st * 1024 + (ob ^ (((ob >> 9) & 1) << 5)); }
__host__ __device__ __forceinline__ void stage_rc(int b, int& R, int& C) { const int st = b / 1024, sb = b % 1024, swz = sb ^ (((sb >> 9) & 1) << 5); R = (st >> 1) * 16 + swz / 64; C = (st & 1) * 32 + (swz % 64) / 2; }
__host__ __device__ __forceinline__ int perm32(int rho) { const int n = rho >> 4, i = rho & 15; return 8 * (i >> 2) + 4 * n + (i & 3); }

struct Unit { int pm, pn; };
struct Gemm { const bf16_t* A; const bf16_t* Bt; int M, N, K; };

struct StaticOrder {
    int nM, nN, nwg, G, c;
    __host__ __device__ void init(int M, int N, int G_, int c_) { nM = M / BM; nN = N / BM; nwg = nM * nN; G = G_; c = c_; }
    __host__ __device__ bool next(int i, Unit& u) const {
        const long L = (long)i * G + c; if (L >= nwg) return false;
        int wgid = (int)L; { const int q = nwg / NXCD, r = nwg % NXCD, xcd = wgid % NXCD, off = wgid / NXCD; wgid = (xcd < r ? xcd * (q + 1) : r * (q + 1) + (xcd - r) * q) + off; }
        const int nig = WGM * nN, gid = wgid / nig, fm = gid * WGM, gsz = (nM - fm) < WGM ? (nM - fm) : WGM;
        u.pm = fm + ((wgid % nig) % gsz); u.pn = (wgid % nig) / gsz; return true;
    }
    __device__ __forceinline__ void a_ready(const Unit&) const {}
    __device__ __forceinline__ void done(const Unit&) const {}
};

__device__ __forceinline__ unsigned cvt_pk_bf16(float lo, float hi) { unsigned r; asm volatile("v_cvt_pk_bf16_f32 %0, %1, %2" : "=v"(r) : "v"(lo), "v"(hi)); return r; }
typedef float f32x2 __attribute__((ext_vector_type(2)));
__device__ __forceinline__ f32x2 gelu_pk(f32x2 v) {
    const f32x2 av = __builtin_elementwise_abs(v), d = av * 0.2316418882f + 1.0f;
    f32x2 t; t.x = __builtin_amdgcn_rcpf(d.x); t.y = __builtin_amdgcn_rcpf(d.y);
    f32x2 q = t * 0.5307027145f + (-0.7265760135f); q = q * t + 0.7107068705f; q = q * t + (-0.142248368f); q = q * t + 0.127414796f; q = q * t;
    const f32x2 s = (v * v) * (-0.72134752044f);
    f32x2 e; e.x = __builtin_amdgcn_exp2f(s.x); e.y = __builtin_amdgcn_exp2f(s.y);
    const f32x2 m = v * (q * e), r = v - m;
    f32x2 o; o.x = v.x < 0.f ? m.x : r.x; o.y = v.y < 0.f ? m.y : r.y; return o;
}

template <int ACT  > struct EpiBf16 {
    static constexpr bool PERM = true, AFTER_DRAIN = false; static_assert(ACT == 0 || ACT == 1, "EpiBf16: ACT is 0 (none) or 1 (gelu_pk)");
    bf16_t* O; int ldc; const float* bias; int split_cols; size_t split_stride; float scale0;
    __device__ __forceinline__ void operator()(const f32x4 (&acc)[2][2][4][2], const Unit& u, int wr, int wc, int fr, int fq) const {
        const int row0 = u.pm * BM + wr * 64 + fr; int colt = u.pn * BM; bf16_t* base = O;
        float sc = 1.f; if (split_cols) { const int t = colt / split_cols; base += (size_t)t * split_stride; colt -= t * split_cols; if (t == 0) sc = scale0; }
        const int col0 = colt + wc * 32 + 8 * fq, bcol0 = u.pn * BM + wc * 32 + 8 * fq;
        f32x4 bv[2][2];
#pragma unroll
        for (int bj = 0; bj < 2; ++bj)
#pragma unroll
            for (int n = 0; n < 2; ++n) bv[bj][n] = bias ? *(const f32x4*)(bias + bcol0 + bj * HALF + 4 * n) : (f32x4){0.f, 0.f, 0.f, 0.f};
#pragma unroll
        for (int ai = 0; ai < 2; ++ai)
#pragma unroll
            for (int m = 0; m < 4; ++m) { bf16_t* rowp = base + (size_t)(row0 + ai * HALF + m * 16) * ldc + col0;
#pragma unroll
                for (int bj = 0; bj < 2; ++bj) { f32x4 v0 = acc[ai][bj][m][0] + bv[bj][0], v1 = acc[ai][bj][m][1] + bv[bj][1];
                    if (ACT == 1) { f32x2 a = gelu_pk((f32x2){v0[0], v0[1]}), b = gelu_pk((f32x2){v0[2], v0[3]}), c = gelu_pk((f32x2){v1[0], v1[1]}), d = gelu_pk((f32x2){v1[2], v1[3]});
                        v0 = (f32x4){a.x, a.y, b.x, b.y}; v1 = (f32x4){c.x, c.y, d.x, d.y}; }
                    v0 = v0 * sc; v1 = v1 * sc; u32x4 w; w.x = cvt_pk_bf16(v0[0], v0[1]); w.y = cvt_pk_bf16(v0[2], v0[3]); w.z = cvt_pk_bf16(v1[0], v1[1]); w.w = cvt_pk_bf16(v1[2], v1[3]);
                    *(u32x4*)(rowp + bj * HALF) = w; } }
    }
};
struct EpiResF32 {
    static constexpr bool PERM = false, AFTER_DRAIN = false;
    const float* base; float* C; int ldc; float alpha;
    __device__ __forceinline__ void operator()(const f32x4 (&acc)[2][2][4][2], const Unit& u, int wr, int wc, int fr, int fq) const {
        const int row0 = u.pm * BM + wr * 64 + fr, col0 = u.pn * BM + wc * 32 + 4 * fq;
#pragma unroll
        for (int ai = 0; ai < 2; ++ai)
#pragma unroll
            for (int m = 0; m < 4; ++m) { const size_t off = (size_t)(row0 + ai * HALF + m * 16) * ldc + col0;
#pragma unroll
                for (int bj = 0; bj < 2; ++bj)
#pragma unroll
                    for (int n = 0; n < 2; ++n) { const f32x4 bs = *(const f32x4*)(base + off + bj * HALF + n * 16);
                        *(f32x4*)(C + off + bj * HALF + n * 16) = acc[ai][bj][m][n] + alpha * bs; } }
    }
};
template <class Epi, class Sched, bool ALIGN_EPI = false, bool SP2 = false>
__device__ __forceinline__ void gemm_phase(PG8_LAS unsigned char* lds, const Gemm g, const Sched& S, const Epi& E) {
    int tid_ = threadIdx.x; asm volatile("" : "+v"(tid_));
    const int tid = tid_, wid = __builtin_amdgcn_readfirstlane(tid >> 6), lane = tid & 63, wr = wid >> 2, wc = wid & 3, fr = lane & 15, fq = lane >> 4;
    const int K = g.K, nt = K / BK;
    unsigned voffA[2], voffB[2];
#pragma unroll
    for (int i = 0; i < 2; ++i) { int R, C; stage_rc(tid * 16 + i * 8192, R, C); const int Rb = Epi::PERM ? ((R & ~31) + perm32(R & 31)) : R;
        voffA[i] = (unsigned)(R * K + C) * 2u; voffB[i] = (unsigned)(Rb * K + C) * 2u; }
    const size_t kstep = (size_t)(BK * 2);
    const size_t hstep = (size_t)HALF * K * 2;
    const size_t tstep = 2 * hstep;
    const unsigned ldsw = (unsigned)wid * 1024u;
    const int aoff = lds_byte(wr * 64 + fr, fq * 8), boff = lds_byte(wc * 32 + fr, fq * 8);
#define PG8_SA(b, h) (((b) * 2 + (h)) * HTB)
#define PG8_SB(b, h) ((4 + (b) * 2 + (h)) * HTB)
#define PG8_STAGE(bufoff, gbase, voff) do { _Pragma("unroll") for (int _i = 0; _i < 2; ++_i) \
        __builtin_amdgcn_global_load_lds((const unsigned*)((const char*)(gbase) + (voff)[_i]), (PG8_LAS unsigned*)(lds + (bufoff) + ldsw + _i * 8192), 16, 0, 0); } while (0)
#define PG8_LDA(dst, b, h) do { _Pragma("unroll") for (int m = 0; m < 4; ++m) _Pragma("unroll") for (int k = 0; k < 2; ++k) dst[m][k] = *(const PG8_LAS bf16x8*)(lds + PG8_SA(b, h) + aoff + m * 2048 + k * 1024); } while (0)
#define PG8_LDB(dst, b, h) do { _Pragma("unroll") for (int n = 0; n < 2; ++n) _Pragma("unroll") for (int k = 0; k < 2; ++k) dst[n][k] = *(const PG8_LAS bf16x8*)(lds + PG8_SB(b, h) + boff + n * 2048 + k * 1024); } while (0)
#define PG8_MMA(ai, bj, At, Bt) do { __builtin_amdgcn_s_setprio(1); _Pragma("unroll") for (int m = 0; m < 4; ++m) _Pragma("unroll") for (int n = 0; n < 2; ++n) _Pragma("unroll") for (int k = 0; k < 2; ++k) \
        acc[ai][bj][m][n] = __builtin_amdgcn_mfma_f32_16x16x32_bf16(Bt[n][k], At[m][k], acc[ai][bj][m][n], 0, 0, 0); __builtin_amdgcn_s_setprio(0); } while (0)
#define PG8_WAIT_V(n) asm volatile("s_waitcnt vmcnt(" #n ")" ::: "memory")
#define PG8_WAIT_L(n) asm volatile("s_waitcnt lgkmcnt(" #n ")" ::: "memory")
#define PG8_BAR __builtin_amdgcn_s_barrier()
#define PG8_SCHED __builtin_amdgcn_sched_barrier(0)
    Unit cur, nxt; int ui = 0;
    if (!S.next(0, cur)) return;
    f32x4 acc[2][2][4][2];
#pragma unroll
    for (int a = 0; a < 2; ++a)
#pragma unroll
        for (int b = 0; b < 2; ++b)
#pragma unroll
            for (int m = 0; m < 4; ++m)
#pragma unroll
                for (int n = 0; n < 2; ++n) acc[a][b][m][n] = (f32x4){0.f, 0.f, 0.f, 0.f};
    bf16x8 At[4][2], B0[2][2], B1[2][2];
    const char* cA = (const char*)g.A + (size_t)cur.pm * tstep; const char* cB = (const char*)g.Bt + (size_t)cur.pn * tstep;
    S.a_ready(cur);
    if constexpr (SP2) {
        PG8_STAGE(PG8_SB(0, 0), cB, voffB); PG8_STAGE(PG8_SB(0, 1), cB + hstep, voffB); PG8_STAGE(PG8_SA(0, 0), cA, voffA); PG8_STAGE(PG8_SA(0, 1), cA + hstep, voffA);
        if (wr == 1) PG8_BAR;
        PG8_WAIT_V(2); PG8_BAR;
        PG8_STAGE(PG8_SB(1, 0), cB + kstep, voffB); PG8_STAGE(PG8_SA(1, 0), cA + kstep, voffA); PG8_STAGE(PG8_SB(1, 1), cB + hstep + kstep, voffB);
        PG8_WAIT_V(6); PG8_BAR;
    } else {
        PG8_STAGE(PG8_SB(0, 0), cB, voffB); PG8_STAGE(PG8_SA(0, 0), cA, voffA); PG8_STAGE(PG8_SB(0, 1), cB + hstep, voffB); PG8_STAGE(PG8_SA(0, 1), cA + hstep, voffA);
        if (wr == 1) PG8_BAR;
        PG8_WAIT_V(4); PG8_BAR;
        PG8_STAGE(PG8_SB(1, 0), cB + kstep, voffB); PG8_STAGE(PG8_SA(1, 0), cA + kstep, voffA); PG8_STAGE(PG8_SB(1, 1), cB + hstep + kstep, voffB);
        PG8_WAIT_V(6); PG8_BAR;
    }
    for (;;) {
        const bool has_next = S.next(ui + 1, nxt);
        const char* nA = has_next ? (const char*)g.A + (size_t)nxt.pm * tstep : cA; const char* nB = has_next ? (const char*)g.Bt + (size_t)nxt.pn * tstep : cB;
        for (int t = 0; t < nt; t += 2) {
            const bool last = (t == nt - 2);
            const char* a1 = cA + (size_t)(t + 1) * kstep;
            const char* a2 = last ? nA : cA + (size_t)(t + 2) * kstep; const char* b2 = last ? nB : cB + (size_t)(t + 2) * kstep;
            const char* a3 = a2 + kstep; const char* b3 = b2 + kstep;
            if (last && has_next) S.a_ready(nxt);
            if constexpr (SP2) {
            PG8_LDB(B0, 0, 0); PG8_LDB(B1, 0, 1); PG8_SCHED; PG8_LDA(At, 0, 0); PG8_STAGE(PG8_SA(1, 1), a1 + hstep, voffA);
            PG8_WAIT_V(8); PG8_WAIT_L(0); PG8_BAR; PG8_MMA(0, 0, At, B0); PG8_MMA(0, 1, At, B1); PG8_BAR; PG8_SCHED;
            PG8_LDA(At, 0, 1); PG8_STAGE(PG8_SB(0, 0), b2, voffB); PG8_STAGE(PG8_SB(0, 1), b2 + hstep, voffB); PG8_STAGE(PG8_SA(0, 0), a2, voffA);
            PG8_WAIT_V(8); PG8_WAIT_L(0); PG8_BAR; PG8_MMA(1, 0, At, B0); PG8_MMA(1, 1, At, B1); PG8_BAR; PG8_SCHED;
            PG8_LDB(B0, 1, 0); PG8_LDB(B1, 1, 1); PG8_SCHED; PG8_LDA(At, 1, 0); PG8_STAGE(PG8_SA(0, 1), a2 + hstep, voffA);
            PG8_WAIT_V(8); PG8_WAIT_L(0); PG8_BAR; PG8_MMA(0, 0, At, B0); PG8_MMA(0, 1, At, B1); PG8_BAR; PG8_SCHED;
            PG8_LDA(At, 1, 1); PG8_STAGE(PG8_SB(1, 0), b3, voffB); PG8_STAGE(PG8_SB(1, 1), b3 + hstep, voffB); PG8_STAGE(PG8_SA(1, 0), a3, voffA);
            PG8_WAIT_V(8); PG8_WAIT_L(0); PG8_BAR; PG8_MMA(1, 0, At, B0); PG8_MMA(1, 1, At, B1); PG8_BAR; PG8_SCHED;
            } else {
            PG8_LDB(B0, 0, 0); PG8_SCHED; PG8_LDA(At, 0, 0); PG8_STAGE(PG8_SA(1, 1), a1 + hstep, voffA);
            PG8_WAIT_L(8); PG8_BAR; PG8_WAIT_L(0); PG8_MMA(0, 0, At, B0); PG8_BAR; PG8_SCHED;
            PG8_LDB(B1, 0, 1); PG8_STAGE(PG8_SB(0, 0), b2, voffB);
            PG8_BAR; PG8_WAIT_L(0); PG8_MMA(0, 1, At, B1); PG8_BAR;
            PG8_LDA(At, 0, 1); PG8_STAGE(PG8_SA(0, 0), a2, voffA);
            PG8_BAR; PG8_WAIT_L(0); PG8_MMA(1, 0, At, B0); PG8_BAR; PG8_SCHED;
            PG8_STAGE(PG8_SB(0, 1), b2 + hstep, voffB);
            PG8_WAIT_V(6); PG8_BAR; PG8_MMA(1, 1, At, B1); PG8_BAR;
            PG8_LDB(B0, 1, 0); PG8_SCHED; PG8_LDA(At, 1, 0); PG8_STAGE(PG8_SA(0, 1), a2 + hstep, voffA);
            PG8_WAIT_L(8); PG8_BAR; PG8_WAIT_L(0); PG8_MMA(0, 0, At, B0); PG8_BAR; PG8_SCHED;
            PG8_LDB(B1, 1, 1); PG8_STAGE(PG8_SB(1, 0), b3, voffB);
            PG8_BAR; PG8_WAIT_L(0); PG8_MMA(0, 1, At, B1); PG8_BAR;
            PG8_LDA(At, 1, 1); PG8_STAGE(PG8_SA(1, 0), a3, voffA);
            PG8_BAR; PG8_WAIT_L(0); PG8_MMA(1, 0, At, B0); PG8_BAR; PG8_SCHED;
            PG8_STAGE(PG8_SB(1, 1), b3 + hstep, voffB);
            PG8_WAIT_V(6); PG8_BAR; PG8_MMA(1, 1, At, B1); PG8_BAR;
            }
        }
        if constexpr (ALIGN_EPI) { if (wr == 0) PG8_BAR; }
        if constexpr (!Epi::AFTER_DRAIN) { E(acc, cur, wr, wc, fr, fq); S.done(cur); }
        if (!has_next) break;
#pragma unroll
        for (int a = 0; a < 2; ++a)
#pragma unroll
            for (int b = 0; b < 2; ++b)
#pragma unroll
                for (int m = 0; m < 4; ++m)
#pragma unroll
                    for (int n = 0; n < 2; ++n) acc[a][b][m][n] = (f32x4){0.f, 0.f, 0.f, 0.f};
        cur = nxt; cA = nA; cB = nB; ++ui;
        if constexpr (ALIGN_EPI) { if (wr == 1) PG8_BAR; }
    }
    PG8_WAIT_V(0);
    if constexpr (!ALIGN_EPI) { if (wr == 0) PG8_BAR; }
    PG8_BAR;
    if constexpr (Epi::AFTER_DRAIN) { E.fused(acc, cur, wr, wc, fr, fq, lds, wid, lane); S.done(cur); }
#undef PG8_SA
#undef PG8_SB
#undef PG8_STAGE
#undef PG8_LDA
#undef PG8_LDB
#undef PG8_MMA
#undef PG8_WAIT_V
#undef PG8_WAIT_L
#undef PG8_BAR
#undef PG8_SCHED
}
}
namespace attn {
using bf16 = __hip_bfloat16;
constexpr int   D = 128, NW = 8, QBLK = 32, KVBLK = 64;
constexpr float SCALE = 0.088388347648318440f;
constexpr float THR = 8.f;
constexpr int SDEPTH = 2;
constexpr int LDQ = 10240, LDK = 10240, LDO = 4096;
constexpr size_t SHM_V = KVBLK * D * 2, SHM_K = KVBLK * D * 2, SHM_ATTN = 2 * SHM_V + 2 * SHM_K + NW * 64 * 4;
using bf16x8 = __attribute__((ext_vector_type(8))) short;
using s16x4  = __attribute__((ext_vector_type(4))) short;
using f32x16 = __attribute__((ext_vector_type(16))) float;
using f32x8  = __attribute__((ext_vector_type(8))) float;
using u32x4  = __attribute__((ext_vector_type(4))) unsigned;
#define KSWZ(row, colB) ((row) * 256 + ((colB) ^ (((row) & 7) << 4)))
#define SBAR() __builtin_amdgcn_sched_barrier(0)
__device__ __forceinline__ int crow(int r, int hi) { return (r & 3) + 8 * (r >> 2) + 4 * hi; }
__device__ __forceinline__ unsigned cvtpk(float lo, float hi) {
  unsigned r; asm volatile("v_cvt_pk_bf16_f32 %0, %1, %2" : "=v"(r) : "v"(lo), "v"(hi)); return r;
}
template <typename TIn> struct Stage;
template <> struct Stage<bf16>  { using T = bf16x8;
  __device__ static __forceinline__ T ld8(const bf16* p) { return *reinterpret_cast<const bf16x8*>(p); }
  __device__ static __forceinline__ bf16x8 tobf(T x) { return x; } };
template <> struct Stage<float> { using T = f32x8;
  __device__ static __forceinline__ T ld8(const float* p) { return *reinterpret_cast<const f32x8*>(p); }
  __device__ static __forceinline__ bf16x8 tobf(T x) {
    u32x4 w = {cvtpk(x[0], x[1]), cvtpk(x[2], x[3]), cvtpk(x[4], x[5]), cvtpk(x[6], x[7])}; return *reinterpret_cast<bf16x8*>(&w); } };

__device__ __forceinline__ void partialSM(f32x16& p0, f32x16& p1, float& m_reg, float& mn, float& alpha) {
  constexpr float C = SCALE * 1.4426950408889634f;
  float pmax = p0[0]; for (int r = 1; r < 16; ++r) pmax = fmaxf(pmax, p0[r]); for (int r = 0; r < 16; ++r) pmax = fmaxf(pmax, p1[r]);
  { auto rr = __builtin_amdgcn_permlane32_swap(__float_as_uint(pmax), __float_as_uint(pmax), false, false);
    pmax = fmaxf(__uint_as_float(rr[0]), __uint_as_float(rr[1])); }
  if (__builtin_expect(__all(pmax - m_reg <= THR / SCALE), 1)) { mn = m_reg; alpha = 1.f; }
  else { mn = fmaxf(m_reg, pmax); alpha = __builtin_amdgcn_exp2f((m_reg - mn) * C); m_reg = mn; }
  float mnC = -mn * C;
  for (int r = 0; r < 16; ++r) p0[r] = fmaf(p0[r], C, mnC); for (int r = 0; r < 16; ++r) p1[r] = fmaf(p1[r], C, mnC);
  for (int r = 0; r < 16; ++r) p0[r] = __builtin_amdgcn_exp2f(p0[r]);
}
__device__ __forceinline__ void finishSM(f32x16& p0, f32x16& p1, float alpha, float& l_reg, bf16x8& pa0, bf16x8& pa1, bf16x8& pa2, bf16x8& pa3) {
  for (int r = 0; r < 16; ++r) p1[r] = __builtin_amdgcn_exp2f(p1[r]);
  float ps = 0; for (int r = 0; r < 16; ++r) ps += p0[r]; for (int r = 0; r < 16; ++r) ps += p1[r];
  { auto rr = __builtin_amdgcn_permlane32_swap(__float_as_uint(ps), __float_as_uint(ps), false, false);
    ps = __uint_as_float(rr[0]) + __uint_as_float(rr[1]); }
  l_reg = l_reg * alpha + ps;
#define PK4(P, BASE, OUT) do { unsigned a0 = cvtpk(P[BASE + 0], P[BASE + 1]), a1 = cvtpk(P[BASE + 2], P[BASE + 3]);   \
    unsigned b0 = cvtpk(P[BASE + 4], P[BASE + 5]), b1 = cvtpk(P[BASE + 6], P[BASE + 7]);                              \
    auto r0 = __builtin_amdgcn_permlane32_swap(a0, b0, false, false); auto r1 = __builtin_amdgcn_permlane32_swap(a1, b1, false, false); \
    u32x4 w = {r0[0], r1[0], r0[1], r1[1]}; OUT = *reinterpret_cast<bf16x8*>(&w); } while (0)
  PK4(p0, 0, pa0); PK4(p0, 8, pa1); PK4(p1, 0, pa2); PK4(p1, 8, pa3);
#undef PK4
}
__device__ __forceinline__ void qkt(f32x16& p0, f32x16& p1, const bf16* Ks, const bf16x8* qr, int r32, int hi) {
  p0 = f32x16{}; p1 = f32x16{};
  for (int d0 = 0; d0 < 8; ++d0) { int cb = (d0 * 16 + hi * 8) * 2;
    bf16x8 b0 = *reinterpret_cast<const bf16x8*>((const char*)Ks + KSWZ(r32, cb));
    bf16x8 b1 = *reinterpret_cast<const bf16x8*>((const char*)Ks + KSWZ(32 + r32, cb));
    p0 = __builtin_amdgcn_mfma_f32_32x32x16_bf16(b0, qr[d0], p0, 0, 0, 0);
    p1 = __builtin_amdgcn_mfma_f32_32x32x16_bf16(b1, qr[d0], p1, 0, 0, 0); }
}
__device__ __forceinline__ int v_st(int k, int c) { const int kk = (k & ~0xC) | ((k & 4) << 1) | ((k & 8) >> 1); return ((kk >> 3) * 4 + (c >> 5)) * 512 + ((kk & 7) * 32 + (c & 31)) * 2; }
__device__ __forceinline__ int v_rd_base(int lane) { return ((lane & 3) << 3) | (((lane >> 2) & 3) << 6) | (((lane >> 4) & 1) << 5) | (((lane >> 5) & 1) << 8); }
constexpr int v_rd_off(int d0, int ks, int half) { return d0 * 512 + ks * 4096 + half * 2048; }
template <int OFF> __device__ __forceinline__ s16x4 tr_read(int vb) {
  s16x4 r; asm volatile("ds_read_b64_tr_b16 %0, %1 offset:%2" : "=&v"(r) : "v"(vb), "i"(OFF) : "memory"); return r;
}
template <int D0> __device__ __forceinline__ void pv_one(f32x16& od, int vb, bf16x8 pa0, bf16x8 pa1, bf16x8 pa2, bf16x8 pa3) {
  const s16x4 l0 = tr_read<v_rd_off(D0, 0, 0)>(vb), h0 = tr_read<v_rd_off(D0, 0, 1)>(vb), l1 = tr_read<v_rd_off(D0, 1, 0)>(vb), h1 = tr_read<v_rd_off(D0, 1, 1)>(vb);
  const s16x4 l2 = tr_read<v_rd_off(D0, 2, 0)>(vb), h2 = tr_read<v_rd_off(D0, 2, 1)>(vb), l3 = tr_read<v_rd_off(D0, 3, 0)>(vb), h3 = tr_read<v_rd_off(D0, 3, 1)>(vb);
  asm volatile("s_waitcnt lgkmcnt(0)" ::: "memory"); SBAR();
#define PK(L, H) (bf16x8){L[0], L[1], L[2], L[3], H[0], H[1], H[2], H[3]}
  od = __builtin_amdgcn_mfma_f32_32x32x16_bf16(pa0, PK(l0, h0), od, 0, 0, 0);
  od = __builtin_amdgcn_mfma_f32_32x32x16_bf16(pa1, PK(l1, h1), od, 0, 0, 0);
  od = __builtin_amdgcn_mfma_f32_32x32x16_bf16(pa2, PK(l2, h2), od, 0, 0, 0);
  od = __builtin_amdgcn_mfma_f32_32x32x16_bf16(pa3, PK(l3, h3), od, 0, 0, 0);
#undef PK
}
__device__ __forceinline__ void pv_d0(f32x16* o, int vb, bf16x8 pa0, bf16x8 pa1, bf16x8 pa2, bf16x8 pa3) {
  pv_one<0>(o[0], vb, pa0, pa1, pa2, pa3); pv_one<1>(o[1], vb, pa0, pa1, pa2, pa3); pv_one<2>(o[2], vb, pa0, pa1, pa2, pa3); pv_one<3>(o[3], vb, pa0, pa1, pa2, pa3);
}

template <typename TQ>
__device__ __forceinline__ void attn_dense_body(const TQ* __restrict__ Qb, const bf16* __restrict__ Kh, const bf16* __restrict__ Vh,
                                                bf16* __restrict__ Ob, int seq, char* lds) {
  using St = Stage<bf16>; using SQ = Stage<TQ>;
  int tid_ = threadIdx.x; asm volatile("" : "+v"(tid_));
  const int tid = tid_, wid = tid >> 6, lane = tid & 63, r32 = lane & 31, hi = lane >> 5;
  bf16* V_lds = (bf16*)lds; bf16* K_lds = (bf16*)(lds + 2 * SHM_V);
  float* ws = (float*)(lds + 2 * SHM_V + 2 * SHM_K) + wid * 64; float* li_l = ws; float* al_l = ws + 32;
  float m_reg = -1e30f, l_reg = 0; f32x16 o[4] = {}; bf16x8 qr[8];
  const TQ* Qw = Qb + (long)(wid * QBLK + r32) * LDQ + hi * 8;
#pragma unroll
  for (int d0 = 0; d0 < 8; ++d0) qr[d0] = SQ::tobf(SQ::ld8(Qw + d0 * 16));
  const int sr = tid >> 4, sc = (tid & 15) * 8, vst0 = v_st(sr, sc), vst1 = v_st(32 + sr, sc);
  const int vb0 = (int)(uintptr_t)V_lds + v_rd_base(lane);
  struct { typename St::T vs0, vs1, ks0, ks1; } sr_[SDEPTH];
#define SLOAD(i, k0) do { sr_[i].vs0 = St::ld8(&Vh[(long)((k0) + sr) * LDK + sc]); sr_[i].vs1 = St::ld8(&Vh[(long)((k0) + 32 + sr) * LDK + sc]); \
    sr_[i].ks0 = St::ld8(&Kh[(long)((k0) + sr) * LDK + sc]); sr_[i].ks1 = St::ld8(&Kh[(long)((k0) + 32 + sr) * LDK + sc]); } while (0)
#define SWRITE(b, i) do { *(bf16x8*)((char*)V_lds + (b) * SHM_V + vst0) = St::tobf(sr_[i].vs0);          \
    *(bf16x8*)((char*)V_lds + (b) * SHM_V + vst1) = St::tobf(sr_[i].vs1); int kc = sc * 2;               \
    *(bf16x8*)((char*)K_lds + (b) * SHM_K + KSWZ(sr, kc)) = St::tobf(sr_[i].ks0);                       \
    *(bf16x8*)((char*)K_lds + (b) * SHM_K + KSWZ(32 + sr, kc)) = St::tobf(sr_[i].ks1); } while (0)
#define SWAIT() do { if constexpr (SDEPTH == 2) asm volatile("s_waitcnt vmcnt(4)" ::: "memory"); else asm volatile("s_waitcnt vmcnt(0)" ::: "memory"); } while (0)
#define RESC(a) do { if (__any((a) < 1.f)) { if (hi == 0) al_l[r32] = (a); asm volatile("s_waitcnt lgkmcnt(0)" ::: "memory"); \
    for (int d = 0; d < 4; ++d) for (int r = 0; r < 16; ++r) o[d][r] *= al_l[crow(r, hi)]; } } while (0)
  f32x16 pA0, pA1, pB0, pB1; float mnA, mnB, alA, alB; bf16x8 pa0, pa1, pa2, pa3; const int NT = seq / KVBLK;
  constexpr int SE = 0, SO = SDEPTH - 1;
  SLOAD(SE, 0); asm volatile("s_waitcnt vmcnt(0)" ::: "memory"); SWRITE(0, SE); __syncthreads();
  qkt(pA0, pA1, K_lds, qr, r32, hi); partialSM(pA0, pA1, m_reg, mnA, alA);
  SLOAD(SO, KVBLK); if constexpr (SDEPTH == 2) { if (2 < NT) SLOAD(SE, 2 * KVBLK); }
  SWAIT(); SWRITE(1, SO); __syncthreads();
  for (int j = 1; j + 1 < NT; j += 2) {
    SBAR(); qkt(pB0, pB1, (bf16*)((char*)K_lds + SHM_K), qr, r32, hi);
    finishSM(pA0, pA1, alA, l_reg, pa0, pa1, pa2, pa3); SBAR();
    SLOAD(SO, (j + SDEPTH) * KVBLK); SBAR();
    pv_d0(o, vb0, pa0, pa1, pa2, pa3); partialSM(pB0, pB1, m_reg, mnB, alB);
    __syncthreads(); SWAIT(); SWRITE(0, SE);
    RESC(alB); __syncthreads();
    SBAR(); qkt(pA0, pA1, K_lds, qr, r32, hi);
    finishSM(pB0, pB1, alB, l_reg, pa0, pa1, pa2, pa3); SBAR();
    if (SDEPTH == 1 || j + 3 < NT) SLOAD(SE, (j + 1 + SDEPTH) * KVBLK); SBAR();
    pv_d0(o, vb0 + (int)SHM_V, pa0, pa1, pa2, pa3); partialSM(pA0, pA1, m_reg, mnA, alA);
    __syncthreads(); SWAIT(); SWRITE(1, SO);
    RESC(alA); __syncthreads();
  }
  SBAR(); qkt(pB0, pB1, (bf16*)((char*)K_lds + SHM_K), qr, r32, hi);
  finishSM(pA0, pA1, alA, l_reg, pa0, pa1, pa2, pa3); SBAR();
  pv_d0(o, vb0, pa0, pa1, pa2, pa3); partialSM(pB0, pB1, m_reg, mnB, alB);
  __syncthreads(); RESC(alB);
  finishSM(pB0, pB1, alB, l_reg, pa0, pa1, pa2, pa3); SBAR();
  pv_d0(o, vb0 + (int)SHM_V, pa0, pa1, pa2, pa3);
  if (hi == 0) li_l[r32] = l_reg; asm volatile("s_waitcnt lgkmcnt(0)" ::: "memory");
  float rli[16];
#pragma unroll
  for (int r = 0; r < 16; ++r) rli[r] = __builtin_amdgcn_rcpf(li_l[crow(r, hi)]);
  bf16* Ow = Ob + (long)(wid * QBLK) * LDO;
#pragma unroll
  for (int r = 0; r < 16; ++r) { int orow = crow(r, hi);
    for (int d0 = 0; d0 < 4; ++d0) Ow[(long)orow * LDO + d0 * 32 + r32] = __float2bfloat16(o[d0][r] * rli[r]); }
#undef SLOAD
#undef SWRITE
#undef SWAIT
#undef RESC
}
}
#define GAS __attribute__((address_space(1)))
#define LAS __attribute__((address_space(3)))
typedef unsigned short bf16;
typedef unsigned v4u __attribute__((ext_vector_type(4)));
typedef float f32x4 __attribute__((ext_vector_type(4)));
typedef short bf16x8 __attribute__((ext_vector_type(8)));
typedef GAS unsigned gu32;
typedef GAS unsigned long long gu64;
#define RLX_AGENT __ATOMIC_RELAXED, __HIP_MEMORY_SCOPE_AGENT
#define LDS_WAIT() asm volatile("s_waitcnt lgkmcnt(0)" ::: "memory")
#define VM_WAIT() asm volatile("s_waitcnt vmcnt(0)" ::: "memory")
__device__ __forceinline__ unsigned long long rt() { return __builtin_amdgcn_s_memrealtime(); }
__device__ __forceinline__ unsigned f2bf(float f) { unsigned u = __builtin_bit_cast(unsigned, f); return (u + 0x7fffu + ((u >> 16) & 1u)) >> 16; }
__device__ __forceinline__ unsigned pk2(float lo, float hi) { return f2bf(lo) | (f2bf(hi) << 16); }

#define XB_TMO      128
#define XB_XCNT(j)  (256  + 64 * (j))
#define XB_XSUB(j)  (1280 + 64 * (j))
#define XB_XGEN(j)  (2304 + 64 * (j))
#define XB_TOP      3328
#define XB_TOPGEN   3392
#define XCD_BAR_WORDS 3456
#define XB_SPIN_CAP (1u << 18)

__device__ __forceinline__ unsigned xb_ld(unsigned* p)              { return __hip_atomic_load(p, __ATOMIC_RELAXED, __HIP_MEMORY_SCOPE_AGENT); }
__device__ __forceinline__ unsigned xb_add(unsigned* p, unsigned v) { return __hip_atomic_fetch_add(p, v, __ATOMIC_RELAXED, __HIP_MEMORY_SCOPE_AGENT); }
__device__ __forceinline__ unsigned xb_xcc_id() { return (unsigned)__builtin_amdgcn_s_getreg((3 << 11) | 20) & 0xFu; }
#define XB_SPIN(cond, bar) do { unsigned _sp = 0; while (cond) { __builtin_amdgcn_s_sleep(1); \
    if ((++_sp & 255u) == 0u) { if (xb_ld(&(bar)[XB_TMO])) break; if (_sp > XB_SPIN_CAP) { atomicAdd(&(bar)[XB_TMO], 1u); break; } } } } while (0)

struct XcdBarrier {
    unsigned* bar; unsigned x;
    volatile LAS unsigned* st;
};

__device__ __forceinline__ XcdBarrier xcd_barrier_post(unsigned* bar, volatile LAS unsigned* st) {
    XcdBarrier b; b.bar = bar; b.x = xb_xcc_id(); b.st = st;
    if (threadIdx.x == 0) (void)xb_add(&bar[XB_XCNT(b.x)], 1u);
    return b;
}
__device__ __forceinline__ void xcd_barrier_complete(unsigned* bar, unsigned x, unsigned& nloc, unsigned& nx) {
    const unsigned G = gridDim.x * gridDim.y * gridDim.z;
    unsigned sum, cnt, mine, sp = 0u;
    for (;;) {
        sum = 0u; cnt = 0u; mine = 0u;
#pragma unroll
        for (unsigned j = 0; j < 16; ++j) { const unsigned c = xb_ld(&bar[XB_XCNT(j)]); sum += c; cnt += (c > 0u) ? 1u : 0u; mine = (j == x) ? c : mine; }
        if (sum == G) break;
        __builtin_amdgcn_s_sleep(1);
        if ((++sp & 255u) == 0u) { if (xb_ld(&bar[XB_TMO])) break; if (sp > XB_SPIN_CAP) { atomicAdd(&bar[XB_TMO], 1u); break; } }
    }
    nloc = mine > 0u ? mine : 1u; nx = cnt > 0u ? cnt : 1u;
}

__device__ __forceinline__ void xcd_barrier(const XcdBarrier& b) {
    asm volatile("s_waitcnt vmcnt(0)" ::: "memory");
    __syncthreads();
    if (threadIdx.x == 0) {
        unsigned* bar = b.bar;
        __builtin_amdgcn_s_waitcnt(0);
        unsigned nloc = b.st[0], nx = b.st[1];
        if (nloc == 0u) { xcd_barrier_complete(bar, b.x, nloc, nx); b.st[0] = nloc; b.st[1] = nx; }
        const unsigned old = xb_add(&bar[XB_XSUB(b.x)], 1u);
        const unsigned gen = old / nloc;
        if (old + 1u == (gen + 1u) * nloc) {
            __builtin_amdgcn_fence(__ATOMIC_RELEASE, "agent");
            asm volatile("s_waitcnt vmcnt(0)" ::: "memory");
            const unsigned og = xb_add(&bar[XB_TOP], 1u);
            const unsigned tg = og / nx;
            if (og + 1u == (tg + 1u) * nx) xb_add(&bar[XB_TOPGEN], 1u);
            else XB_SPIN(xb_ld(&bar[XB_TOPGEN]) == tg, bar);
            __builtin_amdgcn_fence(__ATOMIC_ACQUIRE, "agent");
            xb_add(&bar[XB_XGEN(b.x)], 1u);
            asm volatile("s_waitcnt vmcnt(0)" ::: "memory");
        } else {
            XB_SPIN(xb_ld(&bar[XB_XGEN(b.x)]) == gen, bar);
            __builtin_amdgcn_fence(__ATOMIC_ACQUIRE, "agent");
            asm volatile("s_waitcnt vmcnt(0)" ::: "memory");
        }
    }
    __syncthreads();
}

constexpr int NWAVES = 8, NTHR = NWAVES * 64;
constexpr int BATCH = 8, SEQ = 2048, M = BATCH * SEQ, DM = 4096, NU = 10240, FF = 11008, NG = 2 * FF, HD = 128;
constexpr int AW = 1024, BW = 1024;
constexpr int UA_Q = 0, UA_FF = 1024, UA_FB = 2048, UA_I = 3072, UA_G = 4096, UB_X = 5120, UB_GATE = 6144, UC_Q = 7168, UC_K = 9216, UC_V = 9728;
constexpr float LN_EPS = 1e-5f, RMS_EPS = 1e-6f, DN_ALPHA = 1.41421356237309515f;
#ifndef MK_SINGLE
#define MK_SINGLE 1
#endif
constexpr int PH_PER_LAYER = 11, NPH = 1 + 2 * PH_PER_LAYER;

constexpr size_t MiB = 1u << 20;
constexpr size_t WS_CTL = 0, CTL_ZERO_BYTES = 1 * MiB;
constexpr size_t SZ_WIN = (size_t)NU * DM * 2, SZ_WOUT = (size_t)DM * DM * 2, SZ_WUP = (size_t)NG * DM * 2, SZ_WDN = (size_t)DM * FF * 2, SZ_WRG = (size_t)4096 * 1024 * 2;
constexpr size_t WS_WIN = 1 * MiB, WS_WOUT = WS_WIN + 2 * SZ_WIN, WS_WUP = WS_WOUT + 2 * SZ_WOUT, WS_WDN = WS_WUP + 2 * SZ_WUP, WS_WRG = WS_WDN + 2 * SZ_WDN, WS_TAB = WS_WRG + 2 * SZ_WRG;
constexpr size_t WS_GU = WS_TAB + 1 * MiB;
constexpr size_t SZ_GU = (size_t)M * NG * 2;
constexpr size_t WS_U = WS_GU;
constexpr size_t WS_R = WS_GU + 384 * MiB;
constexpr size_t WS_ACT = WS_GU + SZ_GU;
constexpr size_t SZ_ACT = (size_t)M * FF * 2;
constexpr size_t WS_XC = WS_ACT, WS_G = WS_XC + 32 * MiB, WS_HF = WS_G + 128 * MiB, WS_OF = WS_HF + 64 * MiB, WS_OB = WS_OF + 64 * MiB;
constexpr size_t WS_Y = WS_ACT + ((SZ_ACT > 352 * MiB) ? SZ_ACT : 352 * MiB);
constexpr size_t WS_HB = WS_Y + 128 * MiB;
constexpr size_t WS_END = WS_HB + 128 * MiB;
static_assert(WS_OB + 64 * MiB <= WS_Y && WS_R + 256 * MiB <= WS_ACT && WS_U + (size_t)M * NU * 2 <= WS_R, "d_ws map");
constexpr int CW_BAR = 4096;
constexpr int CW_QUEUE = 8192;

constexpr int RING_BYTES = 131072, MISC_OFF = RING_BYTES + 320, LDS_BYTES = 147456;

__device__ __forceinline__ float bf2f(bf16 b) { return __uint_as_float((unsigned)b << 16); }
__device__ __forceinline__ float sigm(float x) { return 1.f / (1.f + __expf(-x)); }
__device__ __forceinline__ float gelu_tanh(float x) { const float y = 0.7978845608028654f * (x + 0.044715f * x * x * x); const float t = 1.f - 2.f / (1.f + __expf(2.f * y)); return 0.5f * x * (1.f + t); }
__device__ __forceinline__ int fresh_tid() { int t = threadIdx.x; asm volatile("" : "+v"(t)); return t; }
__device__ __forceinline__ float wave_sum(float v) {
#pragma unroll
    for (int o = 1; o < 64; o <<= 1) v += __shfl_xor(v, o);
    return v;
}

struct Args { const float* in[24]; float* out; unsigned char* ws; int ph_lo, ph_hi, pad0, pad1; };
struct Frame {
    LAS unsigned char* lds;
    volatile LAS unsigned* MISC;
    gu32* ctl;
    int tid, lane, wave, G, gw, NGW;
    float* H;
    unsigned char* ws;
};
#define WSP(T, off) ((T*)(F.ws + (off)))

__device__ __forceinline__ void p0_transpose_item(const float* W, int K, int N, bf16* WT, LAS float* scr, int item, int lane) {
    const int nblk = N / 32, kb = item / nblk, nb = item % nblk, k0 = 64 * kb, n0 = 32 * nb;
#pragma unroll 8
    for (int i = 0; i < 32; ++i) { const int kk = 2 * i + (lane >> 5); scr[kk * 33 + (lane & 31)] = W[(size_t)(k0 + kk) * N + n0 + (lane & 31)]; }
    LDS_WAIT(); asm volatile("" ::: "memory");
    const int c = lane & 7;
#pragma unroll
    for (int j = 0; j < 4; ++j) { const int n = (lane >> 3) + 8 * j; const LAS float* s = scr + (8 * c) * 33 + n;
        v4u o; o.x = pk2(s[0 * 33], s[1 * 33]); o.y = pk2(s[2 * 33], s[3 * 33]); o.z = pk2(s[4 * 33], s[5 * 33]); o.w = pk2(s[6 * 33], s[7 * 33]);
        *(GAS v4u*)(WT + (size_t)(n0 + n) * K + k0 + 8 * c) = o; }
    LDS_WAIT(); asm volatile("" ::: "memory");
}

__device__ __forceinline__ void ln_row(const float* src, const float* w, const float* b, float* dstF, bf16* dstB, int lane) {
    const GAS f32x4* xr = (const GAS f32x4*)src + lane;
    f32x4 v[16]; float s = 0.f;
#pragma unroll
    for (int j = 0; j < 16; ++j) { v[j] = xr[64 * j]; s += (v[j].x + v[j].y) + (v[j].z + v[j].w); }
    const float mean = wave_sum(s) * (1.f / DM); float s2 = 0.f;
#pragma unroll
    for (int j = 0; j < 16; ++j) { v[j] = v[j] - mean; s2 += (v[j].x * v[j].x + v[j].y * v[j].y) + (v[j].z * v[j].z + v[j].w * v[j].w); }
    const float rstd = 1.f / sqrtf(wave_sum(s2) * (1.f / DM) + LN_EPS);
    GAS f32x4* of = (GAS f32x4*)dstF + lane; GAS unsigned long long* ob = (GAS unsigned long long*)dstB + lane;
    const GAS f32x4* wv = (const GAS f32x4*)w + lane; const GAS f32x4* bv = (const GAS f32x4*)b + lane;
#pragma unroll
    for (int j = 0; j < 16; ++j) { const f32x4 o = v[j] * rstd * wv[64 * j] + bv[64 * j]; of[64 * j] = o;
        ob[64 * j] = (unsigned long long)pk2(o.x, o.y) | ((unsigned long long)pk2(o.z, o.w) << 32); }
}
__device__ __forceinline__ void ln_phase(Frame& F, const float* src, const float* w, const float* b, float* dstF, bf16* dstB) {
    const int lane = fresh_tid() & 63;
    for (int m = F.gw; m < M; m += F.NGW) ln_row(src + (size_t)m * DM, w, b, dstF + (size_t)m * DM, dstB + (size_t)m * DM, lane);
}

__device__ __forceinline__ void p0_prologue(const Args& A, Frame& F) {
    const int ftid = fresh_tid(), flane = ftid & 63;
    LAS float* scr = (LAS float*)(F.lds + F.wave * 16384);
    const float* w_in = A.in[3]; const float* w_out = A.in[15]; const float* w_up = A.in[18]; const float* w_dn = A.in[21];
    constexpr int I_IN = (DM / 64) * (NU / 32), I_OUT = (DM / 64) * (DM / 32), I_UP = (DM / 64) * (NG / 32), I_DN = (FF / 64) * (DM / 32);
    constexpr int I_L = I_IN + I_OUT + I_UP + I_DN;
    for (int it = F.gw; it < 2 * I_L; it += F.NGW) {
        const int l = it / I_L; int r = it % I_L;
        if (r < I_IN) { p0_transpose_item(w_in + (size_t)l * DM * NU, DM, NU, WSP(bf16, WS_WIN + l * SZ_WIN), scr, r, flane); continue; } r -= I_IN;
        if (r < I_OUT) { p0_transpose_item(w_out + (size_t)l * DM * DM, DM, DM, WSP(bf16, WS_WOUT + l * SZ_WOUT), scr, r, flane); continue; } r -= I_OUT;
        if (r < I_UP) { p0_transpose_item(w_up + (size_t)l * DM * NG, DM, NG, WSP(bf16, WS_WUP + l * SZ_WUP), scr, r, flane); continue; } r -= I_UP;
        p0_transpose_item(w_dn + (size_t)l * FF * DM, FF, DM, WSP(bf16, WS_WDN + l * SZ_WDN), scr, r, flane);
    }
    const int gtid = blockIdx.x * NTHR + ftid, NT = F.G * NTHR;
    for (int it = gtid; it < 2 * 4096 * 128; it += NT) {
        const int l = it / (4096 * 128), r = it % (4096 * 128), col = r >> 7, k0 = (r & 127) * 8;
        const int gt = col >> 10, n = (col >> 7) & 7, e = col & 127, n2 = k0 >> 7, d0 = k0 & 127;
        v4u o = {0u, 0u, 0u, 0u};
        if (n2 == n) { const float* W = ((gt & 1) ? A.in[10] : A.in[8]) + ((size_t)((l * 2 + (gt >> 1)) * 8 + n)) * 16384 + e;
            float x[8];
#pragma unroll
            for (int i = 0; i < 8; ++i) x[i] = W[(d0 + i) * 128];
            o.x = pk2(x[0], x[1]); o.y = pk2(x[2], x[3]); o.z = pk2(x[4], x[5]); o.w = pk2(x[6], x[7]); }
        *(GAS v4u*)(WSP(bf16, WS_WRG + l * SZ_WRG) + (size_t)col * 1024 + k0) = o;
    }
    if (gtid < 64 * 32) {
        const int pos = gtid >> 5, j = gtid & 31;
        double invf = 1.0; for (int i = 0; i < j; ++i) invf *= 0.7498942093324559;
        const double ang = (double)pos * invf;
        const double kq = __builtin_rint(ang * 0.6366197723675814);
        const double r = (ang - kq * 1.5707963267948966) - kq * 6.123233995736766e-17, r2 = r * r;
        double sn = r * (1.0 + r2 * (-1.0 / 6 + r2 * (1.0 / 120 + r2 * (-1.0 / 5040 + r2 * (1.0 / 362880 + r2 * (-1.0 / 39916800 + r2 * (1.0 / 6227020800.0)))))));
        double cs = 1.0 + r2 * (-0.5 + r2 * (1.0 / 24 + r2 * (-1.0 / 720 + r2 * (1.0 / 40320 + r2 * (-1.0 / 3628800 + r2 * (1.0 / 479001600.0 + r2 * (-1.0 / 87178291200.0)))))));
        const int q = ((int)kq) & 3; double c, s;
        if (q == 0) { c = cs; s = sn; } else if (q == 1) { c = -sn; s = cs; } else if (q == 2) { c = -cs; s = -sn; } else { c = sn; s = -cs; }
        float* tab = WSP(float, WS_TAB); tab[2 * gtid] = (float)c; tab[2 * gtid + 1] = (float)s;
    }
    ln_phase(F, A.in[0], A.in[1], A.in[2], F.H, WSP(bf16, WS_HB));
}

__device__ __forceinline__ void prep_phase(const Args& A, Frame& F, int l) {
    const int ftid = fresh_tid(), flane = ftid & 63;
    bf16* U = WSP(bf16, WS_U); const float* tab = WSP(float, WS_TAB);
    const float* qn = A.in[13] + l * HD; const float* kn = A.in[14] + l * HD;
    const int L = flane, d1 = (L & 31) + 64 * (L >> 5), d2 = d1 + 32;
    const float wq1 = qn[d1], wq2 = qn[d2], wk1 = kn[d1], wk2 = kn[d2];
    for (int it = F.gw; it < M * 20; it += F.NGW) {
        const int m = it / 20, j = it % 20; bf16* p = U + (size_t)m * NU + UC_Q + j * HD;
        const float x1 = bf2f(p[d1]), x2 = bf2f(p[d2]);
        const float rstd = 1.f / sqrtf(wave_sum(x1 * x1 + x2 * x2) * (1.f / HD) + RMS_EPS);
        const float n1 = x1 * rstd * (j < 16 ? wq1 : wk1), n2 = x2 * rstd * (j < 16 ? wq2 : wk2);
        const int t = m & (SEQ - 1), pos = (L < 32) ? (t >> 6) : (t & 63);
        const float c = tab[2 * (pos * 32 + (L & 31))], s = tab[2 * (pos * 32 + (L & 31)) + 1];
        p[d1] = (bf16)f2bf(n1 * c - n2 * s); p[d2] = (bf16)f2bf(n2 * c + n1 * s);
    }
    const float* cw = A.in[6] + l * 4 * BW; const float* cb = A.in[7] + l * BW; bf16* XC = WSP(bf16, WS_XC);
    const int gtid = blockIdx.x * NTHR + ftid, NT = F.G * NTHR;
    for (int it = gtid; it < M * 128; it += NT) {
        const int m = it >> 7, c = (it & 127) * 8, t = m & (SEQ - 1);
        float acc[8];
#pragma unroll
        for (int i = 0; i < 8; ++i) acc[i] = cb[c + i];
#pragma unroll
        for (int k = 0; k < 4; ++k) { const int tt = t + k - 2;
            if (tt >= 0 && tt < SEQ) { const v4u xv = *(const GAS v4u*)(U + (size_t)(m + k - 2) * NU + UB_X + c); const unsigned xw[4] = {xv.x, xv.y, xv.z, xv.w};
#pragma unroll
                for (int i = 0; i < 4; ++i) { acc[2 * i] += cw[k * BW + c + 2 * i] * __uint_as_float(xw[i] << 16); acc[2 * i + 1] += cw[k * BW + c + 2 * i + 1] * __uint_as_float(xw[i] & 0xffff0000u); } } }
        v4u o; o.x = pk2(acc[0], acc[1]); o.y = pk2(acc[2], acc[3]); o.z = pk2(acc[4], acc[5]); o.w = pk2(acc[6], acc[7]);
        *(GAS v4u*)(XC + (size_t)m * BW + c) = o;
    }
}

__device__ __forceinline__ void hgrn_item(const Args& A, Frame& F, int l, int id) {
    const int dir = id & 1, h = (id >> 1) & 7, b = id >> 4, tid = fresh_tid();
    LAS float* Fs = (LAS float*)F.lds; LAS float* Qs = Fs + 2048; LAS float* Vs = Qs + 2048; LAS float* Ps = Vs + 2048; LAS float* LB = Ps + 8192;
    const bf16* U = WSP(bf16, WS_U); float* O = WSP(float, dir ? WS_OB : WS_OF);
    if (tid < 128) { float lb = 0.f;
        if (l == 1) { const float* lg = A.in[4]; const float l0 = lg[(0 * 2 + dir) * AW + h * HD + tid], l1 = lg[(1 * 2 + dir) * AW + h * HD + tid]; lb = 1.f / (1.f + expf(l0 - l1)); }
        LB[tid] = lb; }
    __syncthreads();
    const int e = tid & 127, dq = tid >> 7, sj = tid >> 5, sd = (tid & 31) * 4;
    float lb4[4];
#pragma unroll
    for (int i = 0; i < 4; ++i) lb4[i] = LB[sd + i];
    const int zc = (dir ? UA_FB : UA_FF) + h * HD + sd, qc = UA_Q + h * HD + sd, vc = UA_I + h * HD + sd;
    float s[32];
#pragma unroll
    for (int i = 0; i < 32; ++i) s[i] = 0.f;
    typedef unsigned u32x2 __attribute__((ext_vector_type(2)));
    u32x2 zr, qr, vr;
    { const int t = dir ? (SEQ - 1 - sj) : sj; const bf16* row = U + (size_t)(b * SEQ + t) * NU;
      zr = *(const GAS u32x2*)(row + zc); qr = *(const GAS u32x2*)(row + qc); vr = *(const GAS u32x2*)(row + vc); }
    for (int blk = 0; blk < SEQ / 16; ++blk) {
        { const float z0 = __uint_as_float(zr.x << 16), z1 = __uint_as_float(zr.x & 0xffff0000u), z2 = __uint_as_float(zr.y << 16), z3 = __uint_as_float(zr.y & 0xffff0000u);
          f32x4 fv; fv.x = lb4[0] + (1.f - lb4[0]) * sigm(z0); fv.y = lb4[1] + (1.f - lb4[1]) * sigm(z1); fv.z = lb4[2] + (1.f - lb4[2]) * sigm(z2); fv.w = lb4[3] + (1.f - lb4[3]) * sigm(z3);
          f32x4 qv = {__uint_as_float(qr.x << 16), __uint_as_float(qr.x & 0xffff0000u), __uint_as_float(qr.y << 16), __uint_as_float(qr.y & 0xffff0000u)};
          f32x4 vv = {__uint_as_float(vr.x << 16), __uint_as_float(vr.x & 0xffff0000u), __uint_as_float(vr.y << 16), __uint_as_float(vr.y & 0xffff0000u)};
          *(LAS f32x4*)(Fs + sj * 128 + sd) = fv; *(LAS f32x4*)(Qs + sj * 128 + sd) = qv; *(LAS f32x4*)(Vs + sj * 128 + sd) = vv; }
        if (blk + 1 < SEQ / 16) { const int st = (blk + 1) * 16 + sj, t = dir ? (SEQ - 1 - st) : st; const bf16* row = U + (size_t)(b * SEQ + t) * NU;
            zr = *(const GAS u32x2*)(row + zc); qr = *(const GAS u32x2*)(row + qc); vr = *(const GAS u32x2*)(row + vc); }
        __syncthreads();
#pragma unroll 2
        for (int j = 0; j < 16; ++j) {
            const float ve = Vs[j * 128 + e]; float acc = 0.f;
#pragma unroll
            for (int i4 = 0; i4 < 8; ++i4) { const f32x4 f4 = *(const LAS f32x4*)(Fs + j * 128 + 32 * dq + 4 * i4), q4 = *(const LAS f32x4*)(Qs + j * 128 + 32 * dq + 4 * i4);
                s[4 * i4 + 0] = fmaf(f4.x, s[4 * i4 + 0] - ve, ve); acc = fmaf(s[4 * i4 + 0], q4.x, acc);
                s[4 * i4 + 1] = fmaf(f4.y, s[4 * i4 + 1] - ve, ve); acc = fmaf(s[4 * i4 + 1], q4.y, acc);
                s[4 * i4 + 2] = fmaf(f4.z, s[4 * i4 + 2] - ve, ve); acc = fmaf(s[4 * i4 + 2], q4.z, acc);
                s[4 * i4 + 3] = fmaf(f4.w, s[4 * i4 + 3] - ve, ve); acc = fmaf(s[4 * i4 + 3], q4.w, acc); }
            Ps[(j * 4 + dq) * 128 + e] = acc;
        }
        __syncthreads();
        { const f32x4 r = (*(const LAS f32x4*)(Ps + (sj * 4 + 0) * 128 + sd) + *(const LAS f32x4*)(Ps + (sj * 4 + 1) * 128 + sd)) + (*(const LAS f32x4*)(Ps + (sj * 4 + 2) * 128 + sd) + *(const LAS f32x4*)(Ps + (sj * 4 + 3) * 128 + sd));
          const int st = blk * 16 + sj, t = dir ? (SEQ - 1 - st) : st;
          *(GAS f32x4*)(O + (size_t)(b * SEQ + t) * AW + h * HD + sd) = r; }
    }
}

__device__ __forceinline__ void hgrn_final_phase(const Args& A, Frame& F, int l) {
    const int ftid = fresh_tid(), flane = ftid & 63;
    const float* OFp = WSP(float, WS_OF); const float* OBp = WSP(float, WS_OB); const bf16* U = WSP(bf16, WS_U); bf16* Y = WSP(bf16, WS_Y);
    const float* nw = A.in[5] + l * AW; typedef float f32x2 __attribute__((ext_vector_type(2)));
    for (int it = F.gw; it < M * 8; it += F.NGW) {
        const int m = it >> 3, h = it & 7, c = h * HD + 2 * flane;
        const f32x2 a = *(const GAS f32x2*)(OFp + (size_t)m * AW + c), bq = *(const GAS f32x2*)(OBp + (size_t)m * AW + c);
        const float o0 = a.x + bq.x, o1 = a.y + bq.y;
        const float rstd = 1.f / sqrtf(wave_sum(o0 * o0 + o1 * o1) * (1.f / HD) + RMS_EPS);
        const unsigned gw2 = *(const GAS unsigned*)(U + (size_t)m * NU + UA_G + c);
        const float g0 = __uint_as_float(gw2 << 16), g1 = __uint_as_float(gw2 & 0xffff0000u);
        const float y0 = o0 * rstd * nw[c] * (g0 * sigm(g0)), y1 = o1 * rstd * nw[c + 1] * (g1 * sigm(g1));
        *(GAS unsigned*)(Y + (size_t)m * DM + c) = pk2(y0, y1);
    }
}

__device__ __forceinline__ void rg_item(const Args& A, Frame& F, int l, int id) {
    const int lane = fresh_tid() & 63; const int b = id >> 4, c = (id & 15) * 64 + lane, w = F.wave;
    const bf16* G = WSP(bf16, WS_G); const bf16* XC = WSP(bf16, WS_XC); const bf16* U = WSP(bf16, WS_U); float* HF = WSP(float, WS_HF); bf16* Y = WSP(bf16, WS_Y);
    const float baf = A.in[9][(l * 2 + 0) * BW + c], bab = A.in[9][(l * 2 + 1) * BW + c], bxf = A.in[11][(l * 2 + 0) * BW + c], bxb = A.in[11][(l * 2 + 1) * BW + c];
    const float spf = -8.f * log1pf(expf(-A.in[12][(l * 2 + 0) * BW + c])), spb = -8.f * log1pf(expf(-A.in[12][(l * 2 + 1) * BW + c]));
    LAS float* X = (LAS float*)F.lds;
    const int m0 = b * SEQ + w * 256;
#define RG_GATE(m, off, bias_a, bias_x, sp, a_out, bt_out) do { const bf16* g_ = G + (size_t)(m) * 4096 + (off) + c; const float la_ = (sp) * sigm(bf2f(g_[0]) + (bias_a)); \
        a_out = __expf(la_); bt_out = sqrtf(-expm1f(2.f * la_)) * sigm(bf2f(g_[1024]) + (bias_x)) * bf2f(XC[(size_t)(m) * BW + c]); } while (0)
    float Hf = 0.f, Af = 1.f, Hb = 0.f, Pb = 1.f;
#pragma unroll 4
    for (int t = 0; t < 256; ++t) { float af, btf, ab, btb; RG_GATE(m0 + t, 0, baf, bxf, spf, af, btf); RG_GATE(m0 + t, 2048, bab, bxb, spb, ab, btb);
        Hf = af * Hf + btf; Af *= af; Hb += Pb * btb; Pb *= ab; }
    X[(w * 4 + 0) * 64 + lane] = Af; X[(w * 4 + 1) * 64 + lane] = Hf; X[(w * 4 + 2) * 64 + lane] = Pb; X[(w * 4 + 3) * 64 + lane] = Hb;
    __syncthreads();
    float cf = 0.f, cbk = 0.f;
    for (int w2 = 0; w2 < w; ++w2) cf = X[(w2 * 4 + 0) * 64 + lane] * cf + X[(w2 * 4 + 1) * 64 + lane];
    for (int w2 = 7; w2 > w; --w2) cbk = X[(w2 * 4 + 2) * 64 + lane] * cbk + X[(w2 * 4 + 3) * 64 + lane];
    float hs = cf;
#pragma unroll 4
    for (int t = 0; t < 256; ++t) { float af, btf; RG_GATE(m0 + t, 0, baf, bxf, spf, af, btf); hs = af * hs + btf; HF[(size_t)(m0 + t) * BW + c] = hs; }
    hs = cbk;
#pragma unroll 4
    for (int t = 255; t >= 0; --t) { float ab, btb; RG_GATE(m0 + t, 2048, bab, bxb, spb, ab, btb); hs = ab * hs + btb;
        const float gt = bf2f(U[(size_t)(m0 + t) * NU + UB_GATE + c]);
        Y[(size_t)(m0 + t) * DM + AW + c] = (bf16)f2bf(gelu_tanh(gt) * (HF[(size_t)(m0 + t) * BW + c] + hs)); }
#undef RG_GATE
}

constexpr int Q_HGRN = 128, Q_RG = 128, Q_ATT = BATCH * 16 * (SEQ / 256), Q_ALL = Q_HGRN + Q_RG + Q_ATT;
__device__ __forceinline__ void mixer_phase(const Args& A, Frame& F, int l, char* lds_generic) {
#ifndef MIX_DIS
#define MIX_DIS 0
#endif
    for (;;) {
        __syncthreads();
        if (F.tid == 0) F.MISC[0] = __hip_atomic_fetch_add(F.ctl + CW_QUEUE + 128 * l, 1u, RLX_AGENT);
        __syncthreads();
        const int id = (int)F.MISC[0];
        if (id >= Q_HGRN + Q_RG) break;
        if (id < Q_HGRN) { if (!(MIX_DIS & 1)) hgrn_item(A, F, l, id); }
        else { if (!(MIX_DIS & 2)) rg_item(A, F, l, id - Q_HGRN); }
    }
    const attn::bf16* U = (const attn::bf16*)WSP(bf16, WS_U); attn::bf16* Y = (attn::bf16*)WSP(bf16, WS_Y);
    for (;;) {
        __syncthreads();
        if (F.tid == 0) F.MISC[0] = __hip_atomic_fetch_add(F.ctl + CW_QUEUE + 128 * l + 64, 1u, RLX_AGENT);
        __syncthreads();
        const int a = (int)F.MISC[0];
        if (a >= Q_ATT) break;
        if (!(MIX_DIS & 4)) { const int qb = a & 7, h = (a >> 3) & 15, b = a >> 7;
            const size_t r0 = (size_t)b * SEQ;
            attn::attn_dense_body<attn::bf16>(U + (r0 + qb * 256) * NU + UC_Q + h * HD, U + r0 * NU + UC_K + (h >> 2) * HD, U + r0 * NU + UC_V + (h >> 2) * HD,
                                              Y + (r0 + qb * 256) * DM + AW + BW + h * HD, SEQ, lds_generic); }
    }
}

__device__ __forceinline__ void act_phase(const Args& A, Frame& F, int l) {
    const int ftid = fresh_tid(), flane = ftid & 63;
    const bf16* GU = WSP(bf16, WS_GU); bf16* ACT = WSP(bf16, WS_ACT);
    const float* cw = A.in[19] + (size_t)l * 3 * FF; const float* cb = A.in[20] + (size_t)l * FF;
    const int gtid = blockIdx.x * NTHR + ftid, NT = F.G * NTHR; constexpr int C8 = FF / 8;
    for (long it = gtid; it < (long)M * C8; it += NT) {
        const int m = (int)(it / C8), c = (int)(it % C8) * 8, t = m & (SEQ - 1);
        float acc[8];
#pragma unroll
        for (int i = 0; i < 8; ++i) acc[i] = cb[c + i];
#pragma unroll
        for (int k = 0; k < 3; ++k) { const int tt = t + k - 1;
            if (tt >= 0 && tt < SEQ) { const v4u xv = *(const GAS v4u*)(GU + (size_t)(m + k - 1) * NG + c); const unsigned xw[4] = {xv.x, xv.y, xv.z, xv.w};
#pragma unroll
                for (int i = 0; i < 4; ++i) { acc[2 * i] += cw[(size_t)k * FF + c + 2 * i] * __uint_as_float(xw[i] << 16); acc[2 * i + 1] += cw[(size_t)k * FF + c + 2 * i + 1] * __uint_as_float(xw[i] & 0xffff0000u); } } }
        const v4u uv = *(const GAS v4u*)(GU + (size_t)m * NG + FF + c); const unsigned uw[4] = {uv.x, uv.y, uv.z, uv.w};
        float o[8];
#pragma unroll
        for (int i = 0; i < 4; ++i) { o[2 * i] = acc[2 * i] * sigm(acc[2 * i]) * __uint_as_float(uw[i] << 16); o[2 * i + 1] = acc[2 * i + 1] * sigm(acc[2 * i + 1]) * __uint_as_float(uw[i] & 0xffff0000u); }
        v4u ov; ov.x = pk2(o[0], o[1]); ov.y = pk2(o[2], o[3]); ov.z = pk2(o[4], o[5]); ov.w = pk2(o[6], o[7]);
        *(GAS v4u*)(ACT + (size_t)m * FF + c) = ov;
    }
}

__global__ void __launch_bounds__(NTHR, 2) fwd_kernel(Args args) {
    extern __shared__ __attribute__((aligned(16))) unsigned char lds[];
    Frame F;
    F.lds = (LAS unsigned char*)lds;
    F.MISC = (volatile LAS unsigned*)(F.lds + MISC_OFF);
    F.tid = threadIdx.x; F.lane = F.tid & 63; F.wave = __builtin_amdgcn_readfirstlane(F.tid >> 6);
    F.G = gridDim.x; F.gw = blockIdx.x * NWAVES + F.wave; F.NGW = F.G * NWAVES;
    F.ws = args.ws; F.ctl = (gu32*)(args.ws + WS_CTL); F.H = args.out;
    for (int u = F.tid; u < (LDS_BYTES - RING_BYTES) / 4; u += NTHR) ((LAS unsigned*)(F.lds + RING_BYTES))[u] = 0u;
    __syncthreads();
    const int lo = args.ph_lo, hi = args.ph_hi;
    XcdBarrier bar; bar.bar = (unsigned*)(F.ctl + CW_BAR); bar.x = 0; bar.st = nullptr;
    if (hi - lo > 1) bar = xcd_barrier_post((unsigned*)(F.ctl + CW_BAR), F.MISC + 8);
#ifndef DIS
#define DIS 0
#endif
#define EN(j) (!((DIS >> (j)) & 1))
#define IN(k) (lo <= (k) && (k) < hi)
#define SEAM(k) do { if (IN(k) && IN((k) + 1)) xcd_barrier(bar); } while (0)
    LAS unsigned char* ring = F.lds;

    if (EN(0) && IN(0)) { p0_prologue(args, F); } SEAM(0);

    for (int l = 0; l < 2; ++l) {
        const int pb = 1 + PH_PER_LAYER * l;
        bf16* HB = WSP(bf16, WS_HB); bf16* U = WSP(bf16, WS_U); bf16* Y = WSP(bf16, WS_Y); float* R = WSP(float, WS_R);
        if (EN(1) && IN(pb + 0)) { pg8::Gemm g{HB, WSP(bf16, WS_WIN + l * SZ_WIN), M, NU, DM}; pg8::StaticOrder S; S.init(M, NU, F.G, (int)blockIdx.x);
            pg8::EpiBf16<0> E{U, NU, nullptr, 0, 0, 1.f};
            pg8::gemm_phase<pg8::EpiBf16<0>, pg8::StaticOrder, true, true>(ring, g, S, E); } SEAM(pb + 0);
        if (EN(2) && IN(pb + 1)) { prep_phase(args, F, l); } SEAM(pb + 1);
        if (EN(3) && IN(pb + 2)) { pg8::Gemm g{WSP(bf16, WS_XC), WSP(bf16, WS_WRG + l * SZ_WRG), M, 4096, 1024}; pg8::StaticOrder S; S.init(M, 4096, F.G, (int)blockIdx.x);
            pg8::EpiBf16<0> E{WSP(bf16, WS_G), 4096, nullptr, 0, 0, 1.f};
            pg8::gemm_phase<pg8::EpiBf16<0>, pg8::StaticOrder, true, true>(ring, g, S, E); } SEAM(pb + 2);
        if (EN(4) && IN(pb + 3)) { mixer_phase(args, F, l, (char*)lds); } SEAM(pb + 3);
        if (EN(5) && IN(pb + 4)) { hgrn_final_phase(args, F, l); } SEAM(pb + 4);
        if (EN(6) && IN(pb + 5)) { pg8::Gemm g{Y, WSP(bf16, WS_WOUT + l * SZ_WOUT), M, DM, DM}; pg8::StaticOrder S; S.init(M, DM, F.G, (int)blockIdx.x);
            pg8::EpiResF32 E{F.H, R, DM, DN_ALPHA};
            pg8::gemm_phase<pg8::EpiResF32, pg8::StaticOrder, true, true>(ring, g, S, E); } SEAM(pb + 5);
        if (EN(7) && IN(pb + 6)) { ln_phase(F, R, args.in[16] + l * DM, args.in[17] + l * DM, F.H, HB); } SEAM(pb + 6);
        if (EN(8) && IN(pb + 7)) { pg8::Gemm g{HB, WSP(bf16, WS_WUP + l * SZ_WUP), M, NG, DM}; pg8::StaticOrder S; S.init(M, NG, F.G, (int)blockIdx.x);
            pg8::EpiBf16<0> E{WSP(bf16, WS_GU), NG, nullptr, 0, 0, 1.f};
            pg8::gemm_phase<pg8::EpiBf16<0>, pg8::StaticOrder, true, true>(ring, g, S, E); } SEAM(pb + 7);
        if (EN(9) && IN(pb + 8)) { act_phase(args, F, l); } SEAM(pb + 8);
        if (EN(10) && IN(pb + 9)) { pg8::Gemm g{WSP(bf16, WS_ACT), WSP(bf16, WS_WDN + l * SZ_WDN), M, DM, FF}; pg8::StaticOrder S; S.init(M, DM, F.G, (int)blockIdx.x);
            pg8::EpiResF32 E{F.H, R, DM, DN_ALPHA};
            pg8::gemm_phase<pg8::EpiResF32, pg8::StaticOrder, true, true>(ring, g, S, E); } SEAM(pb + 9);
        if (EN(11) && IN(pb + 10)) { ln_phase(F, R, args.in[22] + l * DM, args.in[23] + l * DM, F.H, HB); } SEAM(pb + 10);
    }
#undef IN
#undef SEAM
}

extern "C" void kernel_launch(void* const* d_in, const int* in_sizes, int n_in, void* d_out, int out_size, void* d_ws, size_t ws_size, hipStream_t stream) {
    static int grid = 0;
    if (grid == 0) {
        if (n_in != 24 || in_sizes[0] != M * DM || out_size != M * DM || ws_size < WS_END) { fprintf(stderr, "kernel_launch: unexpected shapes: n_in %d in0 %d out %d ws %zu (need %zu)\n", n_in, n_in > 0 ? in_sizes[0] : -1, out_size, ws_size, (size_t)WS_END); grid = -1; return; }
        int dev = 0, cus = 0, per_cu = 0;
        if (hipGetDevice(&dev) != hipSuccess || hipDeviceGetAttribute(&cus, hipDeviceAttributeMultiprocessorCount, dev) != hipSuccess) { grid = -1; return; }
        if (hipFuncSetAttribute((const void*)fwd_kernel, hipFuncAttributeMaxDynamicSharedMemorySize, LDS_BYTES) != hipSuccess) { fprintf(stderr, "kernel_launch: hipFuncSetAttribute failed\n"); grid = -1; return; }
        if (hipOccupancyMaxActiveBlocksPerMultiprocessor(&per_cu, (const void*)fwd_kernel, NTHR, LDS_BYTES) != hipSuccess || per_cu < 1) fprintf(stderr, "kernel_launch: occupancy query reports %d\n", per_cu);
        (void)hipGetLastError();
        grid = cus;
    }
    if (grid < 0) return;
    if (hipMemsetAsync((char*)d_ws + WS_CTL, 0, CTL_ZERO_BYTES, stream) != hipSuccess) return;
    Args a{};
    for (int i = 0; i < 24; ++i) a.in[i] = (const float*)d_in[i];
    a.out = (float*)d_out; a.ws = (unsigned char*)d_ws;
#if MK_SINGLE
    a.ph_lo = 0; a.ph_hi = NPH;
    hipLaunchKernelGGL(fwd_kernel, dim3(grid), dim3(NTHR), LDS_BYTES, stream, a);
#else
    for (int p = 0; p < NPH; ++p) { a.ph_lo = p; a.ph_hi = p + 1; hipLaunchKernelGGL(fwd_kernel, dim3(grid), dim3(NTHR), LDS_BYTES, stream, a); }
#endif
    const hipError_t le = hipPeekAtLastError();
    if (le != hipSuccess) fprintf(stderr, "kernel_launch: launch failed: %s\n", hipGetErrorName(le));
}
```

```cpp
#include <hip/hip_runtime.h>
#include <hip/hip_bf16.h>
#include <cstdio>
#include <cstdint>
#define MK_SINGLE 1
namespace pg8 {
#define PG8_LAS __attribute__((address_space(3)))
typedef unsigned short bf16_t;
typedef short bf16x8 __attribute__((ext_vector_type(8)));
typedef float f32x4 __attribute__((ext_vector_type(4)));
typedef unsigned u32x4 __attribute__((ext_vector_type(4)));
constexpr int BM = 256, BK = 64, HALF = 128, HTB = HALF * BK * 2  , STAGE_BYTES = 8 * HTB, NXCD = 8, WGM = 8;

__host__ __device__ __forceinline__ int lds_byte(int r, int c) { const int st = (r >> 4) * 2 + (c >> 5), rr = r & 15, cc = c & 31, ob = rr * 64 + cc * 2; return st * 1024 + (ob ^ (((ob >> 9) & 1) << 5)); }
__host__ __device__ __forceinline__ void stage_rc(int b, int& R, int& C) { const int st = b / 1024, sb = b % 1024, swz = sb ^ (((sb >> 9) & 1) << 5); R = (st >> 1) * 16 + swz / 64; C = (st & 1) * 32 + (swz % 64) / 2; }
__host__ __device__ __forceinline__ int perm32(int rho) { const int n = rho >> 4, i = rho & 15; return 8 * (i >> 2) + 4 * n + (i & 3); }

struct Unit { int pm, pn; };
struct Gemm { const bf16_t* A; const bf16_t* Bt; int M, N, K; int a_rstep, lda, kwin; };

struct StaticOrder {
    int nM, nN, nwg, G, c;
    __host__ __device__ void init(int M, int N, int G_, int c_) { nM = M / BM; nN = N / BM; nwg = nM * nN; G = G_; c = c_; }
    __host__ __device__ bool next(int i, Unit& u) const {
        const long L = (long)i * G + c; if (L >= nwg) return false;
        int wgid = (int)L; { const int q = nwg / NXCD, r = nwg % NXCD, xcd = wgid % NXCD, off = wgid / NXCD; wgid = (xcd < r ? xcd * (q + 1) : r * (q + 1) + (xcd - r) * q) + off; }
        const int nig = WGM * nN, gid = wgid / nig, fm = gid * WGM, gsz = (nM - fm) < WGM ? (nM - fm) : WGM;
        u.pm = fm + ((wgid % nig) % gsz); u.pn = (wgid % nig) / gsz; return true;
    }
    __device__ __forceinline__ void a_ready(const Unit&) const {}
    __device__ __forceinline__ void done(const Unit&) const {}
};

__device__ __forceinline__ unsigned cvt_pk_bf16(float lo, float hi) { unsigned r; asm volatile("v_cvt_pk_bf16_f32 %0, %1, %2" : "=v"(r) : "v"(lo), "v"(hi)); return r; }
typedef float f32x2 __attribute__((ext_vector_type(2)));
__device__ __forceinline__ f32x2 gelu_pk(f32x2 v) {
    const f32x2 av = __builtin_elementwise_abs(v), d = av * 0.2316418882f + 1.0f;
    f32x2 t; t.x = __builtin_amdgcn_rcpf(d.x); t.y = __builtin_amdgcn_rcpf(d.y);
    f32x2 q = t * 0.5307027145f + (-0.7265760135f); q = q * t + 0.7107068705f; q = q * t + (-0.142248368f); q = q * t + 0.127414796f; q = q * t;
    const f32x2 s = (v * v) * (-0.72134752044f);
    f32x2 e; e.x = __builtin_amdgcn_exp2f(s.x); e.y = __builtin_amdgcn_exp2f(s.y);
    const f32x2 m = v * (q * e), r = v - m;
    f32x2 o; o.x = v.x < 0.f ? m.x : r.x; o.y = v.y < 0.f ? m.y : r.y; return o;
}

template <int ACT  > struct EpiBf16 {
    static constexpr bool PERM = true, AFTER_DRAIN = false; static_assert(ACT == 0 || ACT == 1, "EpiBf16: ACT is 0 (none) or 1 (gelu_pk)");
    bf16_t* O; int ldc; const float* bias; int split_cols; size_t split_stride; float scale0;
    __device__ __forceinline__ void operator()(const f32x4 (&acc)[2][2][4][2], const Unit& u, int wr, int wc, int fr, int fq) const {
        const int row0 = u.pm * BM + wr * 64 + fr; int colt = u.pn * BM; bf16_t* base = O;
        float sc = 1.f; if (split_cols) { const int t = colt / split_cols; base += (size_t)t * split_stride; colt -= t * split_cols; if (t == 0) sc = scale0; }
        const int col0 = colt + wc * 32 + 8 * fq, bcol0 = u.pn * BM + wc * 32 + 8 * fq;
        f32x4 bv[2][2];
#pragma unroll
        for (int bj = 0; bj < 2; ++bj)
#pragma unroll
            for (int n = 0; n < 2; ++n) bv[bj][n] = bias ? *(const f32x4*)(bias + bcol0 + bj * HALF + 4 * n) : (f32x4){0.f, 0.f, 0.f, 0.f};
#pragma unroll
        for (int ai = 0; ai < 2; ++ai)
#pragma unroll
            for (int m = 0; m < 4; ++m) { bf16_t* rowp = base + (size_t)(row0 + ai * HALF + m * 16) * ldc + col0;
#pragma unroll
                for (int bj = 0; bj < 2; ++bj) { f32x4 v0 = acc[ai][bj][m][0] + bv[bj][0], v1 = acc[ai][bj][m][1] + bv[bj][1];
                    if (ACT == 1) { f32x2 a = gelu_pk((f32x2){v0[0], v0[1]}), b = gelu_pk((f32x2){v0[2], v0[3]}), c = gelu_pk((f32x2){v1[0], v1[1]}), d = gelu_pk((f32x2){v1[2], v1[3]});
                        v0 = (f32x4){a.x, a.y, b.x, b.y}; v1 = (f32x4){c.x, c.y, d.x, d.y}; }
                    v0 = v0 * sc; v1 = v1 * sc; u32x4 w; w.x = cvt_pk_bf16(v0[0], v0[1]); w.y = cvt_pk_bf16(v0[2], v0[3]); w.z = cvt_pk_bf16(v1[0], v1[1]); w.w = cvt_pk_bf16(v1[2], v1[3]);
                    *(u32x4*)(rowp + bj * HALF) = w; } }
    }
};
struct EpiResF32 {
    static constexpr bool PERM = false, AFTER_DRAIN = false;
    const float* base; float* C; int ldc; float alpha;
    __device__ __forceinline__ void operator()(const f32x4 (&acc)[2][2][4][2], const Unit& u, int wr, int wc, int fr, int fq) const {
        const int row0 = u.pm * BM + wr * 64 + fr, col0 = u.pn * BM + wc * 32 + 4 * fq;
#pragma unroll
        for (int ai = 0; ai < 2; ++ai)
#pragma unroll
            for (int m = 0; m < 4; ++m) { const size_t off = (size_t)(row0 + ai * HALF + m * 16) * ldc + col0;
#pragma unroll
                for (int bj = 0; bj < 2; ++bj)
#pragma unroll
                    for (int n = 0; n < 2; ++n) { const f32x4 bs = *(const f32x4*)(base + off + bj * HALF + n * 16);
                        *(f32x4*)(C + off + bj * HALF + n * 16) = acc[ai][bj][m][n] + alpha * bs; } }
    }
};
struct EpiConvGlu {
    static constexpr bool PERM = true, AFTER_DRAIN = false;
    bf16_t* ACT; int ldo; const float* cw; const float* cb; PG8_LAS float* xch; int seq, mtok;
    __device__ __forceinline__ void operator()(const f32x4 (&acc)[2][2][4][2], const Unit& u, int wr, int wc, int fr, int fq) const {
        const int lane = fq * 16 + fr, cl = wc * 32 + 8 * fq;
#pragma unroll
        for (int ai = 0; ai < 2; ++ai)
#pragma unroll
            for (int n = 0; n < 2; ++n) {
                if (fr == 0)  *(PG8_LAS f32x4*)(xch + ((ai * 2 + wr) * 2 + 0) * 128 + cl + 4 * n) = acc[ai][0][0][n];
                if (fr == 15) *(PG8_LAS f32x4*)(xch + ((ai * 2 + wr) * 2 + 1) * 128 + cl + 4 * n) = acc[ai][0][3][n]; }
        asm volatile("s_waitcnt lgkmcnt(0)" ::: "memory"); __builtin_amdgcn_s_barrier(); asm volatile("" ::: "memory");
        const int ch0 = u.pn * 128 + cl;
        f32x4 w0[2], w1[2], w2[2], bb[2];
#pragma unroll
        for (int n = 0; n < 2; ++n) { w0[n] = *(const f32x4*)(cw + ch0 + 4 * n); w1[n] = *(const f32x4*)(cw + ldo + ch0 + 4 * n); w2[n] = *(const f32x4*)(cw + 2 * ldo + ch0 + 4 * n); bb[n] = *(const f32x4*)(cb + ch0 + 4 * n); }
        const int srcU = fr > 0 ? lane - 1 : lane + 15, srcD = fr < 15 ? lane + 1 : lane - 15;
#pragma unroll
        for (int ai = 0; ai < 2; ++ai)
#pragma unroll
            for (int m = 0; m < 4; ++m) {
                const int r = ai * HALF + wr * 64 + m * 16 + fr, tok = 254 * u.pm - 1 + r, t = tok & (seq - 1);
                unsigned ow[4];
#pragma unroll
                for (int n = 0; n < 2; ++n) {
                    const f32x4 g = acc[ai][0][m][n], gm = acc[ai][0][m > 0 ? m - 1 : 0][n], gp = acc[ai][0][m < 3 ? m + 1 : 3][n];
                    const f32x4 sU = (fr == 15) ? gm : g, sD = (fr == 0) ? gp : g;
                    f32x4 up, dn;
#pragma unroll
                    for (int j = 0; j < 4; ++j) { up[j] = __shfl(sU[j], srcU, 64); dn[j] = __shfl(sD[j], srcD, 64); }
                    if (m == 0) { const int pa = wr ? ai : ai - 1, pw = wr ^ 1;
                        if (pa >= 0) { const f32x4 e = *(const PG8_LAS f32x4*)(xch + ((pa * 2 + pw) * 2 + 1) * 128 + cl + 4 * n); if (fr == 0) up = e; } }
                    if (m == 3) { const int pa = wr ? ai + 1 : ai, pw = wr ^ 1;
                        if (pa <= 1) { const f32x4 e = *(const PG8_LAS f32x4*)(xch + ((pa * 2 + pw) * 2 + 0) * 128 + cl + 4 * n); if (fr == 15) dn = e; } }
                    if (t == 0) up = (f32x4){0.f, 0.f, 0.f, 0.f};
                    if (t == seq - 1) dn = (f32x4){0.f, 0.f, 0.f, 0.f};
                    const f32x4 cv = bb[n] + w0[n] * up + w1[n] * g + w2[n] * dn, uu = acc[ai][1][m][n];
                    float o[4];
#pragma unroll
                    for (int j = 0; j < 4; ++j) o[j] = cv[j] * __builtin_amdgcn_rcpf(1.f + __expf(-cv[j])) * uu[j];
                    ow[2 * n] = cvt_pk_bf16(o[0], o[1]); ow[2 * n + 1] = cvt_pk_bf16(o[2], o[3]); }
                if (r >= 1 && r <= 254 && tok < mtok) *(u32x4*)(ACT + (size_t)tok * ldo + ch0) = (u32x4){ow[0], ow[1], ow[2], ow[3]};
            }
    }
};
struct EpiResLazy {
    static constexpr bool PERM = false, AFTER_DRAIN = false;
    const float* Rp; const float* st; const float* w; const float* b; float* C; int ldc; float alpha;
    __device__ __forceinline__ void operator()(const f32x4 (&acc)[2][2][4][2], const Unit& u, int wr, int wc, int fr, int fq) const {
        typedef float f32x2v __attribute__((ext_vector_type(2)));
        const int row0 = u.pm * BM + wr * 64 + fr, col0 = u.pn * BM + wc * 32 + 4 * fq;
        f32x4 wv[2][2], bv[2][2];
#pragma unroll
        for (int bj = 0; bj < 2; ++bj)
#pragma unroll
            for (int n = 0; n < 2; ++n) { wv[bj][n] = *(const f32x4*)(w + col0 + bj * HALF + n * 16) * alpha; bv[bj][n] = *(const f32x4*)(b + col0 + bj * HALF + n * 16) * alpha; }
#pragma unroll
        for (int ai = 0; ai < 2; ++ai)
#pragma unroll
            for (int m = 0; m < 4; ++m) { const int row = row0 + ai * HALF + m * 16; const size_t off = (size_t)row * ldc + col0; const f32x2v s = *(const f32x2v*)(st + 2 * row);
#pragma unroll
                for (int bj = 0; bj < 2; ++bj)
#pragma unroll
                    for (int n = 0; n < 2; ++n) { const f32x4 rp = *(const f32x4*)(Rp + off + bj * HALF + n * 16);
                        *(f32x4*)(C + off + bj * HALF + n * 16) = acc[ai][bj][m][n] + ((rp - s.x) * s.y) * wv[bj][n] + bv[bj][n]; } }
    }
};

template <bool RPF32> struct EpiResBf {
    static constexpr bool PERM = true, AFTER_DRAIN = false;
    static constexpr int ldc = 4096; static constexpr float alpha = 1.41421356237309515f;
    const float* RpF; const float* st; const float* w; const float* b; bf16_t* RB;
    __device__ __forceinline__ void operator()(const f32x4 (&acc)[2][2][4][2], const Unit& u, int wr, int wc, int fr, int fq) const {
        typedef float f32x2v __attribute__((ext_vector_type(2)));
        const int row0 = u.pm * BM + wr * 64 + fr, col0 = u.pn * BM + wc * 32 + 8 * fq;
        f32x4 wv[2][2], bv[2][2];
#pragma unroll
        for (int bj = 0; bj < 2; ++bj)
#pragma unroll
            for (int n = 0; n < 2; ++n) { wv[bj][n] = *(const f32x4*)(w + col0 + bj * HALF + 4 * n) * alpha; bv[bj][n] = *(const f32x4*)(b + col0 + bj * HALF + 4 * n) * alpha; }
#pragma unroll
        for (int ai = 0; ai < 2; ++ai)
#pragma unroll
            for (int m = 0; m < 4; ++m) { const int row = row0 + ai * HALF + m * 16; const size_t off = (size_t)row * ldc + col0; const f32x2v s = *(const f32x2v*)(st + 2 * row);
#pragma unroll
                for (int bj = 0; bj < 2; ++bj) { f32x4 r0, r1;
                    if constexpr (RPF32) { r0 = *(const f32x4*)(RpF + off + bj * HALF); r1 = *(const f32x4*)(RpF + off + bj * HALF + 4); }
                    else { const u32x4 pw = *(const u32x4*)(RB + off + bj * HALF);
                        r0 = (f32x4){__uint_as_float(pw.x << 16), __uint_as_float(pw.x & 0xffff0000u), __uint_as_float(pw.y << 16), __uint_as_float(pw.y & 0xffff0000u)};
                        r1 = (f32x4){__uint_as_float(pw.z << 16), __uint_as_float(pw.z & 0xffff0000u), __uint_as_float(pw.w << 16), __uint_as_float(pw.w & 0xffff0000u)}; }
                    const f32x4 v0 = acc[ai][bj][m][0] + ((r0 - s.x) * s.y) * wv[bj][0] + bv[bj][0], v1 = acc[ai][bj][m][1] + ((r1 - s.x) * s.y) * wv[bj][1] + bv[bj][1];
                    u32x4 wd; wd.x = cvt_pk_bf16(v0[0], v0[1]); wd.y = cvt_pk_bf16(v0[2], v0[3]); wd.z = cvt_pk_bf16(v1[0], v1[1]); wd.w = cvt_pk_bf16(v1[2], v1[3]);
                    *(u32x4*)(RB + off + bj * HALF) = wd; } }
    }
};
template <class Epi, class Sched, bool ALIGN_EPI = false, bool SP2 = false>
__device__ __forceinline__ void gemm_phase(PG8_LAS unsigned char* lds, const Gemm g, const Sched& S, const Epi& E) {
    int tid_ = threadIdx.x; asm volatile("" : "+v"(tid_));
    const int tid = tid_, wid = __builtin_amdgcn_readfirstlane(tid >> 6), lane = tid & 63, wr = wid >> 2, wc = wid & 3, fr = lane & 15, fq = lane >> 4;
    const int K = g.K, nt = K / BK, lda = g.lda ? g.lda : g.K;
    unsigned voffA[2], voffB[2];
#pragma unroll
    for (int i = 0; i < 2; ++i) { int R, C; stage_rc(tid * 16 + i * 8192, R, C); const int Rb = Epi::PERM ? ((R & ~31) + perm32(R & 31)) : R;
        voffA[i] = (unsigned)(R * lda + C) * 2u; voffB[i] = (unsigned)(Rb * K + C) * 2u; }
    const size_t kstep = (size_t)(BK * 2);
    const size_t hstep = (size_t)HALF * K * 2;
    const size_t hstepA = (size_t)HALF * lda * 2;
    const size_t tstep = 2 * hstep;
    const size_t tstepA = (size_t)(g.a_rstep ? g.a_rstep : BM) * lda * 2;
    const unsigned ldsw = (unsigned)wid * 1024u;
    const int aoff = lds_byte(wr * 64 + fr, fq * 8), boff = lds_byte(wc * 32 + fr, fq * 8);
#define PG8_SA(b, h) (((b) * 2 + (h)) * HTB)
#define PG8_SB(b, h) ((4 + (b) * 2 + (h)) * HTB)
#define PG8_STAGE(bufoff, gbase, voff) do { _Pragma("unroll") for (int _i = 0; _i < 2; ++_i) \
        __builtin_amdgcn_global_load_lds((const unsigned*)((const char*)(gbase) + (voff)[_i]), (PG8_LAS unsigned*)(lds + (bufoff) + ldsw + _i * 8192), 16, 0, 0); } while (0)
#define PG8_LDA(dst, b, h) do { _Pragma("unroll") for (int m = 0; m < 4; ++m) _Pragma("unroll") for (int k = 0; k < 2; ++k) dst[m][k] = *(const PG8_LAS bf16x8*)(lds + PG8_SA(b, h) + aoff + m * 2048 + k * 1024); } while (0)
#define PG8_LDB(dst, b, h) do { _Pragma("unroll") for (int n = 0; n < 2; ++n) _Pragma("unroll") for (int k = 0; k < 2; ++k) dst[n][k] = *(const PG8_LAS bf16x8*)(lds + PG8_SB(b, h) + boff + n * 2048 + k * 1024); } while (0)
#define PG8_MMA(ai, bj, At, Bt) do { __builtin_amdgcn_s_setprio(1); _Pragma("unroll") for (int m = 0; m < 4; ++m) _Pragma("unroll") for (int n = 0; n < 2; ++n) _Pragma("unroll") for (int k = 0; k < 2; ++k) \
        acc[ai][bj][m][n] = __builtin_amdgcn_mfma_f32_16x16x32_bf16(Bt[n][k], At[m][k], acc[ai][bj][m][n], 0, 0, 0); __builtin_amdgcn_s_setprio(0); } while (0)
#define PG8_WAIT_V(n) asm volatile("s_waitcnt vmcnt(" #n ")" ::: "memory")
#define PG8_WAIT_L(n) asm volatile("s_waitcnt lgkmcnt(" #n ")" ::: "memory")
#define PG8_BAR __builtin_amdgcn_s_barrier()
#define PG8_SCHED __builtin_amdgcn_sched_barrier(0)
    Unit cur, nxt; int ui = 0;
    if (!S.next(0, cur)) return;
    f32x4 acc[2][2][4][2];
#pragma unroll
    for (int a = 0; a < 2; ++a)
#pragma unroll
        for (int b = 0; b < 2; ++b)
#pragma unroll
            for (int m = 0; m < 4; ++m)
#pragma unroll
                for (int n = 0; n < 2; ++n) acc[a][b][m][n] = (f32x4){0.f, 0.f, 0.f, 0.f};
    bf16x8 At[4][2], B0[2][2], B1[2][2];
    const char* cA = (const char*)g.A + (size_t)cur.pm * tstepA + (g.kwin ? (size_t)(cur.pn % g.kwin) * K * 2 : 0); const char* cB = (const char*)g.Bt + (size_t)cur.pn * tstep;
    S.a_ready(cur);
    if constexpr (SP2) {
        PG8_STAGE(PG8_SB(0, 0), cB, voffB); PG8_STAGE(PG8_SB(0, 1), cB + hstep, voffB); PG8_STAGE(PG8_SA(0, 0), cA, voffA); PG8_STAGE(PG8_SA(0, 1), cA + hstepA, voffA);
        if (wr == 1) PG8_BAR;
        PG8_WAIT_V(2); PG8_BAR;
        PG8_STAGE(PG8_SB(1, 0), cB + kstep, voffB); PG8_STAGE(PG8_SA(1, 0), cA + kstep, voffA); PG8_STAGE(PG8_SB(1, 1), cB + hstep + kstep, voffB);
        PG8_WAIT_V(6); PG8_BAR;
    } else {
        PG8_STAGE(PG8_SB(0, 0), cB, voffB); PG8_STAGE(PG8_SA(0, 0), cA, voffA); PG8_STAGE(PG8_SB(0, 1), cB + hstep, voffB); PG8_STAGE(PG8_SA(0, 1), cA + hstepA, voffA);
        if (wr == 1) PG8_BAR;
        PG8_WAIT_V(4); PG8_BAR;
        PG8_STAGE(PG8_SB(1, 0), cB + kstep, voffB); PG8_STAGE(PG8_SA(1, 0), cA + kstep, voffA); PG8_STAGE(PG8_SB(1, 1), cB + hstep + kstep, voffB);
        PG8_WAIT_V(6); PG8_BAR;
    }
    for (;;) {
        const bool has_next = S.next(ui + 1, nxt);
        const char* nA = has_next ? (const char*)g.A + (size_t)nxt.pm * tstepA + (g.kwin ? (size_t)(nxt.pn % g.kwin) * K * 2 : 0) : cA; const char* nB = has_next ? (const char*)g.Bt + (size_t)nxt.pn * tstep : cB;
        for (int t = 0; t < nt; t += 2) {
            const bool last = (t == nt - 2);
            const char* a1 = cA + (size_t)(t + 1) * kstep;
            const char* a2 = last ? nA : cA + (size_t)(t + 2) * kstep; const char* b2 = last ? nB : cB + (size_t)(t + 2) * kstep;
            const char* a3 = a2 + kstep; const char* b3 = b2 + kstep;
            if (last && has_next) S.a_ready(nxt);
            if constexpr (SP2) {
            PG8_LDB(B0, 0, 0); PG8_LDB(B1, 0, 1); PG8_SCHED; PG8_LDA(At, 0, 0); PG8_STAGE(PG8_SA(1, 1), a1 + hstepA, voffA);
            PG8_WAIT_V(8); PG8_WAIT_L(0); PG8_BAR; PG8_MMA(0, 0, At, B0); PG8_MMA(0, 1, At, B1); PG8_BAR; PG8_SCHED;
            PG8_LDA(At, 0, 1); PG8_STAGE(PG8_SB(0, 0), b2, voffB); PG8_STAGE(PG8_SB(0, 1), b2 + hstep, voffB); PG8_STAGE(PG8_SA(0, 0), a2, voffA);
            PG8_WAIT_V(8); PG8_WAIT_L(0); PG8_BAR; PG8_MMA(1, 0, At, B0); PG8_MMA(1, 1, At, B1); PG8_BAR; PG8_SCHED;
            PG8_LDB(B0, 1, 0); PG8_LDB(B1, 1, 1); PG8_SCHED; PG8_LDA(At, 1, 0); PG8_STAGE(PG8_SA(0, 1), a2 + hstepA, voffA);
            PG8_WAIT_V(8); PG8_WAIT_L(0); PG8_BAR; PG8_MMA(0, 0, At, B0); PG8_MMA(0, 1, At, B1); PG8_BAR; PG8_SCHED;
            PG8_LDA(At, 1, 1); PG8_STAGE(PG8_SB(1, 0), b3, voffB); PG8_STAGE(PG8_SB(1, 1), b3 + hstep, voffB); PG8_STAGE(PG8_SA(1, 0), a3, voffA);
            PG8_WAIT_V(8); PG8_WAIT_L(0); PG8_BAR; PG8_MMA(1, 0, At, B0); PG8_MMA(1, 1, At, B1); PG8_BAR; PG8_SCHED;
            } else {
            PG8_LDB(B0, 0, 0); PG8_SCHED; PG8_LDA(At, 0, 0); PG8_STAGE(PG8_SA(1, 1), a1 + hstepA, voffA);
            PG8_WAIT_L(8); PG8_BAR; PG8_WAIT_L(0); PG8_MMA(0, 0, At, B0); PG8_BAR; PG8_SCHED;
            PG8_LDB(B1, 0, 1); PG8_STAGE(PG8_SB(0, 0), b2, voffB);
            PG8_BAR; PG8_WAIT_L(0); PG8_MMA(0, 1, At, B1); PG8_BAR;
            PG8_LDA(At, 0, 1); PG8_STAGE(PG8_SA(0, 0), a2, voffA);
            PG8_BAR; PG8_WAIT_L(0); PG8_MMA(1, 0, At, B0); PG8_BAR; PG8_SCHED;
            PG8_STAGE(PG8_SB(0, 1), b2 + hstep, voffB);
            PG8_WAIT_V(6); PG8_BAR; PG8_MMA(1, 1, At, B1); PG8_BAR;
            PG8_LDB(B0, 1, 0); PG8_SCHED; PG8_LDA(At, 1, 0); PG8_STAGE(PG8_SA(0, 1), a2 + hstepA, voffA);
            PG8_WAIT_L(8); PG8_BAR; PG8_WAIT_L(0); PG8_MMA(0, 0, At, B0); PG8_BAR; PG8_SCHED;
            PG8_LDB(B1, 1, 1); PG8_STAGE(PG8_SB(1, 0), b3, voffB);
            PG8_BAR; PG8_WAIT_L(0); PG8_MMA(0, 1, At, B1); PG8_BAR;
            PG8_LDA(At, 1, 1); PG8_STAGE(PG8_SA(1, 0), a3, voffA);
            PG8_BAR; PG8_WAIT_L(0); PG8_MMA(1, 0, At, B0); PG8_BAR; PG8_SCHED;
            PG8_STAGE(PG8_SB(1, 1), b3 + hstep, voffB);
            PG8_WAIT_V(6); PG8_BAR; PG8_MMA(1, 1, At, B1); PG8_BAR;
            }
        }
        if constexpr (ALIGN_EPI) { if (wr == 0) PG8_BAR; }
        if constexpr (!Epi::AFTER_DRAIN) { E(acc, cur, wr, wc, fr, fq); S.done(cur); }
        if (!has_next) break;
#pragma unroll
        for (int a = 0; a < 2; ++a)
#pragma unroll
            for (int b = 0; b < 2; ++b)
#pragma unroll
                for (int m = 0; m < 4; ++m)
#pragma unroll
                    for (int n = 0; n < 2; ++n) acc[a][b][m][n] = (f32x4){0.f, 0.f, 0.f, 0.f};
        cur = nxt; cA = nA; cB = nB; ++ui;
        if constexpr (ALIGN_EPI) { if (wr == 1) PG8_BAR; }
    }
    PG8_WAIT_V(0);
    if constexpr (!ALIGN_EPI) { if (wr == 0) PG8_BAR; }
    PG8_BAR;
    if constexpr (Epi::AFTER_DRAIN) { E.fused(acc, cur, wr, wc, fr, fq, lds, wid, lane); S.done(cur); }
#undef PG8_SA
#undef PG8_SB
#undef PG8_STAGE
#undef PG8_LDA
#undef PG8_LDB
#undef PG8_MMA
#undef PG8_WAIT_V
#undef PG8_WAIT_L
#undef PG8_BAR
#undef PG8_SCHED
}
}
namespace attn {
using bf16 = __hip_bfloat16;
constexpr int   D = 128, NW = 8, QBLK = 32, KVBLK = 64;
constexpr float SCALE = 0.088388347648318440f;
constexpr float THR = 8.f;
constexpr int SDEPTH = 2;
constexpr int LDQ = 10240, LDK = 10240, LDO = 4096;
constexpr size_t SHM_V = KVBLK * D * 2, SHM_K = KVBLK * D * 2, SHM_ATTN = 2 * SHM_V + 2 * SHM_K + NW * 64 * 4;
using bf16x8 = __attribute__((ext_vector_type(8))) short;
using s16x4  = __attribute__((ext_vector_type(4))) short;
using f32x16 = __attribute__((ext_vector_type(16))) float;
using f32x8  = __attribute__((ext_vector_type(8))) float;
using u32x4  = __attribute__((ext_vector_type(4))) unsigned;
#define KSWZ(row, colB) ((row) * 256 + ((colB) ^ (((row) & 7) << 4)))
#define SBAR() __builtin_amdgcn_sched_barrier(0)
__device__ __forceinline__ int crow(int r, int hi) { return (r & 3) + 8 * (r >> 2) + 4 * hi; }
__device__ __forceinline__ unsigned cvtpk(float lo, float hi) {
  unsigned r; asm volatile("v_cvt_pk_bf16_f32 %0, %1, %2" : "=v"(r) : "v"(lo), "v"(hi)); return r;
}
template <typename TIn> struct Stage;
template <> struct Stage<bf16>  { using T = bf16x8;
  __device__ static __forceinline__ T ld8(const bf16* p) { return *reinterpret_cast<const bf16x8*>(p); }
  __device__ static __forceinline__ bf16x8 tobf(T x) { return x; } };
template <> struct Stage<float> { using T = f32x8;
  __device__ static __forceinline__ T ld8(const float* p) { return *reinterpret_cast<const f32x8*>(p); }
  __device__ static __forceinline__ bf16x8 tobf(T x) {
    u32x4 w = {cvtpk(x[0], x[1]), cvtpk(x[2], x[3]), cvtpk(x[4], x[5]), cvtpk(x[6], x[7])}; return *reinterpret_cast<bf16x8*>(&w); } };

__device__ __forceinline__ void partialSM(f32x16& p0, f32x16& p1, float& m_reg, float& mn, float& alpha) {
  constexpr float C = SCALE * 1.4426950408889634f;
  float pmax = p0[0]; for (int r = 1; r < 16; ++r) pmax = fmaxf(pmax, p0[r]); for (int r = 0; r < 16; ++r) pmax = fmaxf(pmax, p1[r]);
  { auto rr = __builtin_amdgcn_permlane32_swap(__float_as_uint(pmax), __float_as_uint(pmax), false, false);
    pmax = fmaxf(__uint_as_float(rr[0]), __uint_as_float(rr[1])); }
  if (__builtin_expect(__all(pmax - m_reg <= THR / SCALE), 1)) { mn = m_reg; alpha = 1.f; }
  else { mn = fmaxf(m_reg, pmax); alpha = __builtin_amdgcn_exp2f((m_reg - mn) * C); m_reg = mn; }
  float mnC = -mn * C;
  for (int r = 0; r < 16; ++r) p0[r] = fmaf(p0[r], C, mnC); for (int r = 0; r < 16; ++r) p1[r] = fmaf(p1[r], C, mnC);
  for (int r = 0; r < 16; ++r) p0[r] = __builtin_amdgcn_exp2f(p0[r]);
}
__device__ __forceinline__ void finishSM(f32x16& p0, f32x16& p1, float alpha, float& l_reg, bf16x8& pa0, bf16x8& pa1, bf16x8& pa2, bf16x8& pa3) {
  for (int r = 0; r < 16; ++r) p1[r] = __builtin_amdgcn_exp2f(p1[r]);
  float ps = 0; for (int r = 0; r < 16; ++r) ps += p0[r]; for (int r = 0; r < 16; ++r) ps += p1[r];
  { auto rr = __builtin_amdgcn_permlane32_swap(__float_as_uint(ps), __float_as_uint(ps), false, false);
    ps = __uint_as_float(rr[0]) + __uint_as_float(rr[1]); }
  l_reg = l_reg * alpha + ps;
#define PK4(P, BASE, OUT) do { unsigned a0 = cvtpk(P[BASE + 0], P[BASE + 1]), a1 = cvtpk(P[BASE + 2], P[BASE + 3]);   \
    unsigned b0 = cvtpk(P[BASE + 4], P[BASE + 5]), b1 = cvtpk(P[BASE + 6], P[BASE + 7]);                              \
    auto r0 = __builtin_amdgcn_permlane32_swap(a0, b0, false, false); auto r1 = __builtin_amdgcn_permlane32_swap(a1, b1, false, false); \
    u32x4 w = {r0[0], r1[0], r0[1], r1[1]}; OUT = *reinterpret_cast<bf16x8*>(&w); } while (0)
  PK4(p0, 0, pa0); PK4(p0, 8, pa1); PK4(p1, 0, pa2); PK4(p1, 8, pa3);
#undef PK4
}
__device__ __forceinline__ void qkt(f32x16& p0, f32x16& p1, const bf16* Ks, const bf16x8* qr, int r32, int hi) {
  p0 = f32x16{}; p1 = f32x16{};
  for (int d0 = 0; d0 < 8; ++d0) { int cb = (d0 * 16 + hi * 8) * 2;
    bf16x8 b0 = *reinterpret_cast<const bf16x8*>((const char*)Ks + KSWZ(r32, cb));
    bf16x8 b1 = *reinterpret_cast<const bf16x8*>((const char*)Ks + KSWZ(32 + r32, cb));
    p0 = __builtin_amdgcn_mfma_f32_32x32x16_bf16(b0, qr[d0], p0, 0, 0, 0);
    p1 = __builtin_amdgcn_mfma_f32_32x32x16_bf16(b1, qr[d0], p1, 0, 0, 0); }
}
__device__ __forceinline__ int v_st(int k, int c) { const int kk = (k & ~0xC) | ((k & 4) << 1) | ((k & 8) >> 1); return ((kk >> 3) * 4 + (c >> 5)) * 512 + ((kk & 7) * 32 + (c & 31)) * 2; }
__device__ __forceinline__ int v_rd_base(int lane) { return ((lane & 3) << 3) | (((lane >> 2) & 3) << 6) | (((lane >> 4) & 1) << 5) | (((lane >> 5) & 1) << 8); }
constexpr int v_rd_off(int d0, int ks, int half) { return d0 * 512 + ks * 4096 + half * 2048; }
template <int OFF> __device__ __forceinline__ s16x4 tr_read(int vb) {
  s16x4 r; asm volatile("ds_read_b64_tr_b16 %0, %1 offset:%2" : "=&v"(r) : "v"(vb), "i"(OFF) : "memory"); return r;
}
template <int D0> __device__ __forceinline__ void pv_one(f32x16& od, int vb, bf16x8 pa0, bf16x8 pa1, bf16x8 pa2, bf16x8 pa3) {
  const s16x4 l0 = tr_read<v_rd_off(D0, 0, 0)>(vb), h0 = tr_read<v_rd_off(D0, 0, 1)>(vb), l1 = tr_read<v_rd_off(D0, 1, 0)>(vb), h1 = tr_read<v_rd_off(D0, 1, 1)>(vb);
  const s16x4 l2 = tr_read<v_rd_off(D0, 2, 0)>(vb), h2 = tr_read<v_rd_off(D0, 2, 1)>(vb), l3 = tr_read<v_rd_off(D0, 3, 0)>(vb), h3 = tr_read<v_rd_off(D0, 3, 1)>(vb);
  asm volatile("s_waitcnt lgkmcnt(0)" ::: "memory"); SBAR();
#define PK(L, H) (bf16x8){L[0], L[1], L[2], L[3], H[0], H[1], H[2], H[3]}
  od = __builtin_amdgcn_mfma_f32_32x32x16_bf16(pa0, PK(l0, h0), od, 0, 0, 0);
  od = __builtin_amdgcn_mfma_f32_32x32x16_bf16(pa1, PK(l1, h1), od, 0, 0, 0);
  od = __builtin_amdgcn_mfma_f32_32x32x16_bf16(pa2, PK(l2, h2), od, 0, 0, 0);
  od = __builtin_amdgcn_mfma_f32_32x32x16_bf16(pa3, PK(l3, h3), od, 0, 0, 0);
#undef PK
}
__device__ __forceinline__ void pv_d0(f32x16* o, int vb, bf16x8 pa0, bf16x8 pa1, bf16x8 pa2, bf16x8 pa3) {
  pv_one<0>(o[0], vb, pa0, pa1, pa2, pa3); pv_one<1>(o[1], vb, pa0, pa1, pa2, pa3); pv_one<2>(o[2], vb, pa0, pa1, pa2, pa3); pv_one<3>(o[3], vb, pa0, pa1, pa2, pa3);
}

template <typename TQ>
__device__ __forceinline__ void attn_dense_body(const TQ* __restrict__ Qb, const bf16* __restrict__ Kh, const bf16* __restrict__ Vh,
                                                bf16* __restrict__ Ob, int seq, char* lds) {
  using St = Stage<bf16>; using SQ = Stage<TQ>;
  int tid_ = threadIdx.x; asm volatile("" : "+v"(tid_));
  const int tid = tid_, wid = tid >> 6, lane = tid & 63, r32 = lane & 31, hi = lane >> 5;
  bf16* V_lds = (bf16*)lds; bf16* K_lds = (bf16*)(lds + 2 * SHM_V);
  float* ws = (float*)(lds + 2 * SHM_V + 2 * SHM_K) + wid * 64; float* li_l = ws; float* al_l = ws + 32;
  float m_reg = -1e30f, l_reg = 0; f32x16 o[4] = {}; bf16x8 qr[8];
  const TQ* Qw = Qb + (long)(wid * QBLK + r32) * LDQ + hi * 8;
#pragma unroll
  for (int d0 = 0; d0 < 8; ++d0) qr[d0] = SQ::tobf(SQ::ld8(Qw + d0 * 16));
  const int sr = tid >> 4, sc = (tid & 15) * 8, vst0 = v_st(sr, sc), vst1 = v_st(32 + sr, sc);
  const int vb0 = (int)(uintptr_t)V_lds + v_rd_base(lane);
  struct { typename St::T vs0, vs1, ks0, ks1; } sr_[SDEPTH];
#define SLOAD(i, k0) do { sr_[i].vs0 = St::ld8(&Vh[(long)((k0) + sr) * LDK + sc]); sr_[i].vs1 = St::ld8(&Vh[(long)((k0) + 32 + sr) * LDK + sc]); \
    sr_[i].ks0 = St::ld8(&Kh[(long)((k0) + sr) * LDK + sc]); sr_[i].ks1 = St::ld8(&Kh[(long)((k0) + 32 + sr) * LDK + sc]); } while (0)
#define SWRITE(b, i) do { *(bf16x8*)((char*)V_lds + (b) * SHM_V + vst0) = St::tobf(sr_[i].vs0);          \
    *(bf16x8*)((char*)V_lds + (b) * SHM_V + vst1) = St::tobf(sr_[i].vs1); int kc = sc * 2;               \
    *(bf16x8*)((char*)K_lds + (b) * SHM_K + KSWZ(sr, kc)) = St::tobf(sr_[i].ks0);                       \
    *(bf16x8*)((char*)K_lds + (b) * SHM_K + KSWZ(32 + sr, kc)) = St::tobf(sr_[i].ks1); } while (0)
#define SWAIT() do { if constexpr (SDEPTH == 2) asm volatile("s_waitcnt vmcnt(4)" ::: "memory"); else asm volatile("s_waitcnt vmcnt(0)" ::: "memory"); } while (0)
#define RESC(a) do { if (__any((a) < 1.f)) { if (hi == 0) al_l[r32] = (a); asm volatile("s_waitcnt lgkmcnt(0)" ::: "memory"); \
    for (int d = 0; d < 4; ++d) for (int r = 0; r < 16; ++r) o[d][r] *= al_l[crow(r, hi)]; } } while (0)
  f32x16 pA0, pA1, pB0, pB1; float mnA, mnB, alA, alB; bf16x8 pa0, pa1, pa2, pa3; const int NT = seq / KVBLK;
  constexpr int SE = 0, SO = SDEPTH - 1;
  SLOAD(SE, 0); asm volatile("s_waitcnt vmcnt(0)" ::: "memory"); SWRITE(0, SE); __syncthreads();
  qkt(pA0, pA1, K_lds, qr, r32, hi); partialSM(pA0, pA1, m_reg, mnA, alA);
  SLOAD(SO, KVBLK); if constexpr (SDEPTH == 2) { if (2 < NT) SLOAD(SE, 2 * KVBLK); }
  SWAIT(); SWRITE(1, SO); __syncthreads();
  for (int j = 1; j + 1 < NT; j += 2) {
    SBAR(); qkt(pB0, pB1, (bf16*)((char*)K_lds + SHM_K), qr, r32, hi);
    finishSM(pA0, pA1, alA, l_reg, pa0, pa1, pa2, pa3); SBAR();
    SLOAD(SO, (j + SDEPTH) * KVBLK); SBAR();
    pv_d0(o, vb0, pa0, pa1, pa2, pa3); partialSM(pB0, pB1, m_reg, mnB, alB);
    __syncthreads(); SWAIT(); SWRITE(0, SE);
    RESC(alB); __syncthreads();
    SBAR(); qkt(pA0, pA1, K_lds, qr, r32, hi);
    finishSM(pB0, pB1, alB, l_reg, pa0, pa1, pa2, pa3); SBAR();
    if (SDEPTH == 1 || j + 3 < NT) SLOAD(SE, (j + 1 + SDEPTH) * KVBLK); SBAR();
    pv_d0(o, vb0 + (int)SHM_V, pa0, pa1, pa2, pa3); partialSM(pA0, pA1, m_reg, mnA, alA);
    __syncthreads(); SWAIT(); SWRITE(1, SO);
    RESC(alA); __syncthreads();
  }
  SBAR(); qkt(pB0, pB1, (bf16*)((char*)K_lds + SHM_K), qr, r32, hi);
  finishSM(pA0, pA1, alA, l_reg, pa0, pa1, pa2, pa3); SBAR();
  pv_d0(o, vb0, pa0, pa1, pa2, pa3); partialSM(pB0, pB1, m_reg, mnB, alB);
  __syncthreads(); RESC(alB);
  finishSM(pB0, pB1, alB, l_reg, pa0, pa1, pa2, pa3); SBAR();
  pv_d0(o, vb0 + (int)SHM_V, pa0, pa1, pa2, pa3);
  if (hi == 0) li_l[r32] = l_reg; asm volatile("s_waitcnt lgkmcnt(0)" ::: "memory");
  float rli[16];
#pragma unroll
  for (int r = 0; r < 16; ++r) rli[r] = __builtin_amdgcn_rcpf(li_l[crow(r, hi)]);
  bf16* Ow = Ob + (long)(wid * QBLK) * LDO;
#pragma unroll
  for (int r = 0; r < 16; ++r) { int orow = crow(r, hi);
    for (int d0 = 0; d0 < 4; ++d0) Ow[(long)orow * LDO + d0 * 32 + r32] = __float2bfloat16(o[d0][r] * rli[r]); }
#undef SLOAD
#undef SWRITE
#undef SWAIT
#undef RESC
}
}
#define GAS __attribute__((address_space(1)))
#define LAS __attribute__((address_space(3)))
typedef unsigned short bf16;
typedef unsigned v4u __attribute__((ext_vector_type(4)));
typedef float f32x4 __attribute__((ext_vector_type(4)));
typedef short bf16x8 __attribute__((ext_vector_type(8)));
typedef GAS unsigned gu32;
typedef GAS unsigned long long gu64;
#define RLX_AGENT __ATOMIC_RELAXED, __HIP_MEMORY_SCOPE_AGENT
#define LDS_WAIT() asm volatile("s_waitcnt lgkmcnt(0)" ::: "memory")
#define VM_WAIT() asm volatile("s_waitcnt vmcnt(0)" ::: "memory")
__device__ __forceinline__ unsigned long long rt() { return __builtin_amdgcn_s_memrealtime(); }
__device__ __forceinline__ unsigned f2bf(float f) { unsigned u = __builtin_bit_cast(unsigned, f); return (u + 0x7fffu + ((u >> 16) & 1u)) >> 16; }
__device__ __forceinline__ unsigned pk2(float lo, float hi) { return f2bf(lo) | (f2bf(hi) << 16); }

#define XB_TMO      128
#define XB_XCNT(j)  (256  + 64 * (j))
#define XB_XSUB(j)  (1280 + 64 * (j))
#define XB_XGEN(j)  (2304 + 64 * (j))
#define XB_TOP      3328
#define XB_TOPGEN   3392
#define XCD_BAR_WORDS 3456
#define XB_SPIN_CAP (1u << 18)

__device__ __forceinline__ unsigned xb_ld(unsigned* p)              { return __hip_atomic_load(p, __ATOMIC_RELAXED, __HIP_MEMORY_SCOPE_AGENT); }
__device__ __forceinline__ unsigned xb_add(unsigned* p, unsigned v) { return __hip_atomic_fetch_add(p, v, __ATOMIC_RELAXED, __HIP_MEMORY_SCOPE_AGENT); }
__device__ __forceinline__ unsigned xb_xcc_id() { return (unsigned)__builtin_amdgcn_s_getreg((3 << 11) | 20) & 0xFu; }
#define XB_SPIN(cond, bar) do { unsigned _sp = 0; while (cond) { __builtin_amdgcn_s_sleep(1); \
    if ((++_sp & 255u) == 0u) { if (xb_ld(&(bar)[XB_TMO])) break; if (_sp > XB_SPIN_CAP) { atomicAdd(&(bar)[XB_TMO], 1u); break; } } } } while (0)

struct XcdBarrier {
    unsigned* bar; unsigned x;
    volatile LAS unsigned* st;
};

__device__ __forceinline__ XcdBarrier xcd_barrier_post(unsigned* bar, volatile LAS unsigned* st) {
    XcdBarrier b; b.bar = bar; b.x = xb_xcc_id(); b.st = st;
    if (threadIdx.x == 0) (void)xb_add(&bar[XB_XCNT(b.x)], 1u);
    return b;
}
__device__ __forceinline__ void xcd_barrier_complete(unsigned* bar, unsigned x, unsigned& nloc, unsigned& nx) {
    const unsigned G = gridDim.x * gridDim.y * gridDim.z;
    unsigned sum, cnt, mine, sp = 0u;
    for (;;) {
        sum = 0u; cnt = 0u; mine = 0u;
#pragma unroll
        for (unsigned j = 0; j < 16; ++j) { const unsigned c = xb_ld(&bar[XB_XCNT(j)]); sum += c; cnt += (c > 0u) ? 1u : 0u; mine = (j == x) ? c : mine; }
        if (sum == G) break;
        __builtin_amdgcn_s_sleep(1);
        if ((++sp & 255u) == 0u) { if (xb_ld(&bar[XB_TMO])) break; if (sp > XB_SPIN_CAP) { atomicAdd(&bar[XB_TMO], 1u); break; } }
    }
    nloc = mine > 0u ? mine : 1u; nx = cnt > 0u ? cnt : 1u;
}

__device__ __forceinline__ void xcd_barrier(const XcdBarrier& b) {
    asm volatile("s_waitcnt vmcnt(0)" ::: "memory");
    __syncthreads();
    if (threadIdx.x == 0) {
        unsigned* bar = b.bar;
        __builtin_amdgcn_s_waitcnt(0);
        unsigned nloc = b.st[0], nx = b.st[1];
        if (nloc == 0u) { xcd_barrier_complete(bar, b.x, nloc, nx); b.st[0] = nloc; b.st[1] = nx; }
        const unsigned old = xb_add(&bar[XB_XSUB(b.x)], 1u);
        const unsigned gen = old / nloc;
        if (old + 1u == (gen + 1u) * nloc) {
            __builtin_amdgcn_fence(__ATOMIC_RELEASE, "agent");
            asm volatile("s_waitcnt vmcnt(0)" ::: "memory");
            const unsigned og = xb_add(&bar[XB_TOP], 1u);
            const unsigned tg = og / nx;
            if (og + 1u == (tg + 1u) * nx) xb_add(&bar[XB_TOPGEN], 1u);
            else XB_SPIN(xb_ld(&bar[XB_TOPGEN]) == tg, bar);
            __builtin_amdgcn_fence(__ATOMIC_ACQUIRE, "agent");
            xb_add(&bar[XB_XGEN(b.x)], 1u);
            asm volatile("s_waitcnt vmcnt(0)" ::: "memory");
        } else {
            XB_SPIN(xb_ld(&bar[XB_XGEN(b.x)]) == gen, bar);
            __builtin_amdgcn_fence(__ATOMIC_ACQUIRE, "agent");
            asm volatile("s_waitcnt vmcnt(0)" ::: "memory");
        }
    }
    __syncthreads();
}

constexpr int NWAVES = 8, NTHR = NWAVES * 64;
constexpr int BATCH = 8, SEQ = 2048, M = BATCH * SEQ, DM = 4096, NU = 10240, FF = 11008, NG = 2 * FF, HD = 128;
constexpr int AW = 1024, BW = 1024;
constexpr int UA_Q = 0, UA_FF = 1024, UA_FB = 2048, UA_I = 3072, UA_G = 4096, UB_X = 5120, UB_GATE = 6144, UC_Q = 7168, UC_K = 9216, UC_V = 9728;
constexpr float LN_EPS = 1e-5f, RMS_EPS = 1e-6f, DN_ALPHA = 1.41421356237309515f;
#ifndef MK_SINGLE
#define MK_SINGLE 1
#endif
constexpr int PH_PER_LAYER = 11, NPH = 1 + 2 * PH_PER_LAYER;

constexpr size_t MiB = 1u << 20;
constexpr size_t WS_CTL = 0, CTL_ZERO_BYTES = 1 * MiB;
constexpr size_t SZ_WIN = (size_t)NU * DM * 2, SZ_WOUT = (size_t)DM * DM * 2, SZ_WUP = (size_t)NG * DM * 2, SZ_WDN = (size_t)DM * FF * 2, SZ_WRG = (size_t)4096 * 1024 * 2;
constexpr size_t WS_WIN = 1 * MiB, WS_WOUT = WS_WIN + 2 * SZ_WIN, WS_WUP = WS_WOUT + 2 * SZ_WOUT, WS_WDN = WS_WUP + 2 * SZ_WUP, WS_WRG = WS_WDN + 2 * SZ_WDN, WS_TAB = WS_WRG + 2 * SZ_WRG;
constexpr size_t WS_ST = WS_TAB + 65536;
constexpr size_t WS_GU = WS_TAB + 1 * MiB;
constexpr size_t SZ_GU = (size_t)M * NG * 2;
constexpr size_t WS_U = WS_GU;
constexpr size_t WS_R = WS_GU + 384 * MiB;
constexpr size_t WS_ACT = WS_GU + SZ_GU;
constexpr size_t SZ_ACT = (size_t)M * FF * 2;
constexpr size_t WS_XC = WS_ACT, WS_G = WS_XC + 32 * MiB, WS_HF = WS_G + 128 * MiB, WS_OF = WS_HF + 64 * MiB, WS_OB = WS_OF + 64 * MiB, WS_HBK = WS_OB + 64 * MiB;
constexpr size_t WS_Y = WS_ACT + ((SZ_ACT > 416 * MiB) ? SZ_ACT : 416 * MiB);
constexpr size_t WS_HB = WS_Y + 128 * MiB;
constexpr size_t WS_END = WS_HB + 128 * MiB;
static_assert(WS_HBK + 64 * MiB <= WS_Y && WS_R + 256 * MiB <= WS_ACT && WS_U + (size_t)M * NU * 2 <= WS_R, "d_ws map");
constexpr int CW_BAR = 4096;
constexpr int CW_QUEUE = 8192;

constexpr int RING_BYTES = 131072, MISC_OFF = RING_BYTES + 320, LDS_BYTES = 147456;

__device__ __forceinline__ float bf2f(bf16 b) { return __uint_as_float((unsigned)b << 16); }
__device__ __forceinline__ float sigm(float x) { return __builtin_amdgcn_rcpf(1.f + __expf(-x)); }
__device__ __forceinline__ float gelu_tanh(float x) { const float y = 0.7978845608028654f * (x + 0.044715f * x * x * x); const float t = 1.f - 2.f * __builtin_amdgcn_rcpf(1.f + __expf(2.f * y)); return 0.5f * x * (1.f + t); }
__device__ __forceinline__ int fresh_tid() { int t = threadIdx.x; asm volatile("" : "+v"(t)); return t; }
__device__ __forceinline__ float wave_sum(float v) {
#pragma unroll
    for (int o = 1; o < 64; o <<= 1) v += __shfl_xor(v, o);
    return v;
}

struct Args { const float* in[24]; float* out; unsigned char* ws; int ph_lo, ph_hi, pad0, pad1; };
struct Frame {
    LAS unsigned char* lds;
    volatile LAS unsigned* MISC;
    gu32* ctl;
    int tid, lane, wave, G, gw, NGW;
    float* H;
    unsigned char* ws;
};
#define WSP(T, off) ((T*)(F.ws + (off)))

template <bool GLU> __device__ __forceinline__ void p0_transpose_item(const float* W, int K, int N, bf16* WT, LAS float* scr, int item, int lane) {
    const int nblk = N / 32, kb = item / nblk, nb = item % nblk, k0 = 64 * kb, n0 = 32 * nb;
    const int nd0 = GLU ? ((n0 < FF) ? ((n0 >> 7) * 256 + (n0 & 127)) : (((n0 - FF) >> 7) * 256 + 128 + ((n0 - FF) & 127))) : n0;
    { f32x4 v[8]; const int kr = lane >> 3, n4 = (lane & 7) * 4;
#pragma unroll
      for (int i = 0; i < 8; ++i) v[i] = __builtin_nontemporal_load((const GAS f32x4*)(W + (size_t)(k0 + 8 * i + kr) * N + n0 + n4));
#pragma unroll
      for (int i = 0; i < 8; ++i) { LAS float* d = scr + (8 * i + kr) * 33 + n4; d[0] = v[i].x; d[1] = v[i].y; d[2] = v[i].z; d[3] = v[i].w; } }
    LDS_WAIT(); asm volatile("" ::: "memory");
    const int c = lane & 7;
#pragma unroll
    for (int j = 0; j < 4; ++j) { const int n = (lane >> 3) + 8 * j; const LAS float* s = scr + (8 * c) * 33 + n;
        v4u o; o.x = pk2(s[0 * 33], s[1 * 33]); o.y = pk2(s[2 * 33], s[3 * 33]); o.z = pk2(s[4 * 33], s[5 * 33]); o.w = pk2(s[6 * 33], s[7 * 33]);
        *(GAS v4u*)(WT + (size_t)(nd0 + n) * K + k0 + 8 * c) = o; }
    LDS_WAIT(); asm volatile("" ::: "memory");
}

__device__ __forceinline__ void ln_row(const float* src, const float* w, const float* b, float* dstF, bf16* dstB, float* st, int lane) {
    const GAS f32x4* xr = (const GAS f32x4*)src + lane;
    f32x4 v[16]; float s = 0.f;
#pragma unroll
    for (int j = 0; j < 16; ++j) { v[j] = xr[64 * j]; s += (v[j].x + v[j].y) + (v[j].z + v[j].w); }
    const float mean = wave_sum(s) * (1.f / DM); float s2 = 0.f;
#pragma unroll
    for (int j = 0; j < 16; ++j) { v[j] = v[j] - mean; s2 += (v[j].x * v[j].x + v[j].y * v[j].y) + (v[j].z * v[j].z + v[j].w * v[j].w); }
    const float rstd = 1.f / sqrtf(wave_sum(s2) * (1.f / DM) + LN_EPS);
    if (st && lane == 0) { st[0] = mean; st[1] = rstd; }
    GAS f32x4* of = (GAS f32x4*)dstF + lane; GAS unsigned long long* ob = (GAS unsigned long long*)dstB + lane;
    const GAS f32x4* wv = (const GAS f32x4*)w + lane; const GAS f32x4* bv = (const GAS f32x4*)b + lane;
#pragma unroll
    for (int j = 0; j < 16; ++j) { const f32x4 o = v[j] * rstd * wv[64 * j] + bv[64 * j]; if (dstF) of[64 * j] = o;
        if (dstB) ob[64 * j] = (unsigned long long)pk2(o.x, o.y) | ((unsigned long long)pk2(o.z, o.w) << 32); }
}
__device__ __forceinline__ void ln_row_bf(const bf16* src, const float* w, const float* b, float* dstF, bf16* dstB, float* st, int lane) {
    const GAS v4u* xr = (const GAS v4u*)src + lane;
    f32x4 v[16]; float s = 0.f;
#pragma unroll
    for (int j = 0; j < 8; ++j) { const v4u pw = xr[64 * j];
        v[2 * j] = (f32x4){__uint_as_float(pw.x << 16), __uint_as_float(pw.x & 0xffff0000u), __uint_as_float(pw.y << 16), __uint_as_float(pw.y & 0xffff0000u)};
        v[2 * j + 1] = (f32x4){__uint_as_float(pw.z << 16), __uint_as_float(pw.z & 0xffff0000u), __uint_as_float(pw.w << 16), __uint_as_float(pw.w & 0xffff0000u)};
        s += ((v[2 * j].x + v[2 * j].y) + (v[2 * j].z + v[2 * j].w)) + ((v[2 * j + 1].x + v[2 * j + 1].y) + (v[2 * j + 1].z + v[2 * j + 1].w)); }
    const float mean = wave_sum(s) * (1.f / DM); float s2 = 0.f;
#pragma unroll
    for (int j = 0; j < 16; ++j) { v[j] = v[j] - mean; s2 += (v[j].x * v[j].x + v[j].y * v[j].y) + (v[j].z * v[j].z + v[j].w * v[j].w); }
    const float rstd = 1.f / sqrtf(wave_sum(s2) * (1.f / DM) + LN_EPS);
    if (st && lane == 0) { st[0] = mean; st[1] = rstd; }
    GAS f32x4* of = (GAS f32x4*)dstF + 2 * lane; GAS v4u* ob = (GAS v4u*)dstB + lane;
    const GAS f32x4* wv = (const GAS f32x4*)w + 2 * lane; const GAS f32x4* bv = (const GAS f32x4*)b + 2 * lane;
#pragma unroll
    for (int j = 0; j < 8; ++j) { const f32x4 o0 = v[2 * j] * rstd * wv[128 * j] + bv[128 * j], o1 = v[2 * j + 1] * rstd * wv[128 * j + 1] + bv[128 * j + 1];
        if (dstF) { of[128 * j] = o0; of[128 * j + 1] = o1; }
        if (dstB) ob[64 * j] = (v4u){pk2(o0.x, o0.y), pk2(o0.z, o0.w), pk2(o1.x, o1.y), pk2(o1.z, o1.w)}; }
}
__device__ __forceinline__ void ln_phase_bf(Frame& F, const bf16* src, const float* w, const float* b, float* dstF, bf16* dstB, float* st) {
    const int lane = fresh_tid() & 63;
    for (int m = F.gw; m < M; m += F.NGW) ln_row_bf(src + (size_t)m * DM, w, b, dstF ? dstF + (size_t)m * DM : nullptr, dstB ? dstB + (size_t)m * DM : nullptr, st ? st + 2 * m : nullptr, lane);
}
__device__ __forceinline__ void ln_phase(Frame& F, const float* src, const float* w, const float* b, float* dstF, bf16* dstB, float* st) {
    const int lane = fresh_tid() & 63;
    for (int m = F.gw; m < M; m += F.NGW) ln_row(src + (size_t)m * DM, w, b, dstF ? dstF + (size_t)m * DM : nullptr, dstB ? dstB + (size_t)m * DM : nullptr, st ? st + 2 * m : nullptr, lane);
}

__device__ __forceinline__ void p0_prologue(const Args& A, Frame& F) {
    const int ftid = fresh_tid(), flane = ftid & 63;
    LAS float* scr = (LAS float*)(F.lds + F.wave * 16384);
    const float* w_in = A.in[3]; const float* w_out = A.in[15]; const float* w_up = A.in[18]; const float* w_dn = A.in[21];
    constexpr int I_IN = (DM / 64) * (NU / 32), I_OUT = (DM / 64) * (DM / 32), I_UP = (DM / 64) * (NG / 32), I_DN = (FF / 64) * (DM / 32);
    constexpr int I_L = I_IN + I_OUT + I_UP + I_DN;
    for (int it = F.gw; it < 2 * I_L; it += F.NGW) {
        const int l = it / I_L; int r = it % I_L;
        if (r < I_IN) { p0_transpose_item<false>(w_in + (size_t)l * DM * NU, DM, NU, WSP(bf16, WS_WIN + l * SZ_WIN), scr, r, flane); continue; } r -= I_IN;
        if (r < I_OUT) { p0_transpose_item<false>(w_out + (size_t)l * DM * DM, DM, DM, WSP(bf16, WS_WOUT + l * SZ_WOUT), scr, r, flane); continue; } r -= I_OUT;
        if (r < I_UP) { p0_transpose_item<true>(w_up + (size_t)l * DM * NG, DM, NG, WSP(bf16, WS_WUP + l * SZ_WUP), scr, r, flane); continue; } r -= I_UP;
        p0_transpose_item<false>(w_dn + (size_t)l * FF * DM, FF, DM, WSP(bf16, WS_WDN + l * SZ_WDN), scr, r, flane);
    }
    const int gtid = blockIdx.x * NTHR + ftid, NT = F.G * NTHR;
    for (int it = gtid; it < 2 * 4096 * 32; it += NT) {
        const int l = it / (4096 * 32), r = it % (4096 * 32), col = r >> 5, k0 = (r & 31) * 8;
        const int gt = col >> 10, n = (col >> 7) & 7, e = col & 127, half = (col >> 7) & 1, d0 = k0 & 127;
        v4u o = {0u, 0u, 0u, 0u};
        if ((k0 >> 7) == half) { const float* W = ((gt & 1) ? A.in[10] : A.in[8]) + ((size_t)((l * 2 + (gt >> 1)) * 8 + n)) * 16384 + e;
            float x[8];
#pragma unroll
            for (int i = 0; i < 8; ++i) x[i] = W[(d0 + i) * 128];
            o.x = pk2(x[0], x[1]); o.y = pk2(x[2], x[3]); o.z = pk2(x[4], x[5]); o.w = pk2(x[6], x[7]); }
        *(GAS v4u*)(WSP(bf16, WS_WRG + l * SZ_WRG) + (size_t)col * 256 + k0) = o;
    }
    if (gtid < 64 * 32) {
        const int pos = gtid >> 5, j = gtid & 31;
        double invf = 1.0; for (int i = 0; i < j; ++i) invf *= 0.7498942093324559;
        const double ang = (double)pos * invf;
        const double kq = __builtin_rint(ang * 0.6366197723675814);
        const double r = (ang - kq * 1.5707963267948966) - kq * 6.123233995736766e-17, r2 = r * r;
        double sn = r * (1.0 + r2 * (-1.0 / 6 + r2 * (1.0 / 120 + r2 * (-1.0 / 5040 + r2 * (1.0 / 362880 + r2 * (-1.0 / 39916800 + r2 * (1.0 / 6227020800.0)))))));
        double cs = 1.0 + r2 * (-0.5 + r2 * (1.0 / 24 + r2 * (-1.0 / 720 + r2 * (1.0 / 40320 + r2 * (-1.0 / 3628800 + r2 * (1.0 / 479001600.0 + r2 * (-1.0 / 87178291200.0)))))));
        const int q = ((int)kq) & 3; double c, s;
        if (q == 0) { c = cs; s = sn; } else if (q == 1) { c = -sn; s = cs; } else if (q == 2) { c = -cs; s = -sn; } else { c = sn; s = -cs; }
        float* tab = WSP(float, WS_TAB); tab[2 * gtid] = (float)c; tab[2 * gtid + 1] = (float)s;
    }
    ln_phase(F, A.in[0], A.in[1], A.in[2], nullptr, WSP(bf16, WS_HB), WSP(float, WS_ST));
}

__device__ __forceinline__ void prep_phase(const Args& A, Frame& F, int l, int rep) {
    const int ftid = fresh_tid(), flane = ftid & 63;
    bf16* U = WSP(bf16, WS_U); const float* tab = WSP(float, WS_TAB);
    const float* qn = A.in[13] + l * HD; const float* kn = A.in[14] + l * HD;
    const int L = flane, d1 = (L & 31) + 64 * (L >> 5), d2 = d1 + 32;
    const float wq1 = qn[d1], wq2 = qn[d2], wk1 = kn[d1], wk2 = kn[d2];
    for (int m = F.gw; m < M; m += F.NGW) {
        bf16* p = U + (size_t)m * NU + UC_Q;
        const int t = m & (SEQ - 1), pos = (L < 32) ? (t >> 6) : (t & 63);
        const float c = tab[2 * (pos * 32 + (L & 31))], s = tab[2 * (pos * 32 + (L & 31)) + 1];
        float x1[20], x2[20];
#pragma unroll
        for (int j = 0; j < 20; ++j) { x1[j] = bf2f(p[j * HD + d1]); x2[j] = bf2f(p[j * HD + d2]); }
#pragma unroll
        for (int j = 0; j < 20; ++j) {
            const float rstd = 1.f / sqrtf(wave_sum(x1[j] * x1[j] + x2[j] * x2[j]) * (1.f / HD) + RMS_EPS);
            const float n1 = x1[j] * rstd * (j < 16 ? wq1 : wk1), n2 = x2[j] * rstd * (j < 16 ? wq2 : wk2);
            const float o1 = n1 * c - n2 * s, o2 = n2 * c + n1 * s;
            if (rep == 0 || o1 != o1) { p[j * HD + d1] = (bf16)f2bf(o1); p[j * HD + d2] = (bf16)f2bf(o2); } }
    }
    const float* cw = A.in[6] + l * 4 * BW; const float* cb = A.in[7] + l * BW; bf16* XC = WSP(bf16, WS_XC);
    const int gtid = blockIdx.x * NTHR + ftid, NT = F.G * NTHR;
    for (int it = gtid; it < M * 128; it += NT) {
        const int m = it >> 7, c = (it & 127) * 8, t = m & (SEQ - 1);
        float acc[8];
#pragma unroll
        for (int i = 0; i < 8; ++i) acc[i] = cb[c + i];
#pragma unroll
        for (int k = 0; k < 4; ++k) { const int tt = t + k - 2;
            if (tt >= 0 && tt < SEQ) { const v4u xv = *(const GAS v4u*)(U + (size_t)(m + k - 2) * NU + UB_X + c); const unsigned xw[4] = {xv.x, xv.y, xv.z, xv.w};
#pragma unroll
                for (int i = 0; i < 4; ++i) { acc[2 * i] += cw[k * BW + c + 2 * i] * __uint_as_float(xw[i] << 16); acc[2 * i + 1] += cw[k * BW + c + 2 * i + 1] * __uint_as_float(xw[i] & 0xffff0000u); } } }
        v4u o; o.x = pk2(acc[0], acc[1]); o.y = pk2(acc[2], acc[3]); o.z = pk2(acc[4], acc[5]); o.w = pk2(acc[6], acc[7]);
        *(GAS v4u*)(XC + (size_t)m * BW + c) = o;
    }
}

namespace hg {
constexpr int PQ = 136, PK = 72;
constexpr int O_QM = 0, O_KM = O_QM + 64 * PQ * 2, O_KMT = O_KM + 64 * PQ * 2, O_VT = O_KMT + 128 * PK * 2, O_ST = O_VT + 128 * PK * 2, O_P = O_ST + 128 * PQ * 2;
constexpr int O_QS = O_P + 64 * PK * 2, O_EBM = O_QS + 4 * 128 * 4, O_ELM = O_EBM + 512, O_LB = O_ELM + 512, O_END = O_LB + 512;
static_assert(O_END <= 131072, "hgrn LDS");
}
__device__ __forceinline__ void hgrn_item(const Args& A, Frame& F, int l, int id) {
    using namespace hg;
    const int dir = id & 1, h = (id >> 1) & 7, b = id >> 4, tid = fresh_tid(), lane = tid & 63, w = tid >> 6, fr = lane & 15, fq = lane >> 4;
    LAS unsigned char* L = F.lds;
    LAS float* QS = (LAS float*)(L + O_QS); LAS float* EBM = (LAS float*)(L + O_EBM); LAS float* ELM = (LAS float*)(L + O_ELM); LAS float* LB = (LAS float*)(L + O_LB);
    const bf16* U = WSP(bf16, WS_U); float* O = WSP(float, dir ? WS_OB : WS_OF);
    if (tid < 128) { float lb = 0.f;
        if (l == 1) { const float* lg = A.in[4]; const float l0 = lg[(0 * 2 + dir) * AW + h * HD + tid], l1 = lg[(1 * 2 + dir) * AW + h * HD + tid]; lb = 1.f / (1.f + expf(l0 - l1)); }
        LB[tid] = lb; }
    __syncthreads();
    const int d = tid & 127, iq = tid >> 7;
    const float lb = LB[d];
    const int zc = (dir ? UA_FB : UA_FF) + h * HD + d, qc = UA_Q + h * HD + d, vc = UA_I + h * HD + d;
    f32x4 S[8];
#pragma unroll
    for (int et = 0; et < 8; ++et) S[et] = (f32x4){0.f, 0.f, 0.f, 0.f};
    bf16 zr[16], qr[16], vr[16];
#define HG_LOAD(c) do { _Pragma("unroll") for (int r = 0; r < 16; ++r) { const int s_ = 64 * (c) + 16 * iq + r, t_ = dir ? (SEQ - 1 - s_) : s_; const bf16* row_ = U + (size_t)(b * SEQ + t_) * NU; \
        zr[r] = row_[zc]; qr[r] = row_[qc]; vr[r] = row_[vc]; } } while (0)
    HG_LOAD(0);
    const int it = w >> 1, jt0 = 2 * (w & 1), et0 = 4 * (w & 1);
    for (int c = 0; c < SEQ / 64; ++c) {
        float lf[16], kk[16]; float run = 0.f;
#pragma unroll
        for (int r = 0; r < 16; ++r) { const float z = bf2f(zr[r]);
            const float ez = __expf(-fabsf(z)), rc = __builtin_amdgcn_rcpf(1.f + ez);
            const float sg = z >= 0.f ? rc : ez * rc, sn = z >= 0.f ? ez * rc : rc;
            lf[r] = (lb > 0.f) ? __logf(lb + (1.f - lb) * sg) : (fminf(z, 0.f) - __logf(1.f + ez));
            kk[r] = (1.f - lb) * sn;
            run += lf[r]; lf[r] = run; }
        QS[iq * 128 + d] = run;
        __syncthreads();
        { const float q0 = QS[d], q1 = QS[128 + d], q2 = QS[256 + d], q3 = QS[384 + d];
          const float off = (iq > 0 ? q0 : 0.f) + (iq > 1 ? q1 : 0.f) + (iq > 2 ? q2 : 0.f);
          const float bmid = q0 + q1, blast = (q0 + q1) + (q2 + q3);
          if (iq == 0) { EBM[d] = __expf(bmid); ELM[d] = __expf(blast - bmid); }
          unsigned kt[8], vt[8];
#pragma unroll
          for (int r = 0; r < 16; r += 2) {
              const float x0 = lf[r] + off - bmid, x1 = lf[r + 1] + off - bmid;
              const float e0 = __expf(fminf(fmaxf(x0, -80.f), 80.f)), e1 = __expf(fminf(fmaxf(x1, -80.f), 80.f));
              const float qm0 = bf2f(qr[r]) * e0, qm1 = bf2f(qr[r + 1]) * e1;
              const float km0 = kk[r] * __builtin_amdgcn_rcpf(e0), km1 = kk[r + 1] * __builtin_amdgcn_rcpf(e1);
              const unsigned k0 = f2bf(km0), k1 = f2bf(km1);
              *(LAS bf16*)(L + O_QM + ((16 * iq + r) * PQ + d) * 2) = (bf16)f2bf(qm0); *(LAS bf16*)(L + O_QM + ((16 * iq + r + 1) * PQ + d) * 2) = (bf16)f2bf(qm1);
              *(LAS bf16*)(L + O_KM + ((16 * iq + r) * PQ + d) * 2) = (bf16)k0;        *(LAS bf16*)(L + O_KM + ((16 * iq + r + 1) * PQ + d) * 2) = (bf16)k1;
              kt[r >> 1] = k0 | (k1 << 16); vt[r >> 1] = (unsigned)vr[r] | ((unsigned)vr[r + 1] << 16); }
          *(LAS v4u*)(L + O_KMT + (d * PK + 16 * iq) * 2) = (v4u){kt[0], kt[1], kt[2], kt[3]}; *(LAS v4u*)(L + O_KMT + (d * PK + 16 * iq + 8) * 2) = (v4u){kt[4], kt[5], kt[6], kt[7]};
          *(LAS v4u*)(L + O_VT + (d * PK + 16 * iq) * 2) = (v4u){vt[0], vt[1], vt[2], vt[3]};  *(LAS v4u*)(L + O_VT + (d * PK + 16 * iq + 8) * 2) = (v4u){vt[4], vt[5], vt[6], vt[7]}; }
        if (c + 1 < SEQ / 64) HG_LOAD(c + 1);
        __syncthreads();
        { const f32x4 eb = *(const LAS f32x4*)(EBM + 16 * w + 4 * fq);
#pragma unroll
          for (int et = 0; et < 8; ++et) { S[et] = S[et] * eb;
              typedef unsigned u32x2 __attribute__((ext_vector_type(2)));
              *(LAS u32x2*)(L + O_ST + ((16 * et + fr) * PQ + 16 * w + 4 * fq) * 2) = (u32x2){pk2(S[et].x, S[et].y), pk2(S[et].z, S[et].w)}; } }
        bf16x8 aq[4];
#pragma unroll
        for (int k4 = 0; k4 < 4; ++k4) aq[k4] = *(const LAS bf16x8*)(L + O_QM + ((16 * it + fr) * PQ + 32 * k4 + 8 * fq) * 2);
#pragma unroll
        for (int jj = 0; jj < 2; ++jj) { const int jt = jt0 + jj; f32x4 sc = {0.f, 0.f, 0.f, 0.f};
#pragma unroll
            for (int k4 = 0; k4 < 4; ++k4) { const bf16x8 bk = *(const LAS bf16x8*)(L + O_KM + ((16 * jt + fr) * PQ + 32 * k4 + 8 * fq) * 2);
                sc = __builtin_amdgcn_mfma_f32_16x16x32_bf16(aq[k4], bk, sc, 0, 0, 0); }
            const int jcol = 16 * jt + fr;
#pragma unroll
            for (int r = 0; r < 4; ++r) { const int irow = 16 * it + 4 * fq + r; *(LAS bf16*)(L + O_P + (irow * PK + jcol) * 2) = (bf16)f2bf(jcol <= irow ? sc[r] : 0.f); } }
        __syncthreads();
        { bf16x8 ap[2];
#pragma unroll
          for (int k2 = 0; k2 < 2; ++k2) ap[k2] = *(const LAS bf16x8*)(L + O_P + ((16 * it + fr) * PK + 32 * k2 + 8 * fq) * 2);
#pragma unroll
          for (int ee = 0; ee < 4; ++ee) { const int et = et0 + ee; f32x4 o = {0.f, 0.f, 0.f, 0.f};
#pragma unroll
              for (int k4 = 0; k4 < 4; ++k4) { const bf16x8 bs = *(const LAS bf16x8*)(L + O_ST + ((16 * et + fr) * PQ + 32 * k4 + 8 * fq) * 2);
                  o = __builtin_amdgcn_mfma_f32_16x16x32_bf16(aq[k4], bs, o, 0, 0, 0); }
#pragma unroll
              for (int k2 = 0; k2 < 2; ++k2) { const bf16x8 bv = *(const LAS bf16x8*)(L + O_VT + ((16 * et + fr) * PK + 32 * k2 + 8 * fq) * 2);
                  o = __builtin_amdgcn_mfma_f32_16x16x32_bf16(ap[k2], bv, o, 0, 0, 0); }
#pragma unroll
              for (int r = 0; r < 4; ++r) { const int s_ = 64 * c + 16 * it + 4 * fq + r, t_ = dir ? (SEQ - 1 - s_) : s_;
                  O[(size_t)(b * SEQ + t_) * AW + h * HD + 16 * et + fr] = o[r]; } } }
        { bf16x8 ak[2];
#pragma unroll
          for (int k2 = 0; k2 < 2; ++k2) ak[k2] = *(const LAS bf16x8*)(L + O_KMT + ((16 * w + fr) * PK + 32 * k2 + 8 * fq) * 2);
          const f32x4 el = *(const LAS f32x4*)(ELM + 16 * w + 4 * fq);
#pragma unroll
          for (int et = 0; et < 8; ++et) {
#pragma unroll
              for (int k2 = 0; k2 < 2; ++k2) { const bf16x8 bv = *(const LAS bf16x8*)(L + O_VT + ((16 * et + fr) * PK + 32 * k2 + 8 * fq) * 2);
                  S[et] = __builtin_amdgcn_mfma_f32_16x16x32_bf16(ak[k2], bv, S[et], 0, 0, 0); }
              S[et] = S[et] * el; } }
    }
#undef HG_LOAD
}

__device__ __forceinline__ void hgrn_final_phase(const Args& A, Frame& F, int l) {
    const int ftid = fresh_tid(), flane = ftid & 63;
    const float* OFp = WSP(float, WS_OF); const float* OBp = WSP(float, WS_OB); const bf16* U = WSP(bf16, WS_U); bf16* Y = WSP(bf16, WS_Y);
    const float* nw = A.in[5] + l * AW; typedef float f32x2 __attribute__((ext_vector_type(2)));
    for (int m = F.gw; m < M; m += F.NGW) {
        f32x2 a[8], bq[8]; unsigned gw2[8];
#pragma unroll
        for (int h = 0; h < 8; ++h) { const int c = h * HD + 2 * flane;
            a[h] = *(const GAS f32x2*)(OFp + (size_t)m * AW + c); bq[h] = *(const GAS f32x2*)(OBp + (size_t)m * AW + c); gw2[h] = *(const GAS unsigned*)(U + (size_t)m * NU + UA_G + c); }
#pragma unroll
        for (int h = 0; h < 8; ++h) { const int c = h * HD + 2 * flane;
            const float o0 = a[h].x + bq[h].x, o1 = a[h].y + bq[h].y;
            const float rstd = 1.f / sqrtf(wave_sum(o0 * o0 + o1 * o1) * (1.f / HD) + RMS_EPS);
            const float g0 = __uint_as_float(gw2[h] << 16), g1 = __uint_as_float(gw2[h] & 0xffff0000u);
            const float y0 = o0 * rstd * nw[c] * (g0 * sigm(g0)), y1 = o1 * rstd * nw[c + 1] * (g1 * sigm(g1));
            *(GAS unsigned*)(Y + (size_t)m * DM + c) = pk2(y0, y1); }
    }
    const float* HFp = WSP(float, WS_HF); const float* HBp = WSP(float, WS_HBK);
    const int gtid = blockIdx.x * NTHR + ftid, NT = F.G * NTHR;
    for (int it = gtid; it < M * 128; it += NT) { const int m = it >> 7, c = (it & 127) * 8;
        const f32x4 a0 = *(const GAS f32x4*)(HFp + (size_t)m * BW + c), a1 = *(const GAS f32x4*)(HFp + (size_t)m * BW + c + 4), b0 = *(const GAS f32x4*)(HBp + (size_t)m * BW + c), b1 = *(const GAS f32x4*)(HBp + (size_t)m * BW + c + 4);
        const v4u gv = *(const GAS v4u*)(U + (size_t)m * NU + UB_GATE + c); const unsigned gw4[4] = {gv.x, gv.y, gv.z, gv.w};
        const float hs[8] = {a0.x + b0.x, a0.y + b0.y, a0.z + b0.z, a0.w + b0.w, a1.x + b1.x, a1.y + b1.y, a1.z + b1.z, a1.w + b1.w};
        unsigned o[4];
#pragma unroll
        for (int i = 0; i < 4; ++i) o[i] = pk2(gelu_tanh(__uint_as_float(gw4[i] << 16)) * hs[2 * i], gelu_tanh(__uint_as_float(gw4[i] & 0xffff0000u)) * hs[2 * i + 1]);
        *(GAS v4u*)(Y + (size_t)m * DM + AW + c) = (v4u){o[0], o[1], o[2], o[3]}; }
}

__device__ __forceinline__ void rg_item(const Args& A, Frame& F, int l, int id) {
    const int tid = fresh_tid(), dir = id & 1, cg = (id >> 1) & 15, b = id >> 5;
    const bf16* G = WSP(bf16, WS_G); const bf16* XC = WSP(bf16, WS_XC); float* HO = WSP(float, dir ? WS_HBK : WS_HF);
    LAS float* As = (LAS float*)F.lds; LAS float* Bs = As + 128 * 64; LAS float* XP = Bs + 128 * 64; LAS float* XH = XP + 512; LAS float* Cs = XH + 512;
    const int srow = tid >> 3, sc8 = (tid & 7) * 8, cc = cg * 64 + sc8;
    float ba[8], bx[8], sp[8];
#pragma unroll
    for (int i = 0; i < 8; ++i) { ba[i] = A.in[9][(l * 2 + dir) * BW + cc + i]; bx[i] = A.in[11][(l * 2 + dir) * BW + cc + i]; sp[i] = -8.f * log1pf(expf(-A.in[12][(l * 2 + dir) * BW + cc + i])); }
    const int ch = tid & 63, sub = tid >> 6;
    if (tid < 64) Cs[tid] = 0.f;
    v4u gr[2], gi[2], gx[2];
#define RG_LOAD(k) do { _Pragma("unroll") for (int p2 = 0; p2 < 2; ++p2) { const int p_ = 64 * p2 + srow, s_ = 128 * (k) + p_, t_ = dir ? (SEQ - 1 - s_) : s_; const size_t m_ = (size_t)b * SEQ + t_; \
        gr[p2] = *(const GAS v4u*)(G + m_ * 4096 + dir * 2048 + cc); gi[p2] = *(const GAS v4u*)(G + m_ * 4096 + dir * 2048 + 1024 + cc); gx[p2] = *(const GAS v4u*)(XC + m_ * BW + cc); } } while (0)
    RG_LOAD(0);
    for (int k = 0; k < SEQ / 128; ++k) {
#pragma unroll
        for (int p2 = 0; p2 < 2; ++p2) { const unsigned rw[4] = {gr[p2].x, gr[p2].y, gr[p2].z, gr[p2].w}, iw[4] = {gi[p2].x, gi[p2].y, gi[p2].z, gi[p2].w}, xw[4] = {gx[p2].x, gx[p2].y, gx[p2].z, gx[p2].w};
            float av[8], bv[8];
#pragma unroll
            for (int i = 0; i < 8; ++i) { const float rp = (i & 1) ? __uint_as_float(rw[i >> 1] & 0xffff0000u) : __uint_as_float(rw[i >> 1] << 16);
                const float ip = (i & 1) ? __uint_as_float(iw[i >> 1] & 0xffff0000u) : __uint_as_float(iw[i >> 1] << 16);
                const float xv = (i & 1) ? __uint_as_float(xw[i >> 1] & 0xffff0000u) : __uint_as_float(xw[i >> 1] << 16);
                const float la = sp[i] * sigm(rp + ba[i]); av[i] = __expf(la); const float y2 = 2.f * la, om = (y2 > -0.25f) ? -y2 * (1.f + y2 * (0.5f + y2 * (0.16666667f + y2 * (0.041666668f + y2 * (0.008333334f + y2 * 0.0013888889f))))) : 1.f - __expf(y2);
                bv[i] = sqrtf(om) * sigm(ip + bx[i]) * xv; }
            LAS f32x4* ap = (LAS f32x4*)(As + (64 * p2 + srow) * 64 + sc8); LAS f32x4* bp = (LAS f32x4*)(Bs + (64 * p2 + srow) * 64 + sc8);
            ap[0] = (f32x4){av[0], av[1], av[2], av[3]}; ap[1] = (f32x4){av[4], av[5], av[6], av[7]}; bp[0] = (f32x4){bv[0], bv[1], bv[2], bv[3]}; bp[1] = (f32x4){bv[4], bv[5], bv[6], bv[7]}; }
        if (k + 1 < SEQ / 128) RG_LOAD(k + 1);
        __syncthreads();
        float hh = 0.f, pp = 1.f;
#pragma unroll
        for (int j = 0; j < 16; ++j) { const float a = As[(16 * sub + j) * 64 + ch], bt = Bs[(16 * sub + j) * 64 + ch]; hh = a * hh + bt; pp *= a; }
        XP[sub * 64 + ch] = pp; XH[sub * 64 + ch] = hh;
        __syncthreads();
        float cin = Cs[ch];
        for (int s2 = 0; s2 < sub; ++s2) cin = XP[s2 * 64 + ch] * cin + XH[s2 * 64 + ch];
#pragma unroll
        for (int j = 0; j < 16; ++j) { const float a = As[(16 * sub + j) * 64 + ch], bt = Bs[(16 * sub + j) * 64 + ch]; cin = a * cin + bt;
            const int s_ = 128 * k + 16 * sub + j, t_ = dir ? (SEQ - 1 - s_) : s_; HO[((size_t)b * SEQ + t_) * BW + cg * 64 + ch] = cin; }
        __syncthreads();
        if (sub == 7) Cs[ch] = cin;
    }
#undef RG_LOAD
}

constexpr int Q_HGRN = 128, Q_RG = 256, Q_ATT = BATCH * 16 * (SEQ / 256), Q_ALL = Q_HGRN + Q_RG + Q_ATT;
__device__ __forceinline__ void mixer_phase(const Args& A, Frame& F, int l, char* lds_generic, int rep) {
#ifndef MIX_DIS
#define MIX_DIS 0
#endif
#ifndef MIX_REP_DIS
#define MIX_REP_DIS 0
#endif
    for (;;) {
        __syncthreads();
        if (F.tid == 0) F.MISC[0] = __hip_atomic_fetch_add(F.ctl + CW_QUEUE + 128 * l + 512 * rep, 1u, RLX_AGENT);
        __syncthreads();
        const int id = (int)F.MISC[0];
        if (id >= Q_HGRN + Q_RG) break;
        if (id < Q_HGRN) { if (!(MIX_DIS & 1) && !(rep && (MIX_REP_DIS & 1))) hgrn_item(A, F, l, id); }
        else { if (!(MIX_DIS & 2) && !(rep && (MIX_REP_DIS & 2))) rg_item(A, F, l, id - Q_HGRN); }
    }
    const attn::bf16* U = (const attn::bf16*)WSP(bf16, WS_U); attn::bf16* Y = (attn::bf16*)WSP(bf16, WS_Y);
    for (;;) {
        __syncthreads();
        if (F.tid == 0) F.MISC[0] = __hip_atomic_fetch_add(F.ctl + CW_QUEUE + 128 * l + 64 + 512 * rep, 1u, RLX_AGENT);
        __syncthreads();
        const int a = (int)F.MISC[0];
        if (a >= Q_ATT) break;
        if (!(MIX_DIS & 4) && !(rep && (MIX_REP_DIS & 4))) { const int qb = a & 7, h = (a >> 3) & 15, b = a >> 7;
            const size_t r0 = (size_t)b * SEQ;
            attn::attn_dense_body<attn::bf16>(U + (r0 + qb * 256) * NU + UC_Q + h * HD, U + r0 * NU + UC_K + (h >> 2) * HD, U + r0 * NU + UC_V + (h >> 2) * HD,
                                              Y + (r0 + qb * 256) * DM + AW + BW + h * HD, SEQ, lds_generic); }
    }
}

__device__ __forceinline__ void act_phase(const Args& A, Frame& F, int l) {
    const int ftid = fresh_tid(), flane = ftid & 63;
    const bf16* GU = WSP(bf16, WS_GU); bf16* ACT = WSP(bf16, WS_ACT);
    const float* cw = A.in[19] + (size_t)l * 3 * FF; const float* cb = A.in[20] + (size_t)l * FF;
    const int gtid = blockIdx.x * NTHR + ftid, NT = F.G * NTHR; constexpr int C8 = FF / 8;
    for (long it = gtid; it < (long)M * C8; it += NT) {
        const int m = (int)(it / C8), c = (int)(it % C8) * 8, t = m & (SEQ - 1);
        float acc[8];
#pragma unroll
        for (int i = 0; i < 8; ++i) acc[i] = cb[c + i];
#pragma unroll
        for (int k = 0; k < 3; ++k) { const int tt = t + k - 1;
            if (tt >= 0 && tt < SEQ) { const v4u xv = *(const GAS v4u*)(GU + (size_t)(m + k - 1) * NG + c); const unsigned xw[4] = {xv.x, xv.y, xv.z, xv.w};
#pragma unroll
                for (int i = 0; i < 4; ++i) { acc[2 * i] += cw[(size_t)k * FF + c + 2 * i] * __uint_as_float(xw[i] << 16); acc[2 * i + 1] += cw[(size_t)k * FF + c + 2 * i + 1] * __uint_as_float(xw[i] & 0xffff0000u); } } }
        const v4u uv = *(const GAS v4u*)(GU + (size_t)m * NG + FF + c); const unsigned uw[4] = {uv.x, uv.y, uv.z, uv.w};
        float o[8];
#pragma unroll
        for (int i = 0; i < 4; ++i) { o[2 * i] = acc[2 * i] * sigm(acc[2 * i]) * __uint_as_float(uw[i] << 16); o[2 * i + 1] = acc[2 * i + 1] * sigm(acc[2 * i + 1]) * __uint_as_float(uw[i] & 0xffff0000u); }
        v4u ov; ov.x = pk2(o[0], o[1]); ov.y = pk2(o[2], o[3]); ov.z = pk2(o[4], o[5]); ov.w = pk2(o[6], o[7]);
        *(GAS v4u*)(ACT + (size_t)m * FF + c) = ov;
    }
}

__global__ void __launch_bounds__(NTHR, 2) fwd_kernel(Args args) {
    extern __shared__ __attribute__((aligned(16))) unsigned char lds[];
    Frame F;
    F.lds = (LAS unsigned char*)lds;
    F.MISC = (volatile LAS unsigned*)(F.lds + MISC_OFF);
    F.tid = threadIdx.x; F.lane = F.tid & 63; F.wave = __builtin_amdgcn_readfirstlane(F.tid >> 6);
    F.G = gridDim.x; F.gw = blockIdx.x * NWAVES + F.wave; F.NGW = F.G * NWAVES;
    F.ws = args.ws; F.ctl = (gu32*)(args.ws + WS_CTL); F.H = args.out;
    for (int u = F.tid; u < (LDS_BYTES - RING_BYTES) / 4; u += NTHR) ((LAS unsigned*)(F.lds + RING_BYTES))[u] = 0u;
    __syncthreads();
    const int lo = args.ph_lo, hi = args.ph_hi;
    XcdBarrier bar; bar.bar = (unsigned*)(F.ctl + CW_BAR); bar.x = 0; bar.st = nullptr;
    if (hi - lo > 1) bar = xcd_barrier_post((unsigned*)(F.ctl + CW_BAR), F.MISC + 8);
#ifndef DIS
#define DIS 0
#endif
#define EN(j) (!((DIS >> (j)) & 1))
#ifndef DBL
#define DBL 0
#endif
#define REPS(j, l) ((((DBL >> (j)) & 1) && (l) == 0) ? 2 : 1)
#define IN(k) (lo <= (k) && (k) < hi)
#define SEAM(k) do { if (IN(k) && IN((k) + 1)) xcd_barrier(bar); } while (0)
    LAS unsigned char* ring = F.lds;

    if (EN(0) && IN(0)) { for (int rep = 0; rep < REPS(0, 0); ++rep) { p0_prologue(args, F); if (rep + 1 < REPS(0, 0)) xcd_barrier(bar); } } SEAM(0);

    for (int l = 0; l < 2; ++l) {
        const int pb = 1 + PH_PER_LAYER * l;
        bf16* HB = WSP(bf16, WS_HB); bf16* U = WSP(bf16, WS_U); bf16* Y = WSP(bf16, WS_Y); bf16* RBUF = WSP(bf16, WS_R);
        if (EN(1) && IN(pb + 0)) for (int rep = 0; rep < REPS(1, l); ++rep) { if (rep) xcd_barrier(bar); pg8::Gemm g{HB, WSP(bf16, WS_WIN + l * SZ_WIN), M, NU, DM}; pg8::StaticOrder S; S.init(M, NU, F.G, (int)blockIdx.x);
            pg8::EpiBf16<0> E{U, NU, nullptr, 0, 0, 1.f};
            pg8::gemm_phase<pg8::EpiBf16<0>, pg8::StaticOrder, true, true>(ring, g, S, E); } SEAM(pb + 0);
        if (EN(2) && IN(pb + 1)) for (int rep = 0; rep < REPS(2, l); ++rep) { if (rep) xcd_barrier(bar); prep_phase(args, F, l, rep); } SEAM(pb + 1);
        if (EN(3) && IN(pb + 2)) for (int rep = 0; rep < REPS(3, l); ++rep) { if (rep) xcd_barrier(bar); pg8::Gemm g{WSP(bf16, WS_XC), WSP(bf16, WS_WRG + l * SZ_WRG), M, 4096, 256, 0, 1024, 4}; pg8::StaticOrder S; S.init(M, 4096, F.G, (int)blockIdx.x);
            pg8::EpiBf16<0> E{WSP(bf16, WS_G), 4096, nullptr, 0, 0, 1.f};
            pg8::gemm_phase<pg8::EpiBf16<0>, pg8::StaticOrder, true, true>(ring, g, S, E); } SEAM(pb + 2);
        if (EN(4) && IN(pb + 3)) for (int rep = 0; rep < REPS(4, l); ++rep) { if (rep) xcd_barrier(bar); mixer_phase(args, F, l, (char*)lds, rep); } SEAM(pb + 3);
        if (EN(5) && IN(pb + 4)) for (int rep = 0; rep < REPS(5, l); ++rep) { if (rep) xcd_barrier(bar); hgrn_final_phase(args, F, l); } SEAM(pb + 4);
        if (EN(6) && IN(pb + 5)) for (int rep = 0; rep < REPS(6, l); ++rep) { if (rep) xcd_barrier(bar); pg8::Gemm g{Y, WSP(bf16, WS_WOUT + l * SZ_WOUT), M, DM, DM}; pg8::StaticOrder S; S.init(M, DM, F.G, (int)blockIdx.x);
            if (l == 0) { pg8::EpiResBf<true> E{args.in[0], WSP(float, WS_ST), args.in[1], args.in[2], RBUF}; pg8::gemm_phase<pg8::EpiResBf<true>, pg8::StaticOrder, true, true>(ring, g, S, E); }
            else { pg8::EpiResBf<false> E{nullptr, WSP(float, WS_ST), args.in[22], args.in[23], RBUF}; pg8::gemm_phase<pg8::EpiResBf<false>, pg8::StaticOrder, true, true>(ring, g, S, E); } } SEAM(pb + 5);
        if (EN(7) && IN(pb + 6)) for (int rep = 0; rep < REPS(7, l); ++rep) { if (rep) xcd_barrier(bar); ln_phase_bf(F, RBUF, args.in[16] + l * DM, args.in[17] + l * DM, nullptr, HB, WSP(float, WS_ST)); } SEAM(pb + 6);
        if (EN(8) && IN(pb + 7)) for (int rep = 0; rep < REPS(8, l); ++rep) { if (rep) xcd_barrier(bar); pg8::Gemm g{HB - DM, WSP(bf16, WS_WUP + l * SZ_WUP), 65 * 256, NG, DM, 254}; pg8::StaticOrder S; S.init(65 * 256, NG, F.G, (int)blockIdx.x);
            pg8::EpiConvGlu E{WSP(bf16, WS_ACT), FF, args.in[19] + (size_t)l * 3 * FF, args.in[20] + (size_t)l * FF, (PG8_LAS float*)(F.lds + RING_BYTES + 1024), SEQ, M};
            pg8::gemm_phase<pg8::EpiConvGlu, pg8::StaticOrder, true, true>(ring, g, S, E); } SEAM(pb + 7);
        if (EN(10) && IN(pb + 9)) for (int rep = 0; rep < REPS(10, l); ++rep) { if (rep) xcd_barrier(bar); pg8::Gemm g{WSP(bf16, WS_ACT), WSP(bf16, WS_WDN + l * SZ_WDN), M, DM, FF}; pg8::StaticOrder S; S.init(M, DM, F.G, (int)blockIdx.x);
            pg8::EpiResBf<false> E{nullptr, WSP(float, WS_ST), args.in[16] + l * DM, args.in[17] + l * DM, RBUF};
            pg8::gemm_phase<pg8::EpiResBf<false>, pg8::StaticOrder, true, true>(ring, g, S, E); } SEAM(pb + 9);
        if (EN(11) && IN(pb + 10)) for (int rep = 0; rep < REPS(11, l); ++rep) { if (rep) xcd_barrier(bar);
            ln_phase_bf(F, RBUF, args.in[22] + l * DM, args.in[23] + l * DM, l == 1 ? F.H : nullptr, l == 1 ? nullptr : HB, l == 1 ? nullptr : WSP(float, WS_ST)); } SEAM(pb + 10);
    }
#undef IN
#undef SEAM
}

extern "C" void kernel_launch(void* const* d_in, const int* in_sizes, int n_in, void* d_out, int out_size, void* d_ws, size_t ws_size, hipStream_t stream) {
    static int grid = 0;
    if (grid == 0) {
        if (n_in != 24 || in_sizes[0] != M * DM || out_size != M * DM || ws_size < WS_END) { fprintf(stderr, "kernel_launch: unexpected shapes: n_in %d in0 %d out %d ws %zu (need %zu)\n", n_in, n_in > 0 ? in_sizes[0] : -1, out_size, ws_size, (size_t)WS_END); grid = -1; return; }
        int dev = 0, cus = 0, per_cu = 0;
        if (hipGetDevice(&dev) != hipSuccess || hipDeviceGetAttribute(&cus, hipDeviceAttributeMultiprocessorCount, dev) != hipSuccess) { grid = -1; return; }
        if (hipFuncSetAttribute((const void*)fwd_kernel, hipFuncAttributeMaxDynamicSharedMemorySize, LDS_BYTES) != hipSuccess) { fprintf(stderr, "kernel_launch: hipFuncSetAttribute failed\n"); grid = -1; return; }
        if (hipOccupancyMaxActiveBlocksPerMultiprocessor(&per_cu, (const void*)fwd_kernel, NTHR, LDS_BYTES) != hipSuccess || per_cu < 1) fprintf(stderr, "kernel_launch: occupancy query reports %d\n", per_cu);
        (void)hipGetLastError();
        grid = cus;
    }
    if (grid < 0) return;
    if (hipMemsetAsync((char*)d_ws + WS_CTL, 0, CTL_ZERO_BYTES, stream) != hipSuccess) return;
    Args a{};
    for (int i = 0; i < 24; ++i) a.in[i] = (const float*)d_in[i];
    a.out = (float*)d_out; a.ws = (unsigned char*)d_ws;
#if MK_SINGLE
    a.ph_lo = 0; a.ph_hi = NPH;
    hipLaunchKernelGGL(fwd_kernel, dim3(grid), dim3(NTHR), LDS_BYTES, stream, a);
#else
    for (int p = 0; p < NPH; ++p) { a.ph_lo = p; a.ph_hi = p + 1; hipLaunchKernelGGL(fwd_kernel, dim3(grid), dim3(NTHR), LDS_BYTES, stream, a); }
#endif
    const hipError_t le = hipPeekAtLastError();
    if (le != hipSuccess) fprintf(stderr, "kernel_launch: launch failed: %s\n", hipGetErrorName(le));
}
```

```cpp
#include <hip/hip_runtime.h>
#include <hip/hip_bf16.h>
#include <cstdio>
#include <cstdint>
#define MK_SINGLE 1
namespace pg8 {
#define PG8_LAS __attribute__((address_space(3)))
typedef unsigned short bf16_t;
typedef short bf16x8 __attribute__((ext_vector_type(8)));
typedef float f32x4 __attribute__((ext_vector_type(4)));
typedef unsigned u32x4 __attribute__((ext_vector_type(4)));
constexpr int BM = 256, BK = 64, HALF = 128, HTB = HALF * BK * 2  , STAGE_BYTES = 8 * HTB, NXCD = 8, WGM = 8;

__host__ __device__ __forceinline__ int lds_byte(int r, int c) { const int st = (r >> 4) * 2 + (c >> 5), rr = r & 15, cc = c & 31, ob = rr * 64 + cc * 2; return st * 1024 + (ob ^ (((ob >> 9) & 1) << 5)); }
__host__ __device__ __forceinline__ void stage_rc(int b, int& R, int& C) { const int st = b / 1024, sb = b % 1024, swz = sb ^ (((sb >> 9) & 1) << 5); R = (st >> 1) * 16 + swz / 64; C = (st & 1) * 32 + (swz % 64) / 2; }
__host__ __device__ __forceinline__ int perm32(int rho) { const int n = rho >> 4, i = rho & 15; return 8 * (i >> 2) + 4 * n + (i & 3); }

struct Unit { int pm, pn; };
struct Gemm { const bf16_t* A; const bf16_t* Bt; int M, N, K; int a_rstep, lda, kwin; };

struct StaticOrder {
    int nM, nN, nwg, G, c;
    __host__ __device__ void init(int M, int N, int G_, int c_) { nM = M / BM; nN = N / BM; nwg = nM * nN; G = G_; c = c_; }
    __host__ __device__ bool next(int i, Unit& u) const {
        const long L = (long)i * G + c; if (L >= nwg) return false;
        int wgid = (int)L; { const int q = nwg / NXCD, r = nwg % NXCD, xcd = wgid % NXCD, off = wgid / NXCD; wgid = (xcd < r ? xcd * (q + 1) : r * (q + 1) + (xcd - r) * q) + off; }
        const int nig = WGM * nN, gid = wgid / nig, fm = gid * WGM, gsz = (nM - fm) < WGM ? (nM - fm) : WGM;
        u.pm = fm + ((wgid % nig) % gsz); u.pn = (wgid % nig) / gsz; return true;
    }
    __device__ __forceinline__ void a_ready(const Unit&) const {}
    __device__ __forceinline__ void done(const Unit&) const {}
};

__device__ __forceinline__ unsigned cvt_pk_bf16(float lo, float hi) { unsigned r; asm volatile("v_cvt_pk_bf16_f32 %0, %1, %2" : "=v"(r) : "v"(lo), "v"(hi)); return r; }
typedef float f32x2 __attribute__((ext_vector_type(2)));
__device__ __forceinline__ f32x2 gelu_pk(f32x2 v) {
    const f32x2 av = __builtin_elementwise_abs(v), d = av * 0.2316418882f + 1.0f;
    f32x2 t; t.x = __builtin_amdgcn_rcpf(d.x); t.y = __builtin_amdgcn_rcpf(d.y);
    f32x2 q = t * 0.5307027145f + (-0.7265760135f); q = q * t + 0.7107068705f; q = q * t + (-0.142248368f); q = q * t + 0.127414796f; q = q * t;
    const f32x2 s = (v * v) * (-0.72134752044f);
    f32x2 e; e.x = __builtin_amdgcn_exp2f(s.x); e.y = __builtin_amdgcn_exp2f(s.y);
    const f32x2 m = v * (q * e), r = v - m;
    f32x2 o; o.x = v.x < 0.f ? m.x : r.x; o.y = v.y < 0.f ? m.y : r.y; return o;
}

template <int ACT  > struct EpiBf16 {
    static constexpr bool PERM = true, AFTER_DRAIN = false; static_assert(ACT == 0 || ACT == 1, "EpiBf16: ACT is 0 (none) or 1 (gelu_pk)");
    bf16_t* O; int ldc; const float* bias; int split_cols; size_t split_stride; float scale0;
    __device__ __forceinline__ void operator()(const f32x4 (&acc)[2][2][4][2], const Unit& u, int wr, int wc, int fr, int fq) const {
        const int row0 = u.pm * BM + wr * 64 + fr; int colt = u.pn * BM; bf16_t* base = O;
        float sc = 1.f; if (split_cols) { const int t = colt / split_cols; base += (size_t)t * split_stride; colt -= t * split_cols; if (t == 0) sc = scale0; }
        const int col0 = colt + wc * 32 + 8 * fq, bcol0 = u.pn * BM + wc * 32 + 8 * fq;
        f32x4 bv[2][2];
#pragma unroll
        for (int bj = 0; bj < 2; ++bj)
#pragma unroll
            for (int n = 0; n < 2; ++n) bv[bj][n] = bias ? *(const f32x4*)(bias + bcol0 + bj * HALF + 4 * n) : (f32x4){0.f, 0.f, 0.f, 0.f};
#pragma unroll
        for (int ai = 0; ai < 2; ++ai)
#pragma unroll
            for (int m = 0; m < 4; ++m) { bf16_t* rowp = base + (size_t)(row0 + ai * HALF + m * 16) * ldc + col0;
#pragma unroll
                for (int bj = 0; bj < 2; ++bj) { f32x4 v0 = acc[ai][bj][m][0] + bv[bj][0], v1 = acc[ai][bj][m][1] + bv[bj][1];
                    if (ACT == 1) { f32x2 a = gelu_pk((f32x2){v0[0], v0[1]}), b = gelu_pk((f32x2){v0[2], v0[3]}), c = gelu_pk((f32x2){v1[0], v1[1]}), d = gelu_pk((f32x2){v1[2], v1[3]});
                        v0 = (f32x4){a.x, a.y, b.x, b.y}; v1 = (f32x4){c.x, c.y, d.x, d.y}; }
                    v0 = v0 * sc; v1 = v1 * sc; u32x4 w; w.x = cvt_pk_bf16(v0[0], v0[1]); w.y = cvt_pk_bf16(v0[2], v0[3]); w.z = cvt_pk_bf16(v1[0], v1[1]); w.w = cvt_pk_bf16(v1[2], v1[3]);
                    *(u32x4*)(rowp + bj * HALF) = w; } }
    }
};
struct EpiResF32 {
    static constexpr bool PERM = false, AFTER_DRAIN = false;
    const float* base; float* C; int ldc; float alpha;
    __device__ __forceinline__ void operator()(const f32x4 (&acc)[2][2][4][2], const Unit& u, int wr, int wc, int fr, int fq) const {
        const int row0 = u.pm * BM + wr * 64 + fr, col0 = u.pn * BM + wc * 32 + 4 * fq;
#pragma unroll
        for (int ai = 0; ai < 2; ++ai)
#pragma unroll
            for (int m = 0; m < 4; ++m) { const size_t off = (size_t)(row0 + ai * HALF + m * 16) * ldc + col0;
#pragma unroll
                for (int bj = 0; bj < 2; ++bj)
#pragma unroll
                    for (int n = 0; n < 2; ++n) { const f32x4 bs = *(const f32x4*)(base + off + bj * HALF + n * 16);
                        *(f32x4*)(C + off + bj * HALF + n * 16) = acc[ai][bj][m][n] + alpha * bs; } }
    }
};
struct EpiConvGlu {
    static constexpr bool PERM = true, AFTER_DRAIN = false;
    bf16_t* ACT; int ldo; const float* cw; const float* cb; PG8_LAS float* xch; int seq, mtok;
    __device__ __forceinline__ void operator()(const f32x4 (&acc)[2][2][4][2], const Unit& u, int wr, int wc, int fr, int fq) const {
        const int lane = fq * 16 + fr, cl = wc * 32 + 8 * fq;
#pragma unroll
        for (int ai = 0; ai < 2; ++ai)
#pragma unroll
            for (int n = 0; n < 2; ++n) {
                if (fr == 0)  *(PG8_LAS f32x4*)(xch + ((ai * 2 + wr) * 2 + 0) * 128 + cl + 4 * n) = acc[ai][0][0][n];
                if (fr == 15) *(PG8_LAS f32x4*)(xch + ((ai * 2 + wr) * 2 + 1) * 128 + cl + 4 * n) = acc[ai][0][3][n]; }
        asm volatile("s_waitcnt lgkmcnt(0)" ::: "memory"); __builtin_amdgcn_s_barrier(); asm volatile("" ::: "memory");
        const int ch0 = u.pn * 128 + cl;
        f32x4 w0[2], w1[2], w2[2], bb[2];
#pragma unroll
        for (int n = 0; n < 2; ++n) { w0[n] = *(const f32x4*)(cw + ch0 + 4 * n); w1[n] = *(const f32x4*)(cw + ldo + ch0 + 4 * n); w2[n] = *(const f32x4*)(cw + 2 * ldo + ch0 + 4 * n); bb[n] = *(const f32x4*)(cb + ch0 + 4 * n); }
        const int srcU = fr > 0 ? lane - 1 : lane + 15, srcD = fr < 15 ? lane + 1 : lane - 15;
#pragma unroll
        for (int ai = 0; ai < 2; ++ai)
#pragma unroll
            for (int m = 0; m < 4; ++m) {
                const int r = ai * HALF + wr * 64 + m * 16 + fr, tok = 254 * u.pm - 1 + r, t = tok & (seq - 1);
                unsigned ow[4];
#pragma unroll
                for (int n = 0; n < 2; ++n) {
                    const f32x4 g = acc[ai][0][m][n], gm = acc[ai][0][m > 0 ? m - 1 : 0][n], gp = acc[ai][0][m < 3 ? m + 1 : 3][n];
                    const f32x4 sU = (fr == 15) ? gm : g, sD = (fr == 0) ? gp : g;
                    f32x4 up, dn;
#pragma unroll
                    for (int j = 0; j < 4; ++j) { up[j] = __shfl(sU[j], srcU, 64); dn[j] = __shfl(sD[j], srcD, 64); }
                    if (m == 0) { const int pa = wr ? ai : ai - 1, pw = wr ^ 1;
                        if (pa >= 0) { const f32x4 e = *(const PG8_LAS f32x4*)(xch + ((pa * 2 + pw) * 2 + 1) * 128 + cl + 4 * n); if (fr == 0) up = e; } }
                    if (m == 3) { const int pa = wr ? ai + 1 : ai, pw = wr ^ 1;
                        if (pa <= 1) { const f32x4 e = *(const PG8_LAS f32x4*)(xch + ((pa * 2 + pw) * 2 + 0) * 128 + cl + 4 * n); if (fr == 15) dn = e; } }
                    if (t == 0) up = (f32x4){0.f, 0.f, 0.f, 0.f};
                    if (t == seq - 1) dn = (f32x4){0.f, 0.f, 0.f, 0.f};
                    const f32x4 cv = bb[n] + w0[n] * up + w1[n] * g + w2[n] * dn, uu = acc[ai][1][m][n];
                    float o[4];
#pragma unroll
                    for (int j = 0; j < 4; ++j) o[j] = cv[j] * __builtin_amdgcn_rcpf(1.f + __expf(-cv[j])) * uu[j];
                    ow[2 * n] = cvt_pk_bf16(o[0], o[1]); ow[2 * n + 1] = cvt_pk_bf16(o[2], o[3]); }
                if (r >= 1 && r <= 254 && tok < mtok) *(u32x4*)(ACT + (size_t)tok * ldo + ch0) = (u32x4){ow[0], ow[1], ow[2], ow[3]};
            }
    }
};
struct EpiResLazy {
    static constexpr bool PERM = false, AFTER_DRAIN = false;
    const float* Rp; const float* st; const float* w; const float* b; float* C; int ldc; float alpha;
    __device__ __forceinline__ void operator()(const f32x4 (&acc)[2][2][4][2], const Unit& u, int wr, int wc, int fr, int fq) const {
        typedef float f32x2v __attribute__((ext_vector_type(2)));
        const int row0 = u.pm * BM + wr * 64 + fr, col0 = u.pn * BM + wc * 32 + 4 * fq;
        f32x4 wv[2][2], bv[2][2];
#pragma unroll
        for (int bj = 0; bj < 2; ++bj)
#pragma unroll
            for (int n = 0; n < 2; ++n) { wv[bj][n] = *(const f32x4*)(w + col0 + bj * HALF + n * 16) * alpha; bv[bj][n] = *(const f32x4*)(b + col0 + bj * HALF + n * 16) * alpha; }
#pragma unroll
        for (int ai = 0; ai < 2; ++ai)
#pragma unroll
            for (int m = 0; m < 4; ++m) { const int row = row0 + ai * HALF + m * 16; const size_t off = (size_t)row * ldc + col0; const f32x2v s = *(const f32x2v*)(st + 2 * row);
#pragma unroll
                for (int bj = 0; bj < 2; ++bj)
#pragma unroll
                    for (int n = 0; n < 2; ++n) { const f32x4 rp = *(const f32x4*)(Rp + off + bj * HALF + n * 16);
                        *(f32x4*)(C + off + bj * HALF + n * 16) = acc[ai][bj][m][n] + ((rp - s.x) * s.y) * wv[bj][n] + bv[bj][n]; } }
    }
};

template <bool RPF32> struct EpiResBf {
    static constexpr bool PERM = true, AFTER_DRAIN = false;
    static constexpr int ldc = 4096; static constexpr float alpha = 1.41421356237309515f;
    const float* RpF; const float* st; const float* w; const float* b; bf16_t* RB;
    __device__ __forceinline__ void operator()(const f32x4 (&acc)[2][2][4][2], const Unit& u, int wr, int wc, int fr, int fq) const {
        typedef float f32x2v __attribute__((ext_vector_type(2)));
        const int row0 = u.pm * BM + wr * 64 + fr, col0 = u.pn * BM + wc * 32 + 8 * fq;
        f32x4 wv[2][2], bv[2][2];
#pragma unroll
        for (int bj = 0; bj < 2; ++bj)
#pragma unroll
            for (int n = 0; n < 2; ++n) { wv[bj][n] = *(const f32x4*)(w + col0 + bj * HALF + 4 * n) * alpha; bv[bj][n] = *(const f32x4*)(b + col0 + bj * HALF + 4 * n) * alpha; }
#pragma unroll
        for (int ai = 0; ai < 2; ++ai)
#pragma unroll
            for (int m = 0; m < 4; ++m) { const int row = row0 + ai * HALF + m * 16; const size_t off = (size_t)row * ldc + col0; const f32x2v s = *(const f32x2v*)(st + 2 * row);
#pragma unroll
                for (int bj = 0; bj < 2; ++bj) { f32x4 r0, r1;
                    if constexpr (RPF32) { r0 = *(const f32x4*)(RpF + off + bj * HALF); r1 = *(const f32x4*)(RpF + off + bj * HALF + 4); }
                    else { const u32x4 pw = *(const u32x4*)(RB + off + bj * HALF);
                        r0 = (f32x4){__uint_as_float(pw.x << 16), __uint_as_float(pw.x & 0xffff0000u), __uint_as_float(pw.y << 16), __uint_as_float(pw.y & 0xffff0000u)};
                        r1 = (f32x4){__uint_as_float(pw.z << 16), __uint_as_float(pw.z & 0xffff0000u), __uint_as_float(pw.w << 16), __uint_as_float(pw.w & 0xffff0000u)}; }
                    const f32x4 v0 = acc[ai][bj][m][0] + ((r0 - s.x) * s.y) * wv[bj][0] + bv[bj][0], v1 = acc[ai][bj][m][1] + ((r1 - s.x) * s.y) * wv[bj][1] + bv[bj][1];
                    u32x4 wd; wd.x = cvt_pk_bf16(v0[0], v0[1]); wd.y = cvt_pk_bf16(v0[2], v0[3]); wd.z = cvt_pk_bf16(v1[0], v1[1]); wd.w = cvt_pk_bf16(v1[2], v1[3]);
                    *(u32x4*)(RB + off + bj * HALF) = wd; } }
    }
};
template <class Epi, class Sched, bool ALIGN_EPI = false, bool SP2 = false>
__device__ __forceinline__ void gemm_phase(PG8_LAS unsigned char* lds, const Gemm g, const Sched& S, const Epi& E) {
    int tid_ = threadIdx.x; asm volatile("" : "+v"(tid_));
    const int tid = tid_, wid = __builtin_amdgcn_readfirstlane(tid >> 6), lane = tid & 63, wr = wid >> 2, wc = wid & 3, fr = lane & 15, fq = lane >> 4;
    const int K = g.K, nt = K / BK, lda = g.lda ? g.lda : g.K;
    unsigned voffA[2], voffB[2];
#pragma unroll
    for (int i = 0; i < 2; ++i) { int R, C; stage_rc(tid * 16 + i * 8192, R, C); const int Rb = Epi::PERM ? ((R & ~31) + perm32(R & 31)) : R;
        voffA[i] = (unsigned)(R * lda + C) * 2u; voffB[i] = (unsigned)(Rb * K + C) * 2u; }
    const size_t kstep = (size_t)(BK * 2);
    const size_t hstep = (size_t)HALF * K * 2;
    const size_t hstepA = (size_t)HALF * lda * 2;
    const size_t tstep = 2 * hstep;
    const size_t tstepA = (size_t)(g.a_rstep ? g.a_rstep : BM) * lda * 2;
    const unsigned ldsw = (unsigned)wid * 1024u;
    const int aoff = lds_byte(wr * 64 + fr, fq * 8), boff = lds_byte(wc * 32 + fr, fq * 8);
#define PG8_SA(b, h) (((b) * 2 + (h)) * HTB)
#define PG8_SB(b, h) ((4 + (b) * 2 + (h)) * HTB)
#define PG8_STAGE(bufoff, gbase, voff) do { _Pragma("unroll") for (int _i = 0; _i < 2; ++_i) \
        __builtin_amdgcn_global_load_lds((const unsigned*)((const char*)(gbase) + (voff)[_i]), (PG8_LAS unsigned*)(lds + (bufoff) + ldsw + _i * 8192), 16, 0, 0); } while (0)
#define PG8_LDA(dst, b, h) do { _Pragma("unroll") for (int m = 0; m < 4; ++m) _Pragma("unroll") for (int k = 0; k < 2; ++k) dst[m][k] = *(const PG8_LAS bf16x8*)(lds + PG8_SA(b, h) + aoff + m * 2048 + k * 1024); } while (0)
#define PG8_LDB(dst, b, h) do { _Pragma("unroll") for (int n = 0; n < 2; ++n) _Pragma("unroll") for (int k = 0; k < 2; ++k) dst[n][k] = *(const PG8_LAS bf16x8*)(lds + PG8_SB(b, h) + boff + n * 2048 + k * 1024); } while (0)
#define PG8_MMA(ai, bj, At, Bt) do { __builtin_amdgcn_s_setprio(1); _Pragma("unroll") for (int m = 0; m < 4; ++m) _Pragma("unroll") for (int n = 0; n < 2; ++n) _Pragma("unroll") for (int k = 0; k < 2; ++k) \
        acc[ai][bj][m][n] = __builtin_amdgcn_mfma_f32_16x16x32_bf16(Bt[n][k], At[m][k], acc[ai][bj][m][n], 0, 0, 0); __builtin_amdgcn_s_setprio(0); } while (0)
#define PG8_WAIT_V(n) asm volatile("s_waitcnt vmcnt(" #n ")" ::: "memory")
#define PG8_WAIT_L(n) asm volatile("s_waitcnt lgkmcnt(" #n ")" ::: "memory")
#define PG8_BAR __builtin_amdgcn_s_barrier()
#define PG8_SCHED __builtin_amdgcn_sched_barrier(0)
    Unit cur, nxt; int ui = 0;
    if (!S.next(0, cur)) return;
    f32x4 acc[2][2][4][2];
#pragma unroll
    for (int a = 0; a < 2; ++a)
#pragma unroll
        for (int b = 0; b < 2; ++b)
#pragma unroll
            for (int m = 0; m < 4; ++m)
#pragma unroll
                for (int n = 0; n < 2; ++n) acc[a][b][m][n] = (f32x4){0.f, 0.f, 0.f, 0.f};
    bf16x8 At[4][2], B0[2][2], B1[2][2];
    const char* cA = (const char*)g.A + (size_t)cur.pm * tstepA + (g.kwin ? (size_t)(cur.pn % g.kwin) * K * 2 : 0); const char* cB = (const char*)g.Bt + (size_t)cur.pn * tstep;
    S.a_ready(cur);
    if constexpr (SP2) {
        PG8_STAGE(PG8_SB(0, 0), cB, voffB); PG8_STAGE(PG8_SB(0, 1), cB + hstep, voffB); PG8_STAGE(PG8_SA(0, 0), cA, voffA); PG8_STAGE(PG8_SA(0, 1), cA + hstepA, voffA);
        if (wr == 1) PG8_BAR;
        PG8_WAIT_V(2); PG8_BAR;
        PG8_STAGE(PG8_SB(1, 0), cB + kstep, voffB); PG8_STAGE(PG8_SA(1, 0), cA + kstep, voffA); PG8_STAGE(PG8_SB(1, 1), cB + hstep + kstep, voffB);
        PG8_WAIT_V(6); PG8_BAR;
    } else {
        PG8_STAGE(PG8_SB(0, 0), cB, voffB); PG8_STAGE(PG8_SA(0, 0), cA, voffA); PG8_STAGE(PG8_SB(0, 1), cB + hstep, voffB); PG8_STAGE(PG8_SA(0, 1), cA + hstepA, voffA);
        if (wr == 1) PG8_BAR;
        PG8_WAIT_V(4); PG8_BAR;
        PG8_STAGE(PG8_SB(1, 0), cB + kstep, voffB); PG8_STAGE(PG8_SA(1, 0), cA + kstep, voffA); PG8_STAGE(PG8_SB(1, 1), cB + hstep + kstep, voffB);
        PG8_WAIT_V(6); PG8_BAR;
    }
    for (;;) {
        const bool has_next = S.next(ui + 1, nxt);
        const char* nA = has_next ? (const char*)g.A + (size_t)nxt.pm * tstepA + (g.kwin ? (size_t)(nxt.pn % g.kwin) * K * 2 : 0) : cA; const char* nB = has_next ? (const char*)g.Bt + (size_t)nxt.pn * tstep : cB;
        for (int t = 0; t < nt; t += 2) {
            const bool last = (t == nt - 2);
            const char* a1 = cA + (size_t)(t + 1) * kstep;
            const char* a2 = last ? nA : cA + (size_t)(t + 2) * kstep; const char* b2 = last ? nB : cB + (size_t)(t + 2) * kstep;
            const char* a3 = a2 + kstep; const char* b3 = b2 + kstep;
            if (last && has_next) S.a_ready(nxt);
            if constexpr (SP2) {
            PG8_LDB(B0, 0, 0); PG8_LDB(B1, 0, 1); PG8_SCHED; PG8_LDA(At, 0, 0); PG8_STAGE(PG8_SA(1, 1), a1 + hstepA, voffA);
            PG8_WAIT_V(8); PG8_WAIT_L(0); PG8_BAR; PG8_MMA(0, 0, At, B0); PG8_MMA(0, 1, At, B1); PG8_BAR; PG8_SCHED;
            PG8_LDA(At, 0, 1); PG8_STAGE(PG8_SB(0, 0), b2, voffB); PG8_STAGE(PG8_SB(0, 1), b2 + hstep, voffB); PG8_STAGE(PG8_SA(0, 0), a2, voffA);
            PG8_WAIT_V(8); PG8_WAIT_L(0); PG8_BAR; PG8_MMA(1, 0, At, B0); PG8_MMA(1, 1, At, B1); PG8_BAR; PG8_SCHED;
            PG8_LDB(B0, 1, 0); PG8_LDB(B1, 1, 1); PG8_SCHED; PG8_LDA(At, 1, 0); PG8_STAGE(PG8_SA(0, 1), a2 + hstepA, voffA);
            PG8_WAIT_V(8); PG8_WAIT_L(0); PG8_BAR; PG8_MMA(0, 0, At, B0); PG8_MMA(0, 1, At, B1); PG8_BAR; PG8_SCHED;
            PG8_LDA(At, 1, 1); PG8_STAGE(PG8_SB(1, 0), b3, voffB); PG8_STAGE(PG8_SB(1, 1), b3 + hstep, voffB); PG8_STAGE(PG8_SA(1, 0), a3, voffA);
            PG8_WAIT_V(8); PG8_WAIT_L(0); PG8_BAR; PG8_MMA(1, 0, At, B0); PG8_MMA(1, 1, At, B1); PG8_BAR; PG8_SCHED;
            } else {
            PG8_LDB(B0, 0, 0); PG8_SCHED; PG8_LDA(At, 0, 0); PG8_STAGE(PG8_SA(1, 1), a1 + hstepA, voffA);
            PG8_WAIT_L(8); PG8_BAR; PG8_WAIT_L(0); PG8_MMA(0, 0, At, B0); PG8_BAR; PG8_SCHED;
            PG8_LDB(B1, 0, 1); PG8_STAGE(PG8_SB(0, 0), b2, voffB);
            PG8_BAR; PG8_WAIT_L(0); PG8_MMA(0, 1, At, B1); PG8_BAR;
            PG8_LDA(At, 0, 1); PG8_STAGE(PG8_SA(0, 0), a2, voffA);
            PG8_BAR; PG8_WAIT_L(0); PG8_MMA(1, 0, At, B0); PG8_BAR; PG8_SCHED;
            PG8_STAGE(PG8_SB(0, 1), b2 + hstep, voffB);
            PG8_WAIT_V(6); PG8_BAR; PG8_MMA(1, 1, At, B1); PG8_BAR;
            PG8_LDB(B0, 1, 0); PG8_SCHED; PG8_LDA(At, 1, 0); PG8_STAGE(PG8_SA(0, 1), a2 + hstepA, voffA);
            PG8_WAIT_L(8); PG8_BAR; PG8_WAIT_L(0); PG8_MMA(0, 0, At, B0); PG8_BAR; PG8_SCHED;
            PG8_LDB(B1, 1, 1); PG8_STAGE(PG8_SB(1, 0), b3, voffB);
            PG8_BAR; PG8_WAIT_L(0); PG8_MMA(0, 1, At, B1); PG8_BAR;
            PG8_LDA(At, 1, 1); PG8_STAGE(PG8_SA(1, 0), a3, voffA);
            PG8_BAR; PG8_WAIT_L(0); PG8_MMA(1, 0, At, B0); PG8_BAR; PG8_SCHED;
            PG8_STAGE(PG8_SB(1, 1), b3 + hstep, voffB);
            PG8_WAIT_V(6); PG8_BAR; PG8_MMA(1, 1, At, B1); PG8_BAR;
            }
        }
        if constexpr (ALIGN_EPI) { if (wr == 0) PG8_BAR; }
        if constexpr (!Epi::AFTER_DRAIN) { E(acc, cur, wr, wc, fr, fq); S.done(cur); }
        if (!has_next) break;
#pragma unroll
        for (int a = 0; a < 2; ++a)
#pragma unroll
            for (int b = 0; b < 2; ++b)
#pragma unroll
                for (int m = 0; m < 4; ++m)
#pragma unroll
                    for (int n = 0; n < 2; ++n) acc[a][b][m][n] = (f32x4){0.f, 0.f, 0.f, 0.f};
        cur = nxt; cA = nA; cB = nB; ++ui;
        if constexpr (ALIGN_EPI) { if (wr == 1) PG8_BAR; }
    }
    PG8_WAIT_V(0);
    if constexpr (!ALIGN_EPI) { if (wr == 0) PG8_BAR; }
    PG8_BAR;
    if constexpr (Epi::AFTER_DRAIN) { E.fused(acc, cur, wr, wc, fr, fq, lds, wid, lane); S.done(cur); }
#undef PG8_SA
#undef PG8_SB
#undef PG8_STAGE
#undef PG8_LDA
#undef PG8_LDB
#undef PG8_MMA
#undef PG8_WAIT_V
#undef PG8_WAIT_L
#undef PG8_BAR
#undef PG8_SCHED
}
}
namespace attn {
using bf16 = __hip_bfloat16;
constexpr int   D = 128, NW = 8, QBLK = 32, KVBLK = 64;
constexpr float SCALE = 0.088388347648318440f;
constexpr float THR = 8.f;
constexpr int SDEPTH = 2;
constexpr int LDQ = 10240, LDK = 10240, LDO = 4096;
constexpr size_t SHM_V = KVBLK * D * 2, SHM_K = KVBLK * D * 2, SHM_ATTN = 2 * SHM_V + 2 * SHM_K + NW * 64 * 4;
using bf16x8 = __attribute__((ext_vector_type(8))) short;
using s16x4  = __attribute__((ext_vector_type(4))) short;
using f32x16 = __attribute__((ext_vector_type(16))) float;
using f32x8  = __attribute__((ext_vector_type(8))) float;
using u32x4  = __attribute__((ext_vector_type(4))) unsigned;
#define KSWZ(row, colB) ((row) * 256 + ((colB) ^ (((row) & 7) << 4)))
#define SBAR() __builtin_amdgcn_sched_barrier(0)
__device__ __forceinline__ int crow(int r, int hi) { return (r & 3) + 8 * (r >> 2) + 4 * hi; }
__device__ __forceinline__ unsigned cvtpk(float lo, float hi) {
  unsigned r; asm volatile("v_cvt_pk_bf16_f32 %0, %1, %2" : "=v"(r) : "v"(lo), "v"(hi)); return r;
}
template <typename TIn> struct Stage;
template <> struct Stage<bf16>  { using T = bf16x8;
  __device__ static __forceinline__ T ld8(const bf16* p) { return *reinterpret_cast<const bf16x8*>(p); }
  __device__ static __forceinline__ bf16x8 tobf(T x) { return x; } };
template <> struct Stage<float> { using T = f32x8;
  __device__ static __forceinline__ T ld8(const float* p) { return *reinterpret_cast<const f32x8*>(p); }
  __device__ static __forceinline__ bf16x8 tobf(T x) {
    u32x4 w = {cvtpk(x[0], x[1]), cvtpk(x[2], x[3]), cvtpk(x[4], x[5]), cvtpk(x[6], x[7])}; return *reinterpret_cast<bf16x8*>(&w); } };

__device__ __forceinline__ void partialSM(f32x16& p0, f32x16& p1, float& m_reg, float& mn, float& alpha) {
  constexpr float C = SCALE * 1.4426950408889634f;
  float pmax = p0[0]; for (int r = 1; r < 16; ++r) pmax = fmaxf(pmax, p0[r]); for (int r = 0; r < 16; ++r) pmax = fmaxf(pmax, p1[r]);
  { auto rr = __builtin_amdgcn_permlane32_swap(__float_as_uint(pmax), __float_as_uint(pmax), false, false);
    pmax = fmaxf(__uint_as_float(rr[0]), __uint_as_float(rr[1])); }
  if (__builtin_expect(__all(pmax - m_reg <= THR / SCALE), 1)) { mn = m_reg; alpha = 1.f; }
  else { mn = fmaxf(m_reg, pmax); alpha = __builtin_amdgcn_exp2f((m_reg - mn) * C); m_reg = mn; }
  float mnC = -mn * C;
  for (int r = 0; r < 16; ++r) p0[r] = fmaf(p0[r], C, mnC); for (int r = 0; r < 16; ++r) p1[r] = fmaf(p1[r], C, mnC);
  for (int r = 0; r < 16; ++r) p0[r] = __builtin_amdgcn_exp2f(p0[r]);
}
__device__ __forceinline__ void finishSM(f32x16& p0, f32x16& p1, float alpha, float& l_reg, bf16x8& pa0, bf16x8& pa1, bf16x8& pa2, bf16x8& pa3) {
  for (int r = 0; r < 16; ++r) p1[r] = __builtin_amdgcn_exp2f(p1[r]);
  float ps = 0; for (int r = 0; r < 16; ++r) ps += p0[r]; for (int r = 0; r < 16; ++r) ps += p1[r];
  { auto rr = __builtin_amdgcn_permlane32_swap(__float_as_uint(ps), __float_as_uint(ps), false, false);
    ps = __uint_as_float(rr[0]) + __uint_as_float(rr[1]); }
  l_reg = l_reg * alpha + ps;
#define PK4(P, BASE, OUT) do { unsigned a0 = cvtpk(P[BASE + 0], P[BASE + 1]), a1 = cvtpk(P[BASE + 2], P[BASE + 3]);   \
    unsigned b0 = cvtpk(P[BASE + 4], P[BASE + 5]), b1 = cvtpk(P[BASE + 6], P[BASE + 7]);                              \
    auto r0 = __builtin_amdgcn_permlane32_swap(a0, b0, false, false); auto r1 = __builtin_amdgcn_permlane32_swap(a1, b1, false, false); \
    u32x4 w = {r0[0], r1[0], r0[1], r1[1]}; OUT = *reinterpret_cast<bf16x8*>(&w); } while (0)
  PK4(p0, 0, pa0); PK4(p0, 8, pa1); PK4(p1, 0, pa2); PK4(p1, 8, pa3);
#undef PK4
}
__device__ __forceinline__ void qkt(f32x16& p0, f32x16& p1, const bf16* Ks, const bf16x8* qr, int r32, int hi) {
  p0 = f32x16{}; p1 = f32x16{};
  for (int d0 = 0; d0 < 8; ++d0) { int cb = (d0 * 16 + hi * 8) * 2;
    bf16x8 b0 = *reinterpret_cast<const bf16x8*>((const char*)Ks + KSWZ(r32, cb));
    bf16x8 b1 = *reinterpret_cast<const bf16x8*>((const char*)Ks + KSWZ(32 + r32, cb));
    p0 = __builtin_amdgcn_mfma_f32_32x32x16_bf16(b0, qr[d0], p0, 0, 0, 0);
    p1 = __builtin_amdgcn_mfma_f32_32x32x16_bf16(b1, qr[d0], p1, 0, 0, 0); }
}
__device__ __forceinline__ int v_st(int k, int c) { const int kk = (k & ~0xC) | ((k & 4) << 1) | ((k & 8) >> 1); return ((kk >> 3) * 4 + (c >> 5)) * 512 + ((kk & 7) * 32 + (c & 31)) * 2; }
__device__ __forceinline__ int v_rd_base(int lane) { return ((lane & 3) << 3) | (((lane >> 2) & 3) << 6) | (((lane >> 4) & 1) << 5) | (((lane >> 5) & 1) << 8); }
constexpr int v_rd_off(int d0, int ks, int half) { return d0 * 512 + ks * 4096 + half * 2048; }
template <int OFF> __device__ __forceinline__ s16x4 tr_read(int vb) {
  s16x4 r; asm volatile("ds_read_b64_tr_b16 %0, %1 offset:%2" : "=&v"(r) : "v"(vb), "i"(OFF) : "memory"); return r;
}
template <int D0> __device__ __forceinline__ void pv_one(f32x16& od, int vb, bf16x8 pa0, bf16x8 pa1, bf16x8 pa2, bf16x8 pa3) {
  const s16x4 l0 = tr_read<v_rd_off(D0, 0, 0)>(vb), h0 = tr_read<v_rd_off(D0, 0, 1)>(vb), l1 = tr_read<v_rd_off(D0, 1, 0)>(vb), h1 = tr_read<v_rd_off(D0, 1, 1)>(vb);
  const s16x4 l2 = tr_read<v_rd_off(D0, 2, 0)>(vb), h2 = tr_read<v_rd_off(D0, 2, 1)>(vb), l3 = tr_read<v_rd_off(D0, 3, 0)>(vb), h3 = tr_read<v_rd_off(D0, 3, 1)>(vb);
  asm volatile("s_waitcnt lgkmcnt(0)" ::: "memory"); SBAR();
#define PK(L, H) (bf16x8){L[0], L[1], L[2], L[3], H[0], H[1], H[2], H[3]}
  od = __builtin_amdgcn_mfma_f32_32x32x16_bf16(pa0, PK(l0, h0), od, 0, 0, 0);
  od = __builtin_amdgcn_mfma_f32_32x32x16_bf16(pa1, PK(l1, h1), od, 0, 0, 0);
  od = __builtin_amdgcn_mfma_f32_32x32x16_bf16(pa2, PK(l2, h2), od, 0, 0, 0);
  od = __builtin_amdgcn_mfma_f32_32x32x16_bf16(pa3, PK(l3, h3), od, 0, 0, 0);
#undef PK
}
__device__ __forceinline__ void pv_d0(f32x16* o, int vb, bf16x8 pa0, bf16x8 pa1, bf16x8 pa2, bf16x8 pa3) {
  pv_one<0>(o[0], vb, pa0, pa1, pa2, pa3); pv_one<1>(o[1], vb, pa0, pa1, pa2, pa3); pv_one<2>(o[2], vb, pa0, pa1, pa2, pa3); pv_one<3>(o[3], vb, pa0, pa1, pa2, pa3);
}

template <typename TQ>
__device__ __forceinline__ void attn_dense_body(const TQ* __restrict__ Qb, const bf16* __restrict__ Kh, const bf16* __restrict__ Vh,
                                                bf16* __restrict__ Ob, int seq, char* lds) {
  using St = Stage<bf16>; using SQ = Stage<TQ>;
  int tid_ = threadIdx.x; asm volatile("" : "+v"(tid_));
  const int tid = tid_, wid = tid >> 6, lane = tid & 63, r32 = lane & 31, hi = lane >> 5;
  bf16* V_lds = (bf16*)lds; bf16* K_lds = (bf16*)(lds + 2 * SHM_V);
  float* ws = (float*)(lds + 2 * SHM_V + 2 * SHM_K) + wid * 64; float* li_l = ws; float* al_l = ws + 32;
  float m_reg = -1e30f, l_reg = 0; f32x16 o[4] = {}; bf16x8 qr[8];
  const TQ* Qw = Qb + (long)(wid * QBLK + r32) * LDQ + hi * 8;
#pragma unroll
  for (int d0 = 0; d0 < 8; ++d0) qr[d0] = SQ::tobf(SQ::ld8(Qw + d0 * 16));
  const int sr = tid >> 4, sc = (tid & 15) * 8, vst0 = v_st(sr, sc), vst1 = v_st(32 + sr, sc);
  const int vb0 = (int)(uintptr_t)V_lds + v_rd_base(lane);
  struct { typename St::T vs0, vs1, ks0, ks1; } sr_[SDEPTH];
#define SLOAD(i, k0) do { sr_[i].vs0 = St::ld8(&Vh[(long)((k0) + sr) * LDK + sc]); sr_[i].vs1 = St::ld8(&Vh[(long)((k0) + 32 + sr) * LDK + sc]); \
    sr_[i].ks0 = St::ld8(&Kh[(long)((k0) + sr) * LDK + sc]); sr_[i].ks1 = St::ld8(&Kh[(long)((k0) + 32 + sr) * LDK + sc]); } while (0)
#define SWRITE(b, i) do { *(bf16x8*)((char*)V_lds + (b) * SHM_V + vst0) = St::tobf(sr_[i].vs0);          \
    *(bf16x8*)((char*)V_lds + (b) * SHM_V + vst1) = St::tobf(sr_[i].vs1); int kc = sc * 2;               \
    *(bf16x8*)((char*)K_lds + (b) * SHM_K + KSWZ(sr, kc)) = St::tobf(sr_[i].ks0);                       \
    *(bf16x8*)((char*)K_lds + (b) * SHM_K + KSWZ(32 + sr, kc)) = St::tobf(sr_[i].ks1); } while (0)
#define SWAIT() do { if constexpr (SDEPTH == 2) asm volatile("s_waitcnt vmcnt(4)" ::: "memory"); else asm volatile("s_waitcnt vmcnt(0)" ::: "memory"); } while (0)
#define RESC(a) do { if (__any((a) < 1.f)) { if (hi == 0) al_l[r32] = (a); asm volatile("s_waitcnt lgkmcnt(0)" ::: "memory"); \
    for (int d = 0; d < 4; ++d) for (int r = 0; r < 16; ++r) o[d][r] *= al_l[crow(r, hi)]; } } while (0)
  f32x16 pA0, pA1, pB0, pB1; float mnA, mnB, alA, alB; bf16x8 pa0, pa1, pa2, pa3; const int NT = seq / KVBLK;
  constexpr int SE = 0, SO = SDEPTH - 1;
  SLOAD(SE, 0); asm volatile("s_waitcnt vmcnt(0)" ::: "memory"); SWRITE(0, SE); __syncthreads();
  qkt(pA0, pA1, K_lds, qr, r32, hi); partialSM(pA0, pA1, m_reg, mnA, alA);
  SLOAD(SO, KVBLK); if constexpr (SDEPTH == 2) { if (2 < NT) SLOAD(SE, 2 * KVBLK); }
  SWAIT(); SWRITE(1, SO); __syncthreads();
  for (int j = 1; j + 1 < NT; j += 2) {
    SBAR(); qkt(pB0, pB1, (bf16*)((char*)K_lds + SHM_K), qr, r32, hi);
    finishSM(pA0, pA1, alA, l_reg, pa0, pa1, pa2, pa3); SBAR();
    SLOAD(SO, (j + SDEPTH) * KVBLK); SBAR();
    pv_d0(o, vb0, pa0, pa1, pa2, pa3); partialSM(pB0, pB1, m_reg, mnB, alB);
    __syncthreads(); SWAIT(); SWRITE(0, SE);
    RESC(alB); __syncthreads();
    SBAR(); qkt(pA0, pA1, K_lds, qr, r32, hi);
    finishSM(pB0, pB1, alB, l_reg, pa0, pa1, pa2, pa3); SBAR();
    if (SDEPTH == 1 || j + 3 < NT) SLOAD(SE, (j + 1 + SDEPTH) * KVBLK); SBAR();
    pv_d0(o, vb0 + (int)SHM_V, pa0, pa1, pa2, pa3); partialSM(pA0, pA1, m_reg, mnA, alA);
    __syncthreads(); SWAIT(); SWRITE(1, SO);
    RESC(alA); __syncthreads();
  }
  SBAR(); qkt(pB0, pB1, (bf16*)((char*)K_lds + SHM_K), qr, r32, hi);
  finishSM(pA0, pA1, alA, l_reg, pa0, pa1, pa2, pa3); SBAR();
  pv_d0(o, vb0, pa0, pa1, pa2, pa3); partialSM(pB0, pB1, m_reg, mnB, alB);
  __syncthreads(); RESC(alB);
  finishSM(pB0, pB1, alB, l_reg, pa0, pa1, pa2, pa3); SBAR();
  pv_d0(o, vb0 + (int)SHM_V, pa0, pa1, pa2, pa3);
  if (hi == 0) li_l[r32] = l_reg; asm volatile("s_waitcnt lgkmcnt(0)" ::: "memory");
  float rli[16];
#pragma unroll
  for (int r = 0; r < 16; ++r) rli[r] = __builtin_amdgcn_rcpf(li_l[crow(r, hi)]);
  bf16* Ow = Ob + (long)(wid * QBLK) * LDO;
#pragma unroll
  for (int r = 0; r < 16; ++r) { int orow = crow(r, hi);
    for (int d0 = 0; d0 < 4; ++d0) Ow[(long)orow * LDO + d0 * 32 + r32] = __float2bfloat16(o[d0][r] * rli[r]); }
#undef SLOAD
#undef SWRITE
#undef SWAIT
#undef RESC
}
}
#define GAS __attribute__((address_space(1)))
#define LAS __attribute__((address_space(3)))
typedef unsigned short bf16;
typedef unsigned v4u __attribute__((ext_vector_type(4)));
typedef float f32x4 __attribute__((ext_vector_type(4)));
typedef short bf16x8 __attribute__((ext_vector_type(8)));
typedef GAS unsigned gu32;
typedef GAS unsigned long long gu64;
#define RLX_AGENT __ATOMIC_RELAXED, __HIP_MEMORY_SCOPE_AGENT
#define LDS_WAIT() asm volatile("s_waitcnt lgkmcnt(0)" ::: "memory")
#define VM_WAIT() asm volatile("s_waitcnt vmcnt(0)" ::: "memory")
__device__ __forceinline__ unsigned long long rt() { return __builtin_amdgcn_s_memrealtime(); }
__device__ __forceinline__ unsigned f2bf(float f) { unsigned u = __builtin_bit_cast(unsigned, f); return (u + 0x7fffu + ((u >> 16) & 1u)) >> 16; }
__device__ __forceinline__ unsigned pk2(float lo, float hi) { return f2bf(lo) | (f2bf(hi) << 16); }

#define XB_TMO      128
#define XB_XCNT(j)  (256  + 64 * (j))
#define XB_XSUB(j)  (1280 + 64 * (j))
#define XB_XGEN(j)  (2304 + 64 * (j))
#define XB_TOP      3328
#define XB_TOPGEN   3392
#define XCD_BAR_WORDS 3456
#define XB_SPIN_CAP (1u << 18)

__device__ __forceinline__ unsigned xb_ld(unsigned* p)              { return __hip_atomic_load(p, __ATOMIC_RELAXED, __HIP_MEMORY_SCOPE_AGENT); }
__device__ __forceinline__ unsigned xb_add(unsigned* p, unsigned v) { return __hip_atomic_fetch_add(p, v, __ATOMIC_RELAXED, __HIP_MEMORY_SCOPE_AGENT); }
__device__ __forceinline__ unsigned xb_xcc_id() { return (unsigned)__builtin_amdgcn_s_getreg((3 << 11) | 20) & 0xFu; }
#define XB_SPIN(cond, bar) do { unsigned _sp = 0; while (cond) { __builtin_amdgcn_s_sleep(1); \
    if ((++_sp & 255u) == 0u) { if (xb_ld(&(bar)[XB_TMO])) break; if (_sp > XB_SPIN_CAP) { atomicAdd(&(bar)[XB_TMO], 1u); break; } } } } while (0)

struct XcdBarrier {
    unsigned* bar; unsigned x;
    volatile LAS unsigned* st;
};

__device__ __forceinline__ XcdBarrier xcd_barrier_post(unsigned* bar, volatile LAS unsigned* st) {
    XcdBarrier b; b.bar = bar; b.x = xb_xcc_id(); b.st = st;
    if (threadIdx.x == 0) (void)xb_add(&bar[XB_XCNT(b.x)], 1u);
    return b;
}
__device__ __forceinline__ void xcd_barrier_complete(unsigned* bar, unsigned x, unsigned& nloc, unsigned& nx) {
    const unsigned G = gridDim.x * gridDim.y * gridDim.z;
    unsigned sum, cnt, mine, sp = 0u;
    for (;;) {
        sum = 0u; cnt = 0u; mine = 0u;
#pragma unroll
        for (unsigned j = 0; j < 16; ++j) { const unsigned c = xb_ld(&bar[XB_XCNT(j)]); sum += c; cnt += (c > 0u) ? 1u : 0u; mine = (j == x) ? c : mine; }
        if (sum == G) break;
        __builtin_amdgcn_s_sleep(1);
        if ((++sp & 255u) == 0u) { if (xb_ld(&bar[XB_TMO])) break; if (sp > XB_SPIN_CAP) { atomicAdd(&bar[XB_TMO], 1u); break; } }
    }
    nloc = mine > 0u ? mine : 1u; nx = cnt > 0u ? cnt : 1u;
}

__device__ __forceinline__ void xcd_barrier(const XcdBarrier& b) {
    asm volatile("s_waitcnt vmcnt(0)" ::: "memory");
    __syncthreads();
    if (threadIdx.x == 0) {
        unsigned* bar = b.bar;
        __builtin_amdgcn_s_waitcnt(0);
        unsigned nloc = b.st[0], nx = b.st[1];
        if (nloc == 0u) { xcd_barrier_complete(bar, b.x, nloc, nx); b.st[0] = nloc; b.st[1] = nx; }
        const unsigned old = xb_add(&bar[XB_XSUB(b.x)], 1u);
        const unsigned gen = old / nloc;
        if (old + 1u == (gen + 1u) * nloc) {
            __builtin_amdgcn_fence(__ATOMIC_RELEASE, "agent");
            asm volatile("s_waitcnt vmcnt(0)" ::: "memory");
            const unsigned og = xb_add(&bar[XB_TOP], 1u);
            const unsigned tg = og / nx;
            if (og + 1u == (tg + 1u) * nx) xb_add(&bar[XB_TOPGEN], 1u);
            else XB_SPIN(xb_ld(&bar[XB_TOPGEN]) == tg, bar);
            __builtin_amdgcn_fence(__ATOMIC_ACQUIRE, "agent");
            xb_add(&bar[XB_XGEN(b.x)], 1u);
            asm volatile("s_waitcnt vmcnt(0)" ::: "memory");
        } else {
            XB_SPIN(xb_ld(&bar[XB_XGEN(b.x)]) == gen, bar);
            __builtin_amdgcn_fence(__ATOMIC_ACQUIRE, "agent");
            asm volatile("s_waitcnt vmcnt(0)" ::: "memory");
        }
    }
    __syncthreads();
}

constexpr int NWAVES = 8, NTHR = NWAVES * 64;
constexpr int BATCH = 8, SEQ = 2048, M = BATCH * SEQ, DM = 4096, NU = 10240, FF = 11008, NG = 2 * FF, HD = 128;
constexpr int AW = 1024, BW = 1024;
constexpr int UA_Q = 0, UA_FF = 1024, UA_FB = 2048, UA_I = 3072, UA_G = 4096, UB_X = 5120, UB_GATE = 6144, UC_Q = 7168, UC_K = 9216, UC_V = 9728;
constexpr float LN_EPS = 1e-5f, RMS_EPS = 1e-6f, DN_ALPHA = 1.41421356237309515f;
#ifndef MK_SINGLE
#define MK_SINGLE 1
#endif
constexpr int PH_PER_LAYER = 11, NPH = 1 + 2 * PH_PER_LAYER;

constexpr size_t MiB = 1u << 20;
constexpr size_t WS_CTL = 0, CTL_ZERO_BYTES = 1 * MiB;
constexpr size_t SZ_WIN = (size_t)NU * DM * 2, SZ_WOUT = (size_t)DM * DM * 2, SZ_WUP = (size_t)NG * DM * 2, SZ_WDN = (size_t)DM * FF * 2, SZ_WRG = (size_t)4096 * 1024 * 2;
constexpr size_t WS_WIN = 1 * MiB, WS_WOUT = WS_WIN + 2 * SZ_WIN, WS_WUP = WS_WOUT + 2 * SZ_WOUT, WS_WDN = WS_WUP + 2 * SZ_WUP, WS_WRG = WS_WDN + 2 * SZ_WDN, WS_TAB = WS_WRG + 2 * SZ_WRG;
constexpr size_t WS_ST = WS_TAB + 65536;
constexpr size_t WS_GU = WS_TAB + 1 * MiB;
constexpr size_t SZ_GU = (size_t)M * NG * 2;
constexpr size_t WS_U = WS_GU;
constexpr size_t WS_R = WS_GU + 384 * MiB;
constexpr size_t WS_ACT = WS_GU + SZ_GU;
constexpr size_t SZ_ACT = (size_t)M * FF * 2;
constexpr size_t WS_XC = WS_ACT, WS_G = WS_XC + 32 * MiB, WS_HF = WS_G + 128 * MiB, WS_OF = WS_HF + 64 * MiB, WS_OB = WS_OF + 64 * MiB, WS_HBK = WS_OB + 64 * MiB;
constexpr size_t WS_Y = WS_ACT + ((SZ_ACT > 416 * MiB) ? SZ_ACT : 416 * MiB);
constexpr size_t WS_HB = WS_Y + 128 * MiB;
constexpr size_t WS_END = WS_HB + 128 * MiB;
static_assert(WS_HBK + 64 * MiB <= WS_Y && WS_R + 256 * MiB <= WS_ACT && WS_U + (size_t)M * NU * 2 <= WS_R, "d_ws map");
constexpr int CW_BAR = 4096;
constexpr int CW_QUEUE = 8192;

constexpr int RING_BYTES = 131072, MISC_OFF = RING_BYTES + 320, LDS_BYTES = 147456;

__device__ __forceinline__ float bf2f(bf16 b) { return __uint_as_float((unsigned)b << 16); }
__device__ __forceinline__ float sigm(float x) { return __builtin_amdgcn_rcpf(1.f + __expf(-x)); }
__device__ __forceinline__ float gelu_tanh(float x) { const float y = 0.7978845608028654f * (x + 0.044715f * x * x * x); const float t = 1.f - 2.f * __builtin_amdgcn_rcpf(1.f + __expf(2.f * y)); return 0.5f * x * (1.f + t); }
__device__ __forceinline__ int fresh_tid() { int t = threadIdx.x; asm volatile("" : "+v"(t)); return t; }
__device__ __forceinline__ float wave_sum(float v) {
#pragma unroll
    for (int o = 1; o < 64; o <<= 1) v += __shfl_xor(v, o);
    return v;
}

struct Args { const float* in[24]; float* out; unsigned char* ws; int ph_lo, ph_hi, pad0, pad1; };
struct Frame {
    LAS unsigned char* lds;
    volatile LAS unsigned* MISC;
    gu32* ctl;
    int tid, lane, wave, G, gw, NGW;
    float* H;
    unsigned char* ws;
};
#define WSP(T, off) ((T*)(F.ws + (off)))

template <bool GLU> __device__ __forceinline__ void p0_transpose_item(const float* W, int K, int N, bf16* WT, LAS float* scr, int item, int lane) {
    const int nblk = N / 32, kb = item / nblk, nb = item % nblk, k0 = 64 * kb, n0 = 32 * nb;
    const int nd0 = GLU ? ((n0 < FF) ? ((n0 >> 7) * 256 + (n0 & 127)) : (((n0 - FF) >> 7) * 256 + 128 + ((n0 - FF) & 127))) : n0;
    { f32x4 v[8]; const int kr = lane >> 3, n4 = (lane & 7) * 4;
#pragma unroll
      for (int i = 0; i < 8; ++i) v[i] = __builtin_nontemporal_load((const GAS f32x4*)(W + (size_t)(k0 + 8 * i + kr) * N + n0 + n4));
#pragma unroll
      for (int i = 0; i < 8; ++i) { LAS float* d = scr + (8 * i + kr) * 33 + n4; d[0] = v[i].x; d[1] = v[i].y; d[2] = v[i].z; d[3] = v[i].w; } }
    LDS_WAIT(); asm volatile("" ::: "memory");
    const int c = lane & 7;
#pragma unroll
    for (int j = 0; j < 4; ++j) { const int n = (lane >> 3) + 8 * j; const LAS float* s = scr + (8 * c) * 33 + n;
        v4u o; o.x = pk2(s[0 * 33], s[1 * 33]); o.y = pk2(s[2 * 33], s[3 * 33]); o.z = pk2(s[4 * 33], s[5 * 33]); o.w = pk2(s[6 * 33], s[7 * 33]);
        *(GAS v4u*)(WT + (size_t)(nd0 + n) * K + k0 + 8 * c) = o; }
    LDS_WAIT(); asm volatile("" ::: "memory");
}

__device__ __forceinline__ void ln_row(const float* src, const float* w, const float* b, float* dstF, bf16* dstB, float* st, int lane) {
    const GAS f32x4* xr = (const GAS f32x4*)src + lane;
    f32x4 v[16]; float s = 0.f;
#pragma unroll
    for (int j = 0; j < 16; ++j) { v[j] = xr[64 * j]; s += (v[j].x + v[j].y) + (v[j].z + v[j].w); }
    const float mean = wave_sum(s) * (1.f / DM); float s2 = 0.f;
#pragma unroll
    for (int j = 0; j < 16; ++j) { v[j] = v[j] - mean; s2 += (v[j].x * v[j].x + v[j].y * v[j].y) + (v[j].z * v[j].z + v[j].w * v[j].w); }
    const float rstd = 1.f / sqrtf(wave_sum(s2) * (1.f / DM) + LN_EPS);
    if (st && lane == 0) { st[0] = mean; st[1] = rstd; }
    GAS f32x4* of = (GAS f32x4*)dstF + lane; GAS unsigned long long* ob = (GAS unsigned long long*)dstB + lane;
    const GAS f32x4* wv = (const GAS f32x4*)w + lane; const GAS f32x4* bv = (const GAS f32x4*)b + lane;
#pragma unroll
    for (int j = 0; j < 16; ++j) { const f32x4 o = v[j] * rstd * wv[64 * j] + bv[64 * j]; if (dstF) of[64 * j] = o;
        if (dstB) ob[64 * j] = (unsigned long long)pk2(o.x, o.y) | ((unsigned long long)pk2(o.z, o.w) << 32); }
}
__device__ __forceinline__ void ln_row_bf(const bf16* src, const float* w, const float* b, float* dstF, bf16* dstB, float* st, int lane) {
    const GAS v4u* xr = (const GAS v4u*)src + lane;
    f32x4 v[16]; float s = 0.f;
#pragma unroll
    for (int j = 0; j < 8; ++j) { const v4u pw = xr[64 * j];
        v[2 * j] = (f32x4){__uint_as_float(pw.x << 16), __uint_as_float(pw.x & 0xffff0000u), __uint_as_float(pw.y << 16), __uint_as_float(pw.y & 0xffff0000u)};
        v[2 * j + 1] = (f32x4){__uint_as_float(pw.z << 16), __uint_as_float(pw.z & 0xffff0000u), __uint_as_float(pw.w << 16), __uint_as_float(pw.w & 0xffff0000u)};
        s += ((v[2 * j].x + v[2 * j].y) + (v[2 * j].z + v[2 * j].w)) + ((v[2 * j + 1].x + v[2 * j + 1].y) + (v[2 * j + 1].z + v[2 * j + 1].w)); }
    const float mean = wave_sum(s) * (1.f / DM); float s2 = 0.f;
#pragma unroll
    for (int j = 0; j < 16; ++j) { v[j] = v[j] - mean; s2 += (v[j].x * v[j].x + v[j].y * v[j].y) + (v[j].z * v[j].z + v[j].w * v[j].w); }
    const float rstd = 1.f / sqrtf(wave_sum(s2) * (1.f / DM) + LN_EPS);
    if (st && lane == 0) { st[0] = mean; st[1] = rstd; }
    GAS f32x4* of = (GAS f32x4*)dstF + 2 * lane; GAS v4u* ob = (GAS v4u*)dstB + lane;
    const GAS f32x4* wv = (const GAS f32x4*)w + 2 * lane; const GAS f32x4* bv = (const GAS f32x4*)b + 2 * lane;
#pragma unroll
    for (int j = 0; j < 8; ++j) { const f32x4 o0 = v[2 * j] * rstd * wv[128 * j] + bv[128 * j], o1 = v[2 * j + 1] * rstd * wv[128 * j + 1] + bv[128 * j + 1];
        if (dstF) { of[128 * j] = o0; of[128 * j + 1] = o1; }
        if (dstB) ob[64 * j] = (v4u){pk2(o0.x, o0.y), pk2(o0.z, o0.w), pk2(o1.x, o1.y), pk2(o1.z, o1.w)}; }
}
__device__ __forceinline__ void ln_phase_bf(Frame& F, const bf16* src, const float* w, const float* b, float* dstF, bf16* dstB, float* st) {
    const int lane = fresh_tid() & 63;
    for (int m = F.gw; m < M; m += F.NGW) ln_row_bf(src + (size_t)m * DM, w, b, dstF ? dstF + (size_t)m * DM : nullptr, dstB ? dstB + (size_t)m * DM : nullptr, st ? st + 2 * m : nullptr, lane);
}
__device__ __forceinline__ void ln_phase(Frame& F, const float* src, const float* w, const float* b, float* dstF, bf16* dstB, float* st) {
    const int lane = fresh_tid() & 63;
    for (int m = F.gw; m < M; m += F.NGW) ln_row(src + (size_t)m * DM, w, b, dstF ? dstF + (size_t)m * DM : nullptr, dstB ? dstB + (size_t)m * DM : nullptr, st ? st + 2 * m : nullptr, lane);
}

__device__ __forceinline__ void p0_prologue(const Args& A, Frame& F) {
    const int ftid = fresh_tid(), flane = ftid & 63;
    LAS float* scr = (LAS float*)(F.lds + F.wave * 16384);
    const float* w_in = A.in[3]; const float* w_out = A.in[15]; const float* w_up = A.in[18]; const float* w_dn = A.in[21];
    constexpr int I_IN = (DM / 64) * (NU / 32), I_OUT = (DM / 64) * (DM / 32), I_UP = (DM / 64) * (NG / 32), I_DN = (FF / 64) * (DM / 32);
    constexpr int I_L = I_IN + I_OUT + I_UP + I_DN;
    for (int it = F.gw; it < 2 * I_L; it += F.NGW) {
        const int l = it / I_L; int r = it % I_L;
        if (r < I_IN) { p0_transpose_item<false>(w_in + (size_t)l * DM * NU, DM, NU, WSP(bf16, WS_WIN + l * SZ_WIN), scr, r, flane); continue; } r -= I_IN;
        if (r < I_OUT) { p0_transpose_item<false>(w_out + (size_t)l * DM * DM, DM, DM, WSP(bf16, WS_WOUT + l * SZ_WOUT), scr, r, flane); continue; } r -= I_OUT;
        if (r < I_UP) { p0_transpose_item<true>(w_up + (size_t)l * DM * NG, DM, NG, WSP(bf16, WS_WUP + l * SZ_WUP), scr, r, flane); continue; } r -= I_UP;
        p0_transpose_item<false>(w_dn + (size_t)l * FF * DM, FF, DM, WSP(bf16, WS_WDN + l * SZ_WDN), scr, r, flane);
    }
    const int gtid = blockIdx.x * NTHR + ftid, NT = F.G * NTHR;
    for (int it = gtid; it < 2 * 4096 * 32; it += NT) {
        const int l = it / (4096 * 32), r = it % (4096 * 32), col = r >> 5, k0 = (r & 31) * 8;
        const int gt = col >> 10, n = (col >> 7) & 7, e = col & 127, half = (col >> 7) & 1, d0 = k0 & 127;
        v4u o = {0u, 0u, 0u, 0u};
        if ((k0 >> 7) == half) { const float* W = ((gt & 1) ? A.in[10] : A.in[8]) + ((size_t)((l * 2 + (gt >> 1)) * 8 + n)) * 16384 + e;
            float x[8];
#pragma unroll
            for (int i = 0; i < 8; ++i) x[i] = W[(d0 + i) * 128];
            o.x = pk2(x[0], x[1]); o.y = pk2(x[2], x[3]); o.z = pk2(x[4], x[5]); o.w = pk2(x[6], x[7]); }
        *(GAS v4u*)(WSP(bf16, WS_WRG + l * SZ_WRG) + (size_t)col * 256 + k0) = o;
    }
    if (gtid < 64 * 32) {
        const int pos = gtid >> 5, j = gtid & 31;
        double invf = 1.0; for (int i = 0; i < j; ++i) invf *= 0.7498942093324559;
        const double ang = (double)pos * invf;
        const double kq = __builtin_rint(ang * 0.6366197723675814);
        const double r = (ang - kq * 1.5707963267948966) - kq * 6.123233995736766e-17, r2 = r * r;
        double sn = r * (1.0 + r2 * (-1.0 / 6 + r2 * (1.0 / 120 + r2 * (-1.0 / 5040 + r2 * (1.0 / 362880 + r2 * (-1.0 / 39916800 + r2 * (1.0 / 6227020800.0)))))));
        double cs = 1.0 + r2 * (-0.5 + r2 * (1.0 / 24 + r2 * (-1.0 / 720 + r2 * (1.0 / 40320 + r2 * (-1.0 / 3628800 + r2 * (1.0 / 479001600.0 + r2 * (-1.0 / 87178291200.0)))))));
        const int q = ((int)kq) & 3; double c, s;
        if (q == 0) { c = cs; s = sn; } else if (q == 1) { c = -sn; s = cs; } else if (q == 2) { c = -cs; s = -sn; } else { c = sn; s = -cs; }
        float* tab = WSP(float, WS_TAB); tab[2 * gtid] = (float)c; tab[2 * gtid + 1] = (float)s;
    }
    ln_phase(F, A.in[0], A.in[1], A.in[2], nullptr, WSP(bf16, WS_HB), WSP(float, WS_ST));
}

__device__ __forceinline__ void prep_phase(const Args& A, Frame& F, int l, int rep) {
    const int ftid = fresh_tid(), flane = ftid & 63;
    bf16* U = WSP(bf16, WS_U); const float* tab = WSP(float, WS_TAB);
    const float* qn = A.in[13] + l * HD; const float* kn = A.in[14] + l * HD;
    const int L = flane, d1 = (L & 31) + 64 * (L >> 5), d2 = d1 + 32;
    const float wq1 = qn[d1], wq2 = qn[d2], wk1 = kn[d1], wk2 = kn[d2];
    for (int m = F.gw; m < M; m += F.NGW) {
        bf16* p = U + (size_t)m * NU + UC_Q;
        const int t = m & (SEQ - 1), pos = (L < 32) ? (t >> 6) : (t & 63);
        const float c = tab[2 * (pos * 32 + (L & 31))], s = tab[2 * (pos * 32 + (L & 31)) + 1];
        float x1[20], x2[20];
#pragma unroll
        for (int j = 0; j < 20; ++j) { x1[j] = bf2f(p[j * HD + d1]); x2[j] = bf2f(p[j * HD + d2]); }
#pragma unroll
        for (int j = 0; j < 20; ++j) {
            const float rstd = 1.f / sqrtf(wave_sum(x1[j] * x1[j] + x2[j] * x2[j]) * (1.f / HD) + RMS_EPS);
            const float n1 = x1[j] * rstd * (j < 16 ? wq1 : wk1), n2 = x2[j] * rstd * (j < 16 ? wq2 : wk2);
            const float o1 = n1 * c - n2 * s, o2 = n2 * c + n1 * s;
            if (rep == 0 || o1 != o1) { p[j * HD + d1] = (bf16)f2bf(o1); p[j * HD + d2] = (bf16)f2bf(o2); } }
    }
    const float* cw = A.in[6] + l * 4 * BW; const float* cb = A.in[7] + l * BW; bf16* XC = WSP(bf16, WS_XC);
    const int gtid = blockIdx.x * NTHR + ftid, NT = F.G * NTHR;
    for (int it = gtid; it < M * 128; it += NT) {
        const int m = it >> 7, c = (it & 127) * 8, t = m & (SEQ - 1);
        float acc[8];
#pragma unroll
        for (int i = 0; i < 8; ++i) acc[i] = cb[c + i];
#pragma unroll
        for (int k = 0; k < 4; ++k) { const int tt = t + k - 2;
            if (tt >= 0 && tt < SEQ) { const v4u xv = *(const GAS v4u*)(U + (size_t)(m + k - 2) * NU + UB_X + c); const unsigned xw[4] = {xv.x, xv.y, xv.z, xv.w};
#pragma unroll
                for (int i = 0; i < 4; ++i) { acc[2 * i] += cw[k * BW + c + 2 * i] * __uint_as_float(xw[i] << 16); acc[2 * i + 1] += cw[k * BW + c + 2 * i + 1] * __uint_as_float(xw[i] & 0xffff0000u); } } }
        v4u o; o.x = pk2(acc[0], acc[1]); o.y = pk2(acc[2], acc[3]); o.z = pk2(acc[4], acc[5]); o.w = pk2(acc[6], acc[7]);
        *(GAS v4u*)(XC + (size_t)m * BW + c) = o;
    }
}

namespace hg {
constexpr int PQ = 136, PK = 72;
constexpr int O_QM = 0, O_KM = O_QM + 64 * PQ * 2, O_KMT = O_KM + 64 * PQ * 2, O_VT = O_KMT + 128 * PK * 2, O_ST = O_VT + 128 * PK * 2, O_P = O_ST + 128 * PQ * 2;
constexpr int O_QS = O_P + 64 * PK * 2, O_EBM = O_QS + 4 * 128 * 4, O_ELM = O_EBM + 512, O_LB = O_ELM + 512, O_END = O_LB + 512;
static_assert(O_END <= 131072, "hgrn LDS");
}
__device__ __forceinline__ void hgrn_item(const Args& A, Frame& F, int l, int id) {
    using namespace hg;
    const int dir = id & 1, h = (id >> 1) & 7, b = id >> 4, tid = fresh_tid(), lane = tid & 63, w = tid >> 6, fr = lane & 15, fq = lane >> 4;
    LAS unsigned char* L = F.lds;
    LAS float* QS = (LAS float*)(L + O_QS); LAS float* EBM = (LAS float*)(L + O_EBM); LAS float* ELM = (LAS float*)(L + O_ELM); LAS float* LB = (LAS float*)(L + O_LB);
    const bf16* U = WSP(bf16, WS_U); bf16* O = WSP(bf16, dir ? WS_OB : WS_OF);
    if (tid < 128) { float lb = 0.f;
        if (l == 1) { const float* lg = A.in[4]; const float l0 = lg[(0 * 2 + dir) * AW + h * HD + tid], l1 = lg[(1 * 2 + dir) * AW + h * HD + tid]; lb = 1.f / (1.f + expf(l0 - l1)); }
        LB[tid] = lb; }
    __syncthreads();
    const int d = tid & 127, iq = tid >> 7;
    const float lb = LB[d];
    const int zc = (dir ? UA_FB : UA_FF) + h * HD + d, qc = UA_Q + h * HD + d, vc = UA_I + h * HD + d;
    f32x4 S[8];
#pragma unroll
    for (int et = 0; et < 8; ++et) S[et] = (f32x4){0.f, 0.f, 0.f, 0.f};
    bf16 zr[16], qr[16], vr[16];
#define HG_LOAD(c) do { _Pragma("unroll") for (int r = 0; r < 16; ++r) { const int s_ = 64 * (c) + 16 * iq + r, t_ = dir ? (SEQ - 1 - s_) : s_; const bf16* row_ = U + (size_t)(b * SEQ + t_) * NU; \
        zr[r] = row_[zc]; qr[r] = row_[qc]; vr[r] = row_[vc]; } } while (0)
    HG_LOAD(0);
    const int it = w >> 1, jt0 = 2 * (w & 1), et0 = 4 * (w & 1);
    for (int c = 0; c < SEQ / 64; ++c) {
        float lf[16], kk[16]; float run = 0.f;
#pragma unroll
        for (int r = 0; r < 16; ++r) { const float z = bf2f(zr[r]);
            const float ez = __expf(-fabsf(z)), rc = __builtin_amdgcn_rcpf(1.f + ez);
            const float sg = z >= 0.f ? rc : ez * rc, sn = z >= 0.f ? ez * rc : rc;
            lf[r] = (lb > 0.f) ? __logf(lb + (1.f - lb) * sg) : (fminf(z, 0.f) - __logf(1.f + ez));
            kk[r] = (1.f - lb) * sn;
            run += lf[r]; lf[r] = run; }
        QS[iq * 128 + d] = run;
        __syncthreads();
        { const float q0 = QS[d], q1 = QS[128 + d], q2 = QS[256 + d], q3 = QS[384 + d];
          const float off = (iq > 0 ? q0 : 0.f) + (iq > 1 ? q1 : 0.f) + (iq > 2 ? q2 : 0.f);
          const float bmid = q0 + q1, blast = (q0 + q1) + (q2 + q3);
          if (iq == 0) { EBM[d] = __expf(bmid); ELM[d] = __expf(blast - bmid); }
          unsigned kt[8], vt[8];
#pragma unroll
          for (int r = 0; r < 16; r += 2) {
              const float x0 = lf[r] + off - bmid, x1 = lf[r + 1] + off - bmid;
              const float e0 = __expf(fminf(fmaxf(x0, -80.f), 80.f)), e1 = __expf(fminf(fmaxf(x1, -80.f), 80.f));
              const float qm0 = bf2f(qr[r]) * e0, qm1 = bf2f(qr[r + 1]) * e1;
              const float km0 = kk[r] * __builtin_amdgcn_rcpf(e0), km1 = kk[r + 1] * __builtin_amdgcn_rcpf(e1);
              const unsigned k0 = f2bf(km0), k1 = f2bf(km1);
              *(LAS bf16*)(L + O_QM + ((16 * iq + r) * PQ + d) * 2) = (bf16)f2bf(qm0); *(LAS bf16*)(L + O_QM + ((16 * iq + r + 1) * PQ + d) * 2) = (bf16)f2bf(qm1);
              *(LAS bf16*)(L + O_KM + ((16 * iq + r) * PQ + d) * 2) = (bf16)k0;        *(LAS bf16*)(L + O_KM + ((16 * iq + r + 1) * PQ + d) * 2) = (bf16)k1;
              kt[r >> 1] = k0 | (k1 << 16); vt[r >> 1] = (unsigned)vr[r] | ((unsigned)vr[r + 1] << 16); }
          *(LAS v4u*)(L + O_KMT + (d * PK + 16 * iq) * 2) = (v4u){kt[0], kt[1], kt[2], kt[3]}; *(LAS v4u*)(L + O_KMT + (d * PK + 16 * iq + 8) * 2) = (v4u){kt[4], kt[5], kt[6], kt[7]};
          *(LAS v4u*)(L + O_VT + (d * PK + 16 * iq) * 2) = (v4u){vt[0], vt[1], vt[2], vt[3]};  *(LAS v4u*)(L + O_VT + (d * PK + 16 * iq + 8) * 2) = (v4u){vt[4], vt[5], vt[6], vt[7]}; }
        if (c + 1 < SEQ / 64) HG_LOAD(c + 1);
        __syncthreads();
        { const f32x4 eb = *(const LAS f32x4*)(EBM + 16 * w + 4 * fq);
#pragma unroll
          for (int et = 0; et < 8; ++et) { S[et] = S[et] * eb;
              typedef unsigned u32x2 __attribute__((ext_vector_type(2)));
              *(LAS u32x2*)(L + O_ST + ((16 * et + fr) * PQ + 16 * w + 4 * fq) * 2) = (u32x2){pk2(S[et].x, S[et].y), pk2(S[et].z, S[et].w)}; } }
        bf16x8 aq[4];
#pragma unroll
        for (int k4 = 0; k4 < 4; ++k4) aq[k4] = *(const LAS bf16x8*)(L + O_QM + ((16 * it + fr) * PQ + 32 * k4 + 8 * fq) * 2);
#pragma unroll
        for (int jj = 0; jj < 2; ++jj) { const int jt = jt0 + jj; f32x4 sc = {0.f, 0.f, 0.f, 0.f};
#pragma unroll
            for (int k4 = 0; k4 < 4; ++k4) { const bf16x8 bk = *(const LAS bf16x8*)(L + O_KM + ((16 * jt + fr) * PQ + 32 * k4 + 8 * fq) * 2);
                sc = __builtin_amdgcn_mfma_f32_16x16x32_bf16(aq[k4], bk, sc, 0, 0, 0); }
            const int jcol = 16 * jt + fr;
#pragma unroll
            for (int r = 0; r < 4; ++r) { const int irow = 16 * it + 4 * fq + r; *(LAS bf16*)(L + O_P + (irow * PK + jcol) * 2) = (bf16)f2bf(jcol <= irow ? sc[r] : 0.f); } }
        __syncthreads();
        { bf16x8 ap[2];
#pragma unroll
          for (int k2 = 0; k2 < 2; ++k2) ap[k2] = *(const LAS bf16x8*)(L + O_P + ((16 * it + fr) * PK + 32 * k2 + 8 * fq) * 2);
#pragma unroll
          for (int ee = 0; ee < 4; ++ee) { const int et = et0 + ee; f32x4 o = {0.f, 0.f, 0.f, 0.f};
#pragma unroll
              for (int k4 = 0; k4 < 4; ++k4) { const bf16x8 bs = *(const LAS bf16x8*)(L + O_ST + ((16 * et + fr) * PQ + 32 * k4 + 8 * fq) * 2);
                  o = __builtin_amdgcn_mfma_f32_16x16x32_bf16(aq[k4], bs, o, 0, 0, 0); }
#pragma unroll
              for (int k2 = 0; k2 < 2; ++k2) { const bf16x8 bv = *(const LAS bf16x8*)(L + O_VT + ((16 * et + fr) * PK + 32 * k2 + 8 * fq) * 2);
                  o = __builtin_amdgcn_mfma_f32_16x16x32_bf16(ap[k2], bv, o, 0, 0, 0); }
#pragma unroll
              for (int r = 0; r < 4; ++r) { const int s_ = 64 * c + 16 * it + 4 * fq + r, t_ = dir ? (SEQ - 1 - s_) : s_;
                  O[(size_t)(b * SEQ + t_) * AW + h * HD + 16 * et + fr] = (bf16)f2bf(o[r]); } } }
        { bf16x8 ak[2];
#pragma unroll
          for (int k2 = 0; k2 < 2; ++k2) ak[k2] = *(const LAS bf16x8*)(L + O_KMT + ((16 * w + fr) * PK + 32 * k2 + 8 * fq) * 2);
          const f32x4 el = *(const LAS f32x4*)(ELM + 16 * w + 4 * fq);
#pragma unroll
          for (int et = 0; et < 8; ++et) {
#pragma unroll
              for (int k2 = 0; k2 < 2; ++k2) { const bf16x8 bv = *(const LAS bf16x8*)(L + O_VT + ((16 * et + fr) * PK + 32 * k2 + 8 * fq) * 2);
                  S[et] = __builtin_amdgcn_mfma_f32_16x16x32_bf16(ak[k2], bv, S[et], 0, 0, 0); }
              S[et] = S[et] * el; } }
    }
#undef HG_LOAD
}

__device__ __forceinline__ void hgrn_final_phase(const Args& A, Frame& F, int l) {
    const int ftid = fresh_tid(), flane = ftid & 63;
    const bf16* OFp = WSP(bf16, WS_OF); const bf16* OBp = WSP(bf16, WS_OB); const bf16* U = WSP(bf16, WS_U); bf16* Y = WSP(bf16, WS_Y);
    const float* nw = A.in[5] + l * AW; typedef float f32x2 __attribute__((ext_vector_type(2)));
    for (int m = F.gw; m < M; m += F.NGW) {
        unsigned a[8], bq[8], gw2[8];
#pragma unroll
        for (int h = 0; h < 8; ++h) { const int c = h * HD + 2 * flane;
            a[h] = *(const GAS unsigned*)(OFp + (size_t)m * AW + c); bq[h] = *(const GAS unsigned*)(OBp + (size_t)m * AW + c); gw2[h] = *(const GAS unsigned*)(U + (size_t)m * NU + UA_G + c); }
#pragma unroll
        for (int h = 0; h < 8; ++h) { const int c = h * HD + 2 * flane;
            const float o0 = __uint_as_float(a[h] << 16) + __uint_as_float(bq[h] << 16), o1 = __uint_as_float(a[h] & 0xffff0000u) + __uint_as_float(bq[h] & 0xffff0000u);
            const float rstd = 1.f / sqrtf(wave_sum(o0 * o0 + o1 * o1) * (1.f / HD) + RMS_EPS);
            const float g0 = __uint_as_float(gw2[h] << 16), g1 = __uint_as_float(gw2[h] & 0xffff0000u);
            const float y0 = o0 * rstd * nw[c] * (g0 * sigm(g0)), y1 = o1 * rstd * nw[c + 1] * (g1 * sigm(g1));
            *(GAS unsigned*)(Y + (size_t)m * DM + c) = pk2(y0, y1); }
    }
    const bf16* HFp = WSP(bf16, WS_HF); const bf16* HBp = WSP(bf16, WS_HBK);
    const int gtid = blockIdx.x * NTHR + ftid, NT = F.G * NTHR;
    for (int it = gtid; it < M * 128; it += NT) { const int m = it >> 7, c = (it & 127) * 8;
        const v4u av = *(const GAS v4u*)(HFp + (size_t)m * BW + c), bv = *(const GAS v4u*)(HBp + (size_t)m * BW + c);
        const v4u gv = *(const GAS v4u*)(U + (size_t)m * NU + UB_GATE + c); const unsigned gw4[4] = {gv.x, gv.y, gv.z, gv.w}, aw4[4] = {av.x, av.y, av.z, av.w}, bw4[4] = {bv.x, bv.y, bv.z, bv.w};
        float hs[8];
#pragma unroll
        for (int i = 0; i < 4; ++i) { hs[2 * i] = __uint_as_float(aw4[i] << 16) + __uint_as_float(bw4[i] << 16); hs[2 * i + 1] = __uint_as_float(aw4[i] & 0xffff0000u) + __uint_as_float(bw4[i] & 0xffff0000u); }
        unsigned o[4];
#pragma unroll
        for (int i = 0; i < 4; ++i) o[i] = pk2(gelu_tanh(__uint_as_float(gw4[i] << 16)) * hs[2 * i], gelu_tanh(__uint_as_float(gw4[i] & 0xffff0000u)) * hs[2 * i + 1]);
        *(GAS v4u*)(Y + (size_t)m * DM + AW + c) = (v4u){o[0], o[1], o[2], o[3]}; }
}

__device__ __forceinline__ void rg_item(const Args& A, Frame& F, int l, int id) {
    const int tid = fresh_tid(), dir = id & 1, cg = (id >> 1) & 15, b = id >> 5;
    const bf16* G = WSP(bf16, WS_G); const bf16* XC = WSP(bf16, WS_XC); bf16* HO = WSP(bf16, dir ? WS_HBK : WS_HF);
    LAS float* As = (LAS float*)F.lds; LAS float* Bs = As + 128 * 64; LAS float* XP = Bs + 128 * 64; LAS float* XH = XP + 512; LAS float* Cs = XH + 512;
    const int srow = tid >> 3, sc8 = (tid & 7) * 8, cc = cg * 64 + sc8;
    float ba[8], bx[8], sp[8];
#pragma unroll
    for (int i = 0; i < 8; ++i) { ba[i] = A.in[9][(l * 2 + dir) * BW + cc + i]; bx[i] = A.in[11][(l * 2 + dir) * BW + cc + i]; sp[i] = -8.f * log1pf(expf(-A.in[12][(l * 2 + dir) * BW + cc + i])); }
    const int ch = tid & 63, sub = tid >> 6;
    if (tid < 64) Cs[tid] = 0.f;
    v4u gr[2], gi[2], gx[2];
#define RG_LOAD(k) do { _Pragma("unroll") for (int p2 = 0; p2 < 2; ++p2) { const int p_ = 64 * p2 + srow, s_ = 128 * (k) + p_, t_ = dir ? (SEQ - 1 - s_) : s_; const size_t m_ = (size_t)b * SEQ + t_; \
        gr[p2] = *(const GAS v4u*)(G + m_ * 4096 + dir * 2048 + cc); gi[p2] = *(const GAS v4u*)(G + m_ * 4096 + dir * 2048 + 1024 + cc); gx[p2] = *(const GAS v4u*)(XC + m_ * BW + cc); } } while (0)
    RG_LOAD(0);
    for (int k = 0; k < SEQ / 128; ++k) {
#pragma unroll
        for (int p2 = 0; p2 < 2; ++p2) { const unsigned rw[4] = {gr[p2].x, gr[p2].y, gr[p2].z, gr[p2].w}, iw[4] = {gi[p2].x, gi[p2].y, gi[p2].z, gi[p2].w}, xw[4] = {gx[p2].x, gx[p2].y, gx[p2].z, gx[p2].w};
            float av[8], bv[8];
#pragma unroll
            for (int i = 0; i < 8; ++i) { const float rp = (i & 1) ? __uint_as_float(rw[i >> 1] & 0xffff0000u) : __uint_as_float(rw[i >> 1] << 16);
                const float ip = (i & 1) ? __uint_as_float(iw[i >> 1] & 0xffff0000u) : __uint_as_float(iw[i >> 1] << 16);
                const float xv = (i & 1) ? __uint_as_float(xw[i >> 1] & 0xffff0000u) : __uint_as_float(xw[i >> 1] << 16);
                const float la = sp[i] * sigm(rp + ba[i]); av[i] = __expf(la); const float y2 = 2.f * la, om = (y2 > -0.25f) ? -y2 * (1.f + y2 * (0.5f + y2 * (0.16666667f + y2 * (0.041666668f + y2 * (0.008333334f + y2 * 0.0013888889f))))) : 1.f - __expf(y2);
                bv[i] = sqrtf(om) * sigm(ip + bx[i]) * xv; }
            LAS f32x4* ap = (LAS f32x4*)(As + (64 * p2 + srow) * 64 + sc8); LAS f32x4* bp = (LAS f32x4*)(Bs + (64 * p2 + srow) * 64 + sc8);
            ap[0] = (f32x4){av[0], av[1], av[2], av[3]}; ap[1] = (f32x4){av[4], av[5], av[6], av[7]}; bp[0] = (f32x4){bv[0], bv[1], bv[2], bv[3]}; bp[1] = (f32x4){bv[4], bv[5], bv[6], bv[7]}; }
        if (k + 1 < SEQ / 128) RG_LOAD(k + 1);
        __syncthreads();
        float hh = 0.f, pp = 1.f;
#pragma unroll
        for (int j = 0; j < 16; ++j) { const float a = As[(16 * sub + j) * 64 + ch], bt = Bs[(16 * sub + j) * 64 + ch]; hh = a * hh + bt; pp *= a; }
        XP[sub * 64 + ch] = pp; XH[sub * 64 + ch] = hh;
        __syncthreads();
        float cin = Cs[ch];
        for (int s2 = 0; s2 < sub; ++s2) cin = XP[s2 * 64 + ch] * cin + XH[s2 * 64 + ch];
#pragma unroll
        for (int j = 0; j < 16; ++j) { const float a = As[(16 * sub + j) * 64 + ch], bt = Bs[(16 * sub + j) * 64 + ch]; cin = a * cin + bt;
            const int s_ = 128 * k + 16 * sub + j, t_ = dir ? (SEQ - 1 - s_) : s_; HO[((size_t)b * SEQ + t_) * BW + cg * 64 + ch] = (bf16)f2bf(cin); }
        __syncthreads();
        if (sub == 7) Cs[ch] = cin;
    }
#undef RG_LOAD
}

constexpr int Q_HGRN = 128, Q_RG = 256, Q_ATT = BATCH * 16 * (SEQ / 256), Q_ALL = Q_HGRN + Q_RG + Q_ATT;
__device__ __forceinline__ void mixer_phase(const Args& A, Frame& F, int l, char* lds_generic, int rep) {
#ifndef MIX_DIS
#define MIX_DIS 0
#endif
#ifndef MIX_REP_DIS
#define MIX_REP_DIS 0
#endif
    for (;;) {
        __syncthreads();
        if (F.tid == 0) F.MISC[0] = __hip_atomic_fetch_add(F.ctl + CW_QUEUE + 128 * l + 512 * rep, 1u, RLX_AGENT);
        __syncthreads();
        const int id = (int)F.MISC[0];
        if (id >= Q_HGRN + Q_RG) break;
        if (id < Q_HGRN) { if (!(MIX_DIS & 1) && !(rep && (MIX_REP_DIS & 1))) hgrn_item(A, F, l, id); }
        else { if (!(MIX_DIS & 2) && !(rep && (MIX_REP_DIS & 2))) rg_item(A, F, l, id - Q_HGRN); }
    }
    const attn::bf16* U = (const attn::bf16*)WSP(bf16, WS_U); attn::bf16* Y = (attn::bf16*)WSP(bf16, WS_Y);
    for (;;) {
        __syncthreads();
        if (F.tid == 0) F.MISC[0] = __hip_atomic_fetch_add(F.ctl + CW_QUEUE + 128 * l + 64 + 512 * rep, 1u, RLX_AGENT);
        __syncthreads();
        const int a = (int)F.MISC[0];
        if (a >= Q_ATT) break;
        if (!(MIX_DIS & 4) && !(rep && (MIX_REP_DIS & 4))) { const int qb = a & 7, h = (a >> 3) & 15, b = a >> 7;
            const size_t r0 = (size_t)b * SEQ;
            attn::attn_dense_body<attn::bf16>(U + (r0 + qb * 256) * NU + UC_Q + h * HD, U + r0 * NU + UC_K + (h >> 2) * HD, U + r0 * NU + UC_V + (h >> 2) * HD,
                                              Y + (r0 + qb * 256) * DM + AW + BW + h * HD, SEQ, lds_generic); }
    }
}

__device__ __forceinline__ void act_phase(const Args& A, Frame& F, int l) {
    const int ftid = fresh_tid(), flane = ftid & 63;
    const bf16* GU = WSP(bf16, WS_GU); bf16* ACT = WSP(bf16, WS_ACT);
    const float* cw = A.in[19] + (size_t)l * 3 * FF; const float* cb = A.in[20] + (size_t)l * FF;
    const int gtid = blockIdx.x * NTHR + ftid, NT = F.G * NTHR; constexpr int C8 = FF / 8;
    for (long it = gtid; it < (long)M * C8; it += NT) {
        const int m = (int)(it / C8), c = (int)(it % C8) * 8, t = m & (SEQ - 1);
        float acc[8];
#pragma unroll
        for (int i = 0; i < 8; ++i) acc[i] = cb[c + i];
#pragma unroll
        for (int k = 0; k < 3; ++k) { const int tt = t + k - 1;
            if (tt >= 0 && tt < SEQ) { const v4u xv = *(const GAS v4u*)(GU + (size_t)(m + k - 1) * NG + c); const unsigned xw[4] = {xv.x, xv.y, xv.z, xv.w};
#pragma unroll
                for (int i = 0; i < 4; ++i) { acc[2 * i] += cw[(size_t)k * FF + c + 2 * i] * __uint_as_float(xw[i] << 16); acc[2 * i + 1] += cw[(size_t)k * FF + c + 2 * i + 1] * __uint_as_float(xw[i] & 0xffff0000u); } } }
        const v4u uv = *(const GAS v4u*)(GU + (size_t)m * NG + FF + c); const unsigned uw[4] = {uv.x, uv.y, uv.z, uv.w};
        float o[8];
#pragma unroll
        for (int i = 0; i < 4; ++i) { o[2 * i] = acc[2 * i] * sigm(acc[2 * i]) * __uint_as_float(uw[i] << 16); o[2 * i + 1] = acc[2 * i + 1] * sigm(acc[2 * i + 1]) * __uint_as_float(uw[i] & 0xffff0000u); }
        v4u ov; ov.x = pk2(o[0], o[1]); ov.y = pk2(o[2], o[3]); ov.z = pk2(o[4], o[5]); ov.w = pk2(o[6], o[7]);
        *(GAS v4u*)(ACT + (size_t)m * FF + c) = ov;
    }
}

__global__ void __launch_bounds__(NTHR, 2) fwd_kernel(Args args) {
    extern __shared__ __attribute__((aligned(16))) unsigned char lds[];
    Frame F;
    F.lds = (LAS unsigned char*)lds;
    F.MISC = (volatile LAS unsigned*)(F.lds + MISC_OFF);
    F.tid = threadIdx.x; F.lane = F.tid & 63; F.wave = __builtin_amdgcn_readfirstlane(F.tid >> 6);
    F.G = gridDim.x; F.gw = blockIdx.x * NWAVES + F.wave; F.NGW = F.G * NWAVES;
    F.ws = args.ws; F.ctl = (gu32*)(args.ws + WS_CTL); F.H = args.out;
    for (int u = F.tid; u < (LDS_BYTES - RING_BYTES) / 4; u += NTHR) ((LAS unsigned*)(F.lds + RING_BYTES))[u] = 0u;
    __syncthreads();
    const int lo = args.ph_lo, hi = args.ph_hi;
    XcdBarrier bar; bar.bar = (unsigned*)(F.ctl + CW_BAR); bar.x = 0; bar.st = nullptr;
    if (hi - lo > 1) bar = xcd_barrier_post((unsigned*)(F.ctl + CW_BAR), F.MISC + 8);
#ifndef DIS
#define DIS 0
#endif
#define EN(j) (!((DIS >> (j)) & 1))
#ifndef DBL
#define DBL 0
#endif
#define REPS(j, l) ((((DBL >> (j)) & 1) && (l) == 0) ? 2 : 1)
#define IN(k) (lo <= (k) && (k) < hi)
#define SEAM(k) do { if (IN(k) && IN((k) + 1)) xcd_barrier(bar); } while (0)
    LAS unsigned char* ring = F.lds;

    if (EN(0) && IN(0)) { for (int rep = 0; rep < REPS(0, 0); ++rep) { p0_prologue(args, F); if (rep + 1 < REPS(0, 0)) xcd_barrier(bar); } } SEAM(0);

    for (int l = 0; l < 2; ++l) {
        const int pb = 1 + PH_PER_LAYER * l;
        bf16* HB = WSP(bf16, WS_HB); bf16* U = WSP(bf16, WS_U); bf16* Y = WSP(bf16, WS_Y); bf16* RBUF = WSP(bf16, WS_R);
        if (EN(1) && IN(pb + 0)) for (int rep = 0; rep < REPS(1, l); ++rep) { if (rep) xcd_barrier(bar); pg8::Gemm g{HB, WSP(bf16, WS_WIN + l * SZ_WIN), M, NU, DM}; pg8::StaticOrder S; S.init(M, NU, F.G, (int)blockIdx.x);
            pg8::EpiBf16<0> E{U, NU, nullptr, 0, 0, 1.f};
            pg8::gemm_phase<pg8::EpiBf16<0>, pg8::StaticOrder, true, true>(ring, g, S, E); } SEAM(pb + 0);
        if (EN(2) && IN(pb + 1)) for (int rep = 0; rep < REPS(2, l); ++rep) { if (rep) xcd_barrier(bar); prep_phase(args, F, l, rep); } SEAM(pb + 1);
        if (EN(3) && IN(pb + 2)) for (int rep = 0; rep < REPS(3, l); ++rep) { if (rep) xcd_barrier(bar); pg8::Gemm g{WSP(bf16, WS_XC), WSP(bf16, WS_WRG + l * SZ_WRG), M, 4096, 256, 0, 1024, 4}; pg8::StaticOrder S; S.init(M, 4096, F.G, (int)blockIdx.x);
            pg8::EpiBf16<0> E{WSP(bf16, WS_G), 4096, nullptr, 0, 0, 1.f};
            pg8::gemm_phase<pg8::EpiBf16<0>, pg8::StaticOrder, true, true>(ring, g, S, E); } SEAM(pb + 2);
        if (EN(4) && IN(pb + 3)) for (int rep = 0; rep < REPS(4, l); ++rep) { if (rep) xcd_barrier(bar); mixer_phase(args, F, l, (char*)lds, rep); } SEAM(pb + 3);
        if (EN(5) && IN(pb + 4)) for (int rep = 0; rep < REPS(5, l); ++rep) { if (rep) xcd_barrier(bar); hgrn_final_phase(args, F, l); } SEAM(pb + 4);
        if (EN(6) && IN(pb + 5)) for (int rep = 0; rep < REPS(6, l); ++rep) { if (rep) xcd_barrier(bar); pg8::Gemm g{Y, WSP(bf16, WS_WOUT + l * SZ_WOUT), M, DM, DM}; pg8::StaticOrder S; S.init(M, DM, F.G, (int)blockIdx.x);
            if (l == 0) { pg8::EpiResBf<true> E{args.in[0], WSP(float, WS_ST), args.in[1], args.in[2], RBUF}; pg8::gemm_phase<pg8::EpiResBf<true>, pg8::StaticOrder, true, true>(ring, g, S, E); }
            else { pg8::EpiResBf<false> E{nullptr, WSP(float, WS_ST), args.in[22], args.in[23], RBUF}; pg8::gemm_phase<pg8::EpiResBf<false>, pg8::StaticOrder, true, true>(ring, g, S, E); } } SEAM(pb + 5);
        if (EN(7) && IN(pb + 6)) for (int rep = 0; rep < REPS(7, l); ++rep) { if (rep) xcd_barrier(bar); ln_phase_bf(F, RBUF, args.in[16] + l * DM, args.in[17] + l * DM, nullptr, HB, WSP(float, WS_ST)); } SEAM(pb + 6);
        if (EN(8) && IN(pb + 7)) for (int rep = 0; rep < REPS(8, l); ++rep) { if (rep) xcd_barrier(bar); pg8::Gemm g{HB - DM, WSP(bf16, WS_WUP + l * SZ_WUP), 65 * 256, NG, DM, 254}; pg8::StaticOrder S; S.init(65 * 256, NG, F.G, (int)blockIdx.x);
            pg8::EpiConvGlu E{WSP(bf16, WS_ACT), FF, args.in[19] + (size_t)l * 3 * FF, args.in[20] + (size_t)l * FF, (PG8_LAS float*)(F.lds + RING_BYTES + 1024), SEQ, M};
            pg8::gemm_phase<pg8::EpiConvGlu, pg8::StaticOrder, true, true>(ring, g, S, E); } SEAM(pb + 7);
        if (EN(10) && IN(pb + 9)) for (int rep = 0; rep < REPS(10, l); ++rep) { if (rep) xcd_barrier(bar); pg8::Gemm g{WSP(bf16, WS_ACT), WSP(bf16, WS_WDN + l * SZ_WDN), M, DM, FF}; pg8::StaticOrder S; S.init(M, DM, F.G, (int)blockIdx.x);
            pg8::EpiResBf<false> E{nullptr, WSP(float, WS_ST), args.in[16] + l * DM, args.in[17] + l * DM, RBUF};
            pg8::gemm_phase<pg8::EpiResBf<false>, pg8::StaticOrder, true, true>(ring, g, S, E); } SEAM(pb + 9);
        if (EN(11) && IN(pb + 10)) for (int rep = 0; rep < REPS(11, l); ++rep) { if (rep) xcd_barrier(bar);
            ln_phase_bf(F, RBUF, args.in[22] + l * DM, args.in[23] + l * DM, l == 1 ? F.H : nullptr, l == 1 ? nullptr : HB, l == 1 ? nullptr : WSP(float, WS_ST)); } SEAM(pb + 10);
    }
#undef IN
#undef SEAM
}

extern "C" void kernel_launch(void* const* d_in, const int* in_sizes, int n_in, void* d_out, int out_size, void* d_ws, size_t ws_size, hipStream_t stream) {
    static int grid = 0;
    if (grid == 0) {
        if (n_in != 24 || in_sizes[0] != M * DM || out_size != M * DM || ws_size < WS_END) { fprintf(stderr, "kernel_launch: unexpected shapes: n_in %d in0 %d out %d ws %zu (need %zu)\n", n_in, n_in > 0 ? in_sizes[0] : -1, out_size, ws_size, (size_t)WS_END); grid = -1; return; }
        int dev = 0, cus = 0, per_cu = 0;
        if (hipGetDevice(&dev) != hipSuccess || hipDeviceGetAttribute(&cus, hipDeviceAttributeMultiprocessorCount, dev) != hipSuccess) { grid = -1; return; }
        if (hipFuncSetAttribute((const void*)fwd_kernel, hipFuncAttributeMaxDynamicSharedMemorySize, LDS_BYTES) != hipSuccess) { fprintf(stderr, "kernel_launch: hipFuncSetAttribute failed\n"); grid = -1; return; }
        if (hipOccupancyMaxActiveBlocksPerMultiprocessor(&per_cu, (const void*)fwd_kernel, NTHR, LDS_BYTES) != hipSuccess || per_cu < 1) fprintf(stderr, "kernel_launch: occupancy query reports %d\n", per_cu);
        (void)hipGetLastError();
        grid = cus;
    }
    if (grid < 0) return;
    if (hipMemsetAsync((char*)d_ws + WS_CTL, 0, CTL_ZERO_BYTES, stream) != hipSuccess) return;
    Args a{};
    for (int i = 0; i < 24; ++i) a.in[i] = (const float*)d_in[i];
    a.out = (float*)d_out; a.ws = (unsigned char*)d_ws;
#if MK_SINGLE
    a.ph_lo = 0; a.ph_hi = NPH;
    hipLaunchKernelGGL(fwd_kernel, dim3(grid), dim3(NTHR), LDS_BYTES, stream, a);
#else
    for (int p = 0; p < NPH; ++p) { a.ph_lo = p; a.ph_hi = p + 1; hipLaunchKernelGGL(fwd_kernel, dim3(grid), dim3(NTHR), LDS_BYTES, stream, a); }
#endif
    const hipError_t le = hipPeekAtLastError();
    if (le != hipSuccess) fprintf(stderr, "kernel_launch: launch failed: %s\n", hipGetErrorName(le));
}
```

```cpp
#include <hip/hip_runtime.h>
#include <hip/hip_bf16.h>
#include <cstdio>
#include <cstdint>
#define MK_SINGLE 1
namespace pg8 {
#define PG8_LAS __attribute__((address_space(3)))
typedef unsigned short bf16_t;
typedef short bf16x8 __attribute__((ext_vector_type(8)));
typedef float f32x4 __attribute__((ext_vector_type(4)));
typedef unsigned u32x4 __attribute__((ext_vector_type(4)));
constexpr int BM = 256, BK = 64, HALF = 128, HTB = HALF * BK * 2  , STAGE_BYTES = 8 * HTB, NXCD = 8, WGM = 8;

__host__ __device__ __forceinline__ int lds_byte(int r, int c) { const int st = (r >> 4) * 2 + (c >> 5), rr = r & 15, cc = c & 31, ob = rr * 64 + cc * 2; return st * 1024 + (ob ^ (((ob >> 9) & 1) << 5)); }
__host__ __device__ __forceinline__ void stage_rc(int b, int& R, int& C) { const int st = b / 1024, sb = b % 1024, swz = sb ^ (((sb >> 9) & 1) << 5); R = (st >> 1) * 16 + swz / 64; C = (st & 1) * 32 + (swz % 64) / 2; }
__host__ __device__ __forceinline__ int perm32(int rho) { const int n = rho >> 4, i = rho & 15; return 8 * (i >> 2) + 4 * n + (i & 3); }

struct Unit { int pm, pn; };
struct Gemm { const bf16_t* A; const bf16_t* Bt; int M, N, K; int a_rstep, lda, kwin; };

struct StaticOrder {
    int nM, nN, nwg, G, c;
    __host__ __device__ void init(int M, int N, int G_, int c_) { nM = M / BM; nN = N / BM; nwg = nM * nN; G = G_; c = c_; }
    __host__ __device__ bool next(int i, Unit& u) const {
        const long L = (long)i * G + c; if (L >= nwg) return false;
        int wgid = (int)L; { const int q = nwg / NXCD, r = nwg % NXCD, xcd = wgid % NXCD, off = wgid / NXCD; wgid = (xcd < r ? xcd * (q + 1) : r * (q + 1) + (xcd - r) * q) + off; }
        const int nig = WGM * nN, gid = wgid / nig, fm = gid * WGM, gsz = (nM - fm) < WGM ? (nM - fm) : WGM;
        u.pm = fm + ((wgid % nig) % gsz); u.pn = (wgid % nig) / gsz; return true;
    }
    __device__ __forceinline__ void a_ready(const Unit&) const {}
    __device__ __forceinline__ void done(const Unit&) const {}
};

__device__ __forceinline__ unsigned cvt_pk_bf16(float lo, float hi) { unsigned r; asm volatile("v_cvt_pk_bf16_f32 %0, %1, %2" : "=v"(r) : "v"(lo), "v"(hi)); return r; }
typedef float f32x2 __attribute__((ext_vector_type(2)));
__device__ __forceinline__ f32x2 gelu_pk(f32x2 v) {
    const f32x2 av = __builtin_elementwise_abs(v), d = av * 0.2316418882f + 1.0f;
    f32x2 t; t.x = __builtin_amdgcn_rcpf(d.x); t.y = __builtin_amdgcn_rcpf(d.y);
    f32x2 q = t * 0.5307027145f + (-0.7265760135f); q = q * t + 0.7107068705f; q = q * t + (-0.142248368f); q = q * t + 0.127414796f; q = q * t;
    const f32x2 s = (v * v) * (-0.72134752044f);
    f32x2 e; e.x = __builtin_amdgcn_exp2f(s.x); e.y = __builtin_amdgcn_exp2f(s.y);
    const f32x2 m = v * (q * e), r = v - m;
    f32x2 o; o.x = v.x < 0.f ? m.x : r.x; o.y = v.y < 0.f ? m.y : r.y; return o;
}

template <int ACT  > struct EpiBf16 {
    static constexpr bool PERM = true, AFTER_DRAIN = false; static_assert(ACT == 0 || ACT == 1, "EpiBf16: ACT is 0 (none) or 1 (gelu_pk)");
    bf16_t* O; int ldc; const float* bias; int split_cols; size_t split_stride; float scale0;
    __device__ __forceinline__ void operator()(const f32x4 (&acc)[2][2][4][2], const Unit& u, int wr, int wc, int fr, int fq) const {
        const int row0 = u.pm * BM + wr * 64 + fr; int colt = u.pn * BM; bf16_t* base = O;
        float sc = 1.f; if (split_cols) { const int t = colt / split_cols; base += (size_t)t * split_stride; colt -= t * split_cols; if (t == 0) sc = scale0; }
        const int col0 = colt + wc * 32 + 8 * fq, bcol0 = u.pn * BM + wc * 32 + 8 * fq;
        f32x4 bv[2][2];
#pragma unroll
        for (int bj = 0; bj < 2; ++bj)
#pragma unroll
            for (int n = 0; n < 2; ++n) bv[bj][n] = bias ? *(const f32x4*)(bias + bcol0 + bj * HALF + 4 * n) : (f32x4){0.f, 0.f, 0.f, 0.f};
#pragma unroll
        for (int ai = 0; ai < 2; ++ai)
#pragma unroll
            for (int m = 0; m < 4; ++m) { bf16_t* rowp = base + (size_t)(row0 + ai * HALF + m * 16) * ldc + col0;
#pragma unroll
                for (int bj = 0; bj < 2; ++bj) { f32x4 v0 = acc[ai][bj][m][0] + bv[bj][0], v1 = acc[ai][bj][m][1] + bv[bj][1];
                    if (ACT == 1) { f32x2 a = gelu_pk((f32x2){v0[0], v0[1]}), b = gelu_pk((f32x2){v0[2], v0[3]}), c = gelu_pk((f32x2){v1[0], v1[1]}), d = gelu_pk((f32x2){v1[2], v1[3]});
                        v0 = (f32x4){a.x, a.y, b.x, b.y}; v1 = (f32x4){c.x, c.y, d.x, d.y}; }
                    v0 = v0 * sc; v1 = v1 * sc; u32x4 w; w.x = cvt_pk_bf16(v0[0], v0[1]); w.y = cvt_pk_bf16(v0[2], v0[3]); w.z = cvt_pk_bf16(v1[0], v1[1]); w.w = cvt_pk_bf16(v1[2], v1[3]);
                    *(u32x4*)(rowp + bj * HALF) = w; } }
    }
};
struct EpiResF32 {
    static constexpr bool PERM = false, AFTER_DRAIN = false;
    const float* base; float* C; int ldc; float alpha;
    __device__ __forceinline__ void operator()(const f32x4 (&acc)[2][2][4][2], const Unit& u, int wr, int wc, int fr, int fq) const {
        const int row0 = u.pm * BM + wr * 64 + fr, col0 = u.pn * BM + wc * 32 + 4 * fq;
#pragma unroll
        for (int ai = 0; ai < 2; ++ai)
#pragma unroll
            for (int m = 0; m < 4; ++m) { const size_t off = (size_t)(row0 + ai * HALF + m * 16) * ldc + col0;
#pragma unroll
                for (int bj = 0; bj < 2; ++bj)
#pragma unroll
                    for (int n = 0; n < 2; ++n) { const f32x4 bs = *(const f32x4*)(base + off + bj * HALF + n * 16);
                        *(f32x4*)(C + off + bj * HALF + n * 16) = acc[ai][bj][m][n] + alpha * bs; } }
    }
};
struct EpiConvGlu {
    static constexpr bool PERM = true, AFTER_DRAIN = false;
    bf16_t* ACT; int ldo; const float* cw; const float* cb; PG8_LAS float* xch; int seq, mtok;
    __device__ __forceinline__ void operator()(const f32x4 (&acc)[2][2][4][2], const Unit& u, int wr, int wc, int fr, int fq) const {
        const int lane = fq * 16 + fr, cl = wc * 32 + 8 * fq;
#pragma unroll
        for (int ai = 0; ai < 2; ++ai)
#pragma unroll
            for (int n = 0; n < 2; ++n) {
                if (fr == 0)  *(PG8_LAS f32x4*)(xch + ((ai * 2 + wr) * 2 + 0) * 128 + cl + 4 * n) = acc[ai][0][0][n];
                if (fr == 15) *(PG8_LAS f32x4*)(xch + ((ai * 2 + wr) * 2 + 1) * 128 + cl + 4 * n) = acc[ai][0][3][n]; }
        asm volatile("s_waitcnt lgkmcnt(0)" ::: "memory"); __builtin_amdgcn_s_barrier(); asm volatile("" ::: "memory");
        const int ch0 = u.pn * 128 + cl;
        f32x4 w0[2], w1[2], w2[2], bb[2];
#pragma unroll
        for (int n = 0; n < 2; ++n) { w0[n] = *(const f32x4*)(cw + ch0 + 4 * n); w1[n] = *(const f32x4*)(cw + ldo + ch0 + 4 * n); w2[n] = *(const f32x4*)(cw + 2 * ldo + ch0 + 4 * n); bb[n] = *(const f32x4*)(cb + ch0 + 4 * n); }
        const int srcU = fr > 0 ? lane - 1 : lane + 15, srcD = fr < 15 ? lane + 1 : lane - 15;
#pragma unroll
        for (int ai = 0; ai < 2; ++ai)
#pragma unroll
            for (int m = 0; m < 4; ++m) {
                const int r = ai * HALF + wr * 64 + m * 16 + fr, tok = 254 * u.pm - 1 + r, t = tok & (seq - 1);
                unsigned ow[4];
#pragma unroll
                for (int n = 0; n < 2; ++n) {
                    const f32x4 g = acc[ai][0][m][n], gm = acc[ai][0][m > 0 ? m - 1 : 0][n], gp = acc[ai][0][m < 3 ? m + 1 : 3][n];
                    const f32x4 sU = (fr == 15) ? gm : g, sD = (fr == 0) ? gp : g;
                    f32x4 up, dn;
#pragma unroll
                    for (int j = 0; j < 4; ++j) { up[j] = __shfl(sU[j], srcU, 64); dn[j] = __shfl(sD[j], srcD, 64); }
                    if (m == 0) { const int pa = wr ? ai : ai - 1, pw = wr ^ 1;
                        if (pa >= 0) { const f32x4 e = *(const PG8_LAS f32x4*)(xch + ((pa * 2 + pw) * 2 + 1) * 128 + cl + 4 * n); if (fr == 0) up = e; } }
                    if (m == 3) { const int pa = wr ? ai + 1 : ai, pw = wr ^ 1;
                        if (pa <= 1) { const f32x4 e = *(const PG8_LAS f32x4*)(xch + ((pa * 2 + pw) * 2 + 0) * 128 + cl + 4 * n); if (fr == 15) dn = e; } }
                    if (t == 0) up = (f32x4){0.f, 0.f, 0.f, 0.f};
                    if (t == seq - 1) dn = (f32x4){0.f, 0.f, 0.f, 0.f};
                    const f32x4 cv = bb[n] + w0[n] * up + w1[n] * g + w2[n] * dn, uu = acc[ai][1][m][n];
                    float o[4];
#pragma unroll
                    for (int j = 0; j < 4; ++j) o[j] = cv[j] * __builtin_amdgcn_rcpf(1.f + __expf(-cv[j])) * uu[j];
                    ow[2 * n] = cvt_pk_bf16(o[0], o[1]); ow[2 * n + 1] = cvt_pk_bf16(o[2], o[3]); }
                if (r >= 1 && r <= 254 && tok < mtok) *(u32x4*)(ACT + (size_t)tok * ldo + ch0) = (u32x4){ow[0], ow[1], ow[2], ow[3]};
            }
    }
};
struct EpiResLazy {
    static constexpr bool PERM = false, AFTER_DRAIN = false;
    const float* Rp; const float* st; const float* w; const float* b; float* C; int ldc; float alpha;
    __device__ __forceinline__ void operator()(const f32x4 (&acc)[2][2][4][2], const Unit& u, int wr, int wc, int fr, int fq) const {
        typedef float f32x2v __attribute__((ext_vector_type(2)));
        const int row0 = u.pm * BM + wr * 64 + fr, col0 = u.pn * BM + wc * 32 + 4 * fq;
        f32x4 wv[2][2], bv[2][2];
#pragma unroll
        for (int bj = 0; bj < 2; ++bj)
#pragma unroll
            for (int n = 0; n < 2; ++n) { wv[bj][n] = *(const f32x4*)(w + col0 + bj * HALF + n * 16) * alpha; bv[bj][n] = *(const f32x4*)(b + col0 + bj * HALF + n * 16) * alpha; }
#pragma unroll
        for (int ai = 0; ai < 2; ++ai)
#pragma unroll
            for (int m = 0; m < 4; ++m) { const int row = row0 + ai * HALF + m * 16; const size_t off = (size_t)row * ldc + col0; const f32x2v s = *(const f32x2v*)(st + 2 * row);
#pragma unroll
                for (int bj = 0; bj < 2; ++bj)
#pragma unroll
                    for (int n = 0; n < 2; ++n) { const f32x4 rp = *(const f32x4*)(Rp + off + bj * HALF + n * 16);
                        *(f32x4*)(C + off + bj * HALF + n * 16) = acc[ai][bj][m][n] + ((rp - s.x) * s.y) * wv[bj][n] + bv[bj][n]; } }
    }
};

template <bool RPF32> struct EpiResBf {
    static constexpr bool PERM = true, AFTER_DRAIN = false;
    static constexpr int ldc = 4096; static constexpr float alpha = 1.41421356237309515f;
    const float* RpF; const float* st; const float* w; const float* b; bf16_t* RB;
    __device__ __forceinline__ void operator()(const f32x4 (&acc)[2][2][4][2], const Unit& u, int wr, int wc, int fr, int fq) const {
        typedef float f32x2v __attribute__((ext_vector_type(2)));
        const int row0 = u.pm * BM + wr * 64 + fr, col0 = u.pn * BM + wc * 32 + 8 * fq;
        f32x4 wv[2][2], bv[2][2];
#pragma unroll
        for (int bj = 0; bj < 2; ++bj)
#pragma unroll
            for (int n = 0; n < 2; ++n) { wv[bj][n] = *(const f32x4*)(w + col0 + bj * HALF + 4 * n) * alpha; bv[bj][n] = *(const f32x4*)(b + col0 + bj * HALF + 4 * n) * alpha; }
#pragma unroll
        for (int ai = 0; ai < 2; ++ai)
#pragma unroll
            for (int m = 0; m < 4; ++m) { const int row = row0 + ai * HALF + m * 16; const size_t off = (size_t)row * ldc + col0; const f32x2v s = *(const f32x2v*)(st + 2 * row);
#pragma unroll
                for (int bj = 0; bj < 2; ++bj) { f32x4 r0, r1;
                    if constexpr (RPF32) { r0 = *(const f32x4*)(RpF + off + bj * HALF); r1 = *(const f32x4*)(RpF + off + bj * HALF + 4); }
                    else { const u32x4 pw = *(const u32x4*)(RB + off + bj * HALF);
                        r0 = (f32x4){__uint_as_float(pw.x << 16), __uint_as_float(pw.x & 0xffff0000u), __uint_as_float(pw.y << 16), __uint_as_float(pw.y & 0xffff0000u)};
                        r1 = (f32x4){__uint_as_float(pw.z << 16), __uint_as_float(pw.z & 0xffff0000u), __uint_as_float(pw.w << 16), __uint_as_float(pw.w & 0xffff0000u)}; }
                    const f32x4 v0 = acc[ai][bj][m][0] + ((r0 - s.x) * s.y) * wv[bj][0] + bv[bj][0], v1 = acc[ai][bj][m][1] + ((r1 - s.x) * s.y) * wv[bj][1] + bv[bj][1];
                    u32x4 wd; wd.x = cvt_pk_bf16(v0[0], v0[1]); wd.y = cvt_pk_bf16(v0[2], v0[3]); wd.z = cvt_pk_bf16(v1[0], v1[1]); wd.w = cvt_pk_bf16(v1[2], v1[3]);
                    *(u32x4*)(RB + off + bj * HALF) = wd; } }
    }
};
template <class Epi, class Sched, bool ALIGN_EPI = false, bool SP2 = false>
__device__ __forceinline__ void gemm_phase(PG8_LAS unsigned char* lds, const Gemm g, const Sched& S, const Epi& E) {
    int tid_ = threadIdx.x; asm volatile("" : "+v"(tid_));
    const int tid = tid_, wid = __builtin_amdgcn_readfirstlane(tid >> 6), lane = tid & 63, wr = wid >> 2, wc = wid & 3, fr = lane & 15, fq = lane >> 4;
    const int K = g.K, nt = K / BK, lda = g.lda ? g.lda : g.K;
    unsigned voffA[2], voffB[2];
#pragma unroll
    for (int i = 0; i < 2; ++i) { int R, C; stage_rc(tid * 16 + i * 8192, R, C); const int Rb = Epi::PERM ? ((R & ~31) + perm32(R & 31)) : R;
        voffA[i] = (unsigned)(R * lda + C) * 2u; voffB[i] = (unsigned)(Rb * K + C) * 2u; }
    const size_t kstep = (size_t)(BK * 2);
    const size_t hstep = (size_t)HALF * K * 2;
    const size_t hstepA = (size_t)HALF * lda * 2;
    const size_t tstep = 2 * hstep;
    const size_t tstepA = (size_t)(g.a_rstep ? g.a_rstep : BM) * lda * 2;
    const unsigned ldsw = (unsigned)wid * 1024u;
    const int aoff = lds_byte(wr * 64 + fr, fq * 8), boff = lds_byte(wc * 32 + fr, fq * 8);
#define PG8_SA(b, h) (((b) * 2 + (h)) * HTB)
#define PG8_SB(b, h) ((4 + (b) * 2 + (h)) * HTB)
#define PG8_STAGE(bufoff, gbase, voff) do { _Pragma("unroll") for (int _i = 0; _i < 2; ++_i) \
        __builtin_amdgcn_global_load_lds((const unsigned*)((const char*)(gbase) + (voff)[_i]), (PG8_LAS unsigned*)(lds + (bufoff) + ldsw + _i * 8192), 16, 0, 0); } while (0)
#define PG8_LDA(dst, b, h) do { _Pragma("unroll") for (int m = 0; m < 4; ++m) _Pragma("unroll") for (int k = 0; k < 2; ++k) dst[m][k] = *(const PG8_LAS bf16x8*)(lds + PG8_SA(b, h) + aoff + m * 2048 + k * 1024); } while (0)
#define PG8_LDB(dst, b, h) do { _Pragma("unroll") for (int n = 0; n < 2; ++n) _Pragma("unroll") for (int k = 0; k < 2; ++k) dst[n][k] = *(const PG8_LAS bf16x8*)(lds + PG8_SB(b, h) + boff + n * 2048 + k * 1024); } while (0)
#define PG8_MMA(ai, bj, At, Bt) do { __builtin_amdgcn_s_setprio(1); _Pragma("unroll") for (int m = 0; m < 4; ++m) _Pragma("unroll") for (int n = 0; n < 2; ++n) _Pragma("unroll") for (int k = 0; k < 2; ++k) \
        acc[ai][bj][m][n] = __builtin_amdgcn_mfma_f32_16x16x32_bf16(Bt[n][k], At[m][k], acc[ai][bj][m][n], 0, 0, 0); __builtin_amdgcn_s_setprio(0); } while (0)
#define PG8_WAIT_V(n) asm volatile("s_waitcnt vmcnt(" #n ")" ::: "memory")
#define PG8_WAIT_L(n) asm volatile("s_waitcnt lgkmcnt(" #n ")" ::: "memory")
#define PG8_BAR __builtin_amdgcn_s_barrier()
#define PG8_SCHED __builtin_amdgcn_sched_barrier(0)
    Unit cur, nxt; int ui = 0;
    if (!S.next(0, cur)) return;
    f32x4 acc[2][2][4][2];
#pragma unroll
    for (int a = 0; a < 2; ++a)
#pragma unroll
        for (int b = 0; b < 2; ++b)
#pragma unroll
            for (int m = 0; m < 4; ++m)
#pragma unroll
                for (int n = 0; n < 2; ++n) acc[a][b][m][n] = (f32x4){0.f, 0.f, 0.f, 0.f};
    bf16x8 At[4][2], B0[2][2], B1[2][2];
    const char* cA = (const char*)g.A + (size_t)cur.pm * tstepA + (g.kwin ? (size_t)(cur.pn % g.kwin) * K * 2 : 0); const char* cB = (const char*)g.Bt + (size_t)cur.pn * tstep;
    S.a_ready(cur);
    if constexpr (SP2) {
        PG8_STAGE(PG8_SB(0, 0), cB, voffB); PG8_STAGE(PG8_SB(0, 1), cB + hstep, voffB); PG8_STAGE(PG8_SA(0, 0), cA, voffA); PG8_STAGE(PG8_SA(0, 1), cA + hstepA, voffA);
        if (wr == 1) PG8_BAR;
        PG8_WAIT_V(2); PG8_BAR;
        PG8_STAGE(PG8_SB(1, 0), cB + kstep, voffB); PG8_STAGE(PG8_SA(1, 0), cA + kstep, voffA); PG8_STAGE(PG8_SB(1, 1), cB + hstep + kstep, voffB);
        PG8_WAIT_V(6); PG8_BAR;
    } else {
        PG8_STAGE(PG8_SB(0, 0), cB, voffB); PG8_STAGE(PG8_SA(0, 0), cA, voffA); PG8_STAGE(PG8_SB(0, 1), cB + hstep, voffB); PG8_STAGE(PG8_SA(0, 1), cA + hstepA, voffA);
        if (wr == 1) PG8_BAR;
        PG8_WAIT_V(4); PG8_BAR;
        PG8_STAGE(PG8_SB(1, 0), cB + kstep, voffB); PG8_STAGE(PG8_SA(1, 0), cA + kstep, voffA); PG8_STAGE(PG8_SB(1, 1), cB + hstep + kstep, voffB);
        PG8_WAIT_V(6); PG8_BAR;
    }
    for (;;) {
        const bool has_next = S.next(ui + 1, nxt);
        const char* nA = has_next ? (const char*)g.A + (size_t)nxt.pm * tstepA + (g.kwin ? (size_t)(nxt.pn % g.kwin) * K * 2 : 0) : cA; const char* nB = has_next ? (const char*)g.Bt + (size_t)nxt.pn * tstep : cB;
        for (int t = 0; t < nt; t += 2) {
            const bool last = (t == nt - 2);
            const char* a1 = cA + (size_t)(t + 1) * kstep;
            const char* a2 = last ? nA : cA + (size_t)(t + 2) * kstep; const char* b2 = last ? nB : cB + (size_t)(t + 2) * kstep;
            const char* a3 = a2 + kstep; const char* b3 = b2 + kstep;
            if (last && has_next) S.a_ready(nxt);
            if constexpr (SP2) {
            PG8_LDB(B0, 0, 0); PG8_LDB(B1, 0, 1); PG8_SCHED; PG8_LDA(At, 0, 0); PG8_STAGE(PG8_SA(1, 1), a1 + hstepA, voffA);
            PG8_WAIT_V(8); PG8_WAIT_L(0); PG8_BAR; PG8_MMA(0, 0, At, B0); PG8_MMA(0, 1, At, B1); PG8_BAR; PG8_SCHED;
            PG8_LDA(At, 0, 1); PG8_STAGE(PG8_SB(0, 0), b2, voffB); PG8_STAGE(PG8_SB(0, 1), b2 + hstep, voffB); PG8_STAGE(PG8_SA(0, 0), a2, voffA);
            PG8_WAIT_V(8); PG8_WAIT_L(0); PG8_BAR; PG8_MMA(1, 0, At, B0); PG8_MMA(1, 1, At, B1); PG8_BAR; PG8_SCHED;
            PG8_LDB(B0, 1, 0); PG8_LDB(B1, 1, 1); PG8_SCHED; PG8_LDA(At, 1, 0); PG8_STAGE(PG8_SA(0, 1), a2 + hstepA, voffA);
            PG8_WAIT_V(8); PG8_WAIT_L(0); PG8_BAR; PG8_MMA(0, 0, At, B0); PG8_MMA(0, 1, At, B1); PG8_BAR; PG8_SCHED;
            PG8_LDA(At, 1, 1); PG8_STAGE(PG8_SB(1, 0), b3, voffB); PG8_STAGE(PG8_SB(1, 1), b3 + hstep, voffB); PG8_STAGE(PG8_SA(1, 0), a3, voffA);
            PG8_WAIT_V(8); PG8_WAIT_L(0); PG8_BAR; PG8_MMA(1, 0, At, B0); PG8_MMA(1, 1, At, B1); PG8_BAR; PG8_SCHED;
            } else {
            PG8_LDB(B0, 0, 0); PG8_SCHED; PG8_LDA(At, 0, 0); PG8_STAGE(PG8_SA(1, 1), a1 + hstepA, voffA);
            PG8_WAIT_L(8); PG8_BAR; PG8_WAIT_L(0); PG8_MMA(0, 0, At, B0); PG8_BAR; PG8_SCHED;
            PG8_LDB(B1, 0, 1); PG8_STAGE(PG8_SB(0, 0), b2, voffB);
            PG8_BAR; PG8_WAIT_L(0); PG8_MMA(0, 1, At, B1); PG8_BAR;
            PG8_LDA(At, 0, 1); PG8_STAGE(PG8_SA(0, 0), a2, voffA);
            PG8_BAR; PG8_WAIT_L(0); PG8_MMA(1, 0, At, B0); PG8_BAR; PG8_SCHED;
            PG8_STAGE(PG8_SB(0, 1), b2 + hstep, voffB);
            PG8_WAIT_V(6); PG8_BAR; PG8_MMA(1, 1, At, B1); PG8_BAR;
            PG8_LDB(B0, 1, 0); PG8_SCHED; PG8_LDA(At, 1, 0); PG8_STAGE(PG8_SA(0, 1), a2 + hstepA, voffA);
            PG8_WAIT_L(8); PG8_BAR; PG8_WAIT_L(0); PG8_MMA(0, 0, At, B0); PG8_BAR; PG8_SCHED;
            PG8_LDB(B1, 1, 1); PG8_STAGE(PG8_SB(1, 0), b3, voffB);
            PG8_BAR; PG8_WAIT_L(0); PG8_MMA(0, 1, At, B1); PG8_BAR;
            PG8_LDA(At, 1, 1); PG8_STAGE(PG8_SA(1, 0), a3, voffA);
            PG8_BAR; PG8_WAIT_L(0); PG8_MMA(1, 0, At, B0); PG8_BAR; PG8_SCHED;
            PG8_STAGE(PG8_SB(1, 1), b3 + hstep, voffB);
            PG8_WAIT_V(6); PG8_BAR; PG8_MMA(1, 1, At, B1); PG8_BAR;
            }
        }
        if constexpr (ALIGN_EPI) { if (wr == 0) PG8_BAR; }
        if constexpr (!Epi::AFTER_DRAIN) { E(acc, cur, wr, wc, fr, fq); S.done(cur); }
        if (!has_next) break;
#pragma unroll
        for (int a = 0; a < 2; ++a)
#pragma unroll
            for (int b = 0; b < 2; ++b)
#pragma unroll
                for (int m = 0; m < 4; ++m)
#pragma unroll
                    for (int n = 0; n < 2; ++n) acc[a][b][m][n] = (f32x4){0.f, 0.f, 0.f, 0.f};
        cur = nxt; cA = nA; cB = nB; ++ui;
        if constexpr (ALIGN_EPI) { if (wr == 1) PG8_BAR; }
    }
    PG8_WAIT_V(0);
    if constexpr (!ALIGN_EPI) { if (wr == 0) PG8_BAR; }
    PG8_BAR;
    if constexpr (Epi::AFTER_DRAIN) { E.fused(acc, cur, wr, wc, fr, fq, lds, wid, lane); S.done(cur); }
#undef PG8_SA
#undef PG8_SB
#undef PG8_STAGE
#undef PG8_LDA
#undef PG8_LDB
#undef PG8_MMA
#undef PG8_WAIT_V
#undef PG8_WAIT_L
#undef PG8_BAR
#undef PG8_SCHED
}
}
namespace attn {
using bf16 = __hip_bfloat16;
constexpr int   D = 128, NW = 8, QBLK = 32, KVBLK = 64;
constexpr float SCALE = 0.088388347648318440f;
constexpr float THR = 8.f;
constexpr int SDEPTH = 2;
constexpr int LDQ = 10240, LDK = 10240, LDO = 4096;
constexpr size_t SHM_V = KVBLK * D * 2, SHM_K = KVBLK * D * 2, SHM_ATTN = 2 * SHM_V + 2 * SHM_K + NW * 64 * 4;
using bf16x8 = __attribute__((ext_vector_type(8))) short;
using s16x4  = __attribute__((ext_vector_type(4))) short;
using f32x16 = __attribute__((ext_vector_type(16))) float;
using f32x8  = __attribute__((ext_vector_type(8))) float;
using u32x4  = __attribute__((ext_vector_type(4))) unsigned;
#define KSWZ(row, colB) ((row) * 256 + ((colB) ^ (((row) & 7) << 4)))
#define SBAR() __builtin_amdgcn_sched_barrier(0)
__device__ __forceinline__ int crow(int r, int hi) { return (r & 3) + 8 * (r >> 2) + 4 * hi; }
__device__ __forceinline__ unsigned cvtpk(float lo, float hi) {
  unsigned r; asm volatile("v_cvt_pk_bf16_f32 %0, %1, %2" : "=v"(r) : "v"(lo), "v"(hi)); return r;
}
template <typename TIn> struct Stage;
template <> struct Stage<bf16>  { using T = bf16x8;
  __device__ static __forceinline__ T ld8(const bf16* p) { return *reinterpret_cast<const bf16x8*>(p); }
  __device__ static __forceinline__ bf16x8 tobf(T x) { return x; } };
template <> struct Stage<float> { using T = f32x8;
  __device__ static __forceinline__ T ld8(const float* p) { return *reinterpret_cast<const f32x8*>(p); }
  __device__ static __forceinline__ bf16x8 tobf(T x) {
    u32x4 w = {cvtpk(x[0], x[1]), cvtpk(x[2], x[3]), cvtpk(x[4], x[5]), cvtpk(x[6], x[7])}; return *reinterpret_cast<bf16x8*>(&w); } };

__device__ __forceinline__ void partialSM(f32x16& p0, f32x16& p1, float& m_reg, float& mn, float& alpha) {
  constexpr float C = SCALE * 1.4426950408889634f;
  float pmax = p0[0]; for (int r = 1; r < 16; ++r) pmax = fmaxf(pmax, p0[r]); for (int r = 0; r < 16; ++r) pmax = fmaxf(pmax, p1[r]);
  { auto rr = __builtin_amdgcn_permlane32_swap(__float_as_uint(pmax), __float_as_uint(pmax), false, false);
    pmax = fmaxf(__uint_as_float(rr[0]), __uint_as_float(rr[1])); }
  if (__builtin_expect(__all(pmax - m_reg <= THR / SCALE), 1)) { mn = m_reg; alpha = 1.f; }
  else { mn = fmaxf(m_reg, pmax); alpha = __builtin_amdgcn_exp2f((m_reg - mn) * C); m_reg = mn; }
  float mnC = -mn * C;
  for (int r = 0; r < 16; ++r) p0[r] = fmaf(p0[r], C, mnC); for (int r = 0; r < 16; ++r) p1[r] = fmaf(p1[r], C, mnC);
  for (int r = 0; r < 16; ++r) p0[r] = __builtin_amdgcn_exp2f(p0[r]);
}
__device__ __forceinline__ void finishSM(f32x16& p0, f32x16& p1, float alpha, float& l_reg, bf16x8& pa0, bf16x8& pa1, bf16x8& pa2, bf16x8& pa3) {
  for (int r = 0; r < 16; ++r) p1[r] = __builtin_amdgcn_exp2f(p1[r]);
  float ps = 0; for (int r = 0; r < 16; ++r) ps += p0[r]; for (int r = 0; r < 16; ++r) ps += p1[r];
  { auto rr = __builtin_amdgcn_permlane32_swap(__float_as_uint(ps), __float_as_uint(ps), false, false);
    ps = __uint_as_float(rr[0]) + __uint_as_float(rr[1]); }
  l_reg = l_reg * alpha + ps;
#define PK4(P, BASE, OUT) do { unsigned a0 = cvtpk(P[BASE + 0], P[BASE + 1]), a1 = cvtpk(P[BASE + 2], P[BASE + 3]);   \
    unsigned b0 = cvtpk(P[BASE + 4], P[BASE + 5]), b1 = cvtpk(P[BASE + 6], P[BASE + 7]);                              \
    auto r0 = __builtin_amdgcn_permlane32_swap(a0, b0, false, false); auto r1 = __builtin_amdgcn_permlane32_swap(a1, b1, false, false); \
    u32x4 w = {r0[0], r1[0], r0[1], r1[1]}; OUT = *reinterpret_cast<bf16x8*>(&w); } while (0)
  PK4(p0, 0, pa0); PK4(p0, 8, pa1); PK4(p1, 0, pa2); PK4(p1, 8, pa3);
#undef PK4
}
__device__ __forceinline__ void qkt(f32x16& p0, f32x16& p1, const bf16* Ks, const bf16x8* qr, int r32, int hi) {
  p0 = f32x16{}; p1 = f32x16{};
  for (int d0 = 0; d0 < 8; ++d0) { int cb = (d0 * 16 + hi * 8) * 2;
    bf16x8 b0 = *reinterpret_cast<const bf16x8*>((const char*)Ks + KSWZ(r32, cb));
    bf16x8 b1 = *reinterpret_cast<const bf16x8*>((const char*)Ks + KSWZ(32 + r32, cb));
    p0 = __builtin_amdgcn_mfma_f32_32x32x16_bf16(b0, qr[d0], p0, 0, 0, 0);
    p1 = __builtin_amdgcn_mfma_f32_32x32x16_bf16(b1, qr[d0], p1, 0, 0, 0); }
}
__device__ __forceinline__ int v_st(int k, int c) { const int kk = (k & ~0xC) | ((k & 4) << 1) | ((k & 8) >> 1); return ((kk >> 3) * 4 + (c >> 5)) * 512 + ((kk & 7) * 32 + (c & 31)) * 2; }
__device__ __forceinline__ int v_rd_base(int lane) { return ((lane & 3) << 3) | (((lane >> 2) & 3) << 6) | (((lane >> 4) & 1) << 5) | (((lane >> 5) & 1) << 8); }
constexpr int v_rd_off(int d0, int ks, int half) { return d0 * 512 + ks * 4096 + half * 2048; }
template <int OFF> __device__ __forceinline__ s16x4 tr_read(int vb) {
  s16x4 r; asm volatile("ds_read_b64_tr_b16 %0, %1 offset:%2" : "=&v"(r) : "v"(vb), "i"(OFF) : "memory"); return r;
}
template <int D0> __device__ __forceinline__ void pv_one(f32x16& od, int vb, bf16x8 pa0, bf16x8 pa1, bf16x8 pa2, bf16x8 pa3) {
  const s16x4 l0 = tr_read<v_rd_off(D0, 0, 0)>(vb), h0 = tr_read<v_rd_off(D0, 0, 1)>(vb), l1 = tr_read<v_rd_off(D0, 1, 0)>(vb), h1 = tr_read<v_rd_off(D0, 1, 1)>(vb);
  const s16x4 l2 = tr_read<v_rd_off(D0, 2, 0)>(vb), h2 = tr_read<v_rd_off(D0, 2, 1)>(vb), l3 = tr_read<v_rd_off(D0, 3, 0)>(vb), h3 = tr_read<v_rd_off(D0, 3, 1)>(vb);
  asm volatile("s_waitcnt lgkmcnt(0)" ::: "memory"); SBAR();
#define PK(L, H) (bf16x8){L[0], L[1], L[2], L[3], H[0], H[1], H[2], H[3]}
  od = __builtin_amdgcn_mfma_f32_32x32x16_bf16(pa0, PK(l0, h0), od, 0, 0, 0);
  od = __builtin_amdgcn_mfma_f32_32x32x16_bf16(pa1, PK(l1, h1), od, 0, 0, 0);
  od = __builtin_amdgcn_mfma_f32_32x32x16_bf16(pa2, PK(l2, h2), od, 0, 0, 0);
  od = __builtin_amdgcn_mfma_f32_32x32x16_bf16(pa3, PK(l3, h3), od, 0, 0, 0);
#undef PK
}
__device__ __forceinline__ void pv_d0(f32x16* o, int vb, bf16x8 pa0, bf16x8 pa1, bf16x8 pa2, bf16x8 pa3) {
  pv_one<0>(o[0], vb, pa0, pa1, pa2, pa3); pv_one<1>(o[1], vb, pa0, pa1, pa2, pa3); pv_one<2>(o[2], vb, pa0, pa1, pa2, pa3); pv_one<3>(o[3], vb, pa0, pa1, pa2, pa3);
}

template <typename TQ>
__device__ __forceinline__ void attn_dense_body(const TQ* __restrict__ Qb, const bf16* __restrict__ Kh, const bf16* __restrict__ Vh,
                                                bf16* __restrict__ Ob, int seq, char* lds) {
  using St = Stage<bf16>; using SQ = Stage<TQ>;
  int tid_ = threadIdx.x; asm volatile("" : "+v"(tid_));
  const int tid = tid_, wid = tid >> 6, lane = tid & 63, r32 = lane & 31, hi = lane >> 5;
  bf16* V_lds = (bf16*)lds; bf16* K_lds = (bf16*)(lds + 2 * SHM_V);
  float* ws = (float*)(lds + 2 * SHM_V + 2 * SHM_K) + wid * 64; float* li_l = ws; float* al_l = ws + 32;
  float m_reg = -1e30f, l_reg = 0; f32x16 o[4] = {}; bf16x8 qr[8];
  const TQ* Qw = Qb + (long)(wid * QBLK + r32) * LDQ + hi * 8;
#pragma unroll
  for (int d0 = 0; d0 < 8; ++d0) qr[d0] = SQ::tobf(SQ::ld8(Qw + d0 * 16));
  const int sr = tid >> 4, sc = (tid & 15) * 8, vst0 = v_st(sr, sc), vst1 = v_st(32 + sr, sc);
  const int vb0 = (int)(uintptr_t)V_lds + v_rd_base(lane);
  struct { typename St::T vs0, vs1, ks0, ks1; } sr_[SDEPTH];
#define SLOAD(i, k0) do { sr_[i].vs0 = St::ld8(&Vh[(long)((k0) + sr) * LDK + sc]); sr_[i].vs1 = St::ld8(&Vh[(long)((k0) + 32 + sr) * LDK + sc]); \
    sr_[i].ks0 = St::ld8(&Kh[(long)((k0) + sr) * LDK + sc]); sr_[i].ks1 = St::ld8(&Kh[(long)((k0) + 32 + sr) * LDK + sc]); } while (0)
#define SWRITE(b, i) do { *(bf16x8*)((char*)V_lds + (b) * SHM_V + vst0) = St::tobf(sr_[i].vs0);          \
    *(bf16x8*)((char*)V_lds + (b) * SHM_V + vst1) = St::tobf(sr_[i].vs1); int kc = sc * 2;               \
    *(bf16x8*)((char*)K_lds + (b) * SHM_K + KSWZ(sr, kc)) = St::tobf(sr_[i].ks0);                       \
    *(bf16x8*)((char*)K_lds + (b) * SHM_K + KSWZ(32 + sr, kc)) = St::tobf(sr_[i].ks1); } while (0)
#define SWAIT() do { if constexpr (SDEPTH == 2) asm volatile("s_waitcnt vmcnt(4)" ::: "memory"); else asm volatile("s_waitcnt vmcnt(0)" ::: "memory"); } while (0)
#define RESC(a) do { if (__any((a) < 1.f)) { if (hi == 0) al_l[r32] = (a); asm volatile("s_waitcnt lgkmcnt(0)" ::: "memory"); \
    for (int d = 0; d < 4; ++d) for (int r = 0; r < 16; ++r) o[d][r] *= al_l[crow(r, hi)]; } } while (0)
  f32x16 pA0, pA1, pB0, pB1; float mnA, mnB, alA, alB; bf16x8 pa0, pa1, pa2, pa3; const int NT = seq / KVBLK;
  constexpr int SE = 0, SO = SDEPTH - 1;
  SLOAD(SE, 0); asm volatile("s_waitcnt vmcnt(0)" ::: "memory"); SWRITE(0, SE); __syncthreads();
  qkt(pA0, pA1, K_lds, qr, r32, hi); partialSM(pA0, pA1, m_reg, mnA, alA);
  SLOAD(SO, KVBLK); if constexpr (SDEPTH == 2) { if (2 < NT) SLOAD(SE, 2 * KVBLK); }
  SWAIT(); SWRITE(1, SO); __syncthreads();
  for (int j = 1; j + 1 < NT; j += 2) {
    SBAR(); qkt(pB0, pB1, (bf16*)((char*)K_lds + SHM_K), qr, r32, hi);
    finishSM(pA0, pA1, alA, l_reg, pa0, pa1, pa2, pa3); SBAR();
    SLOAD(SO, (j + SDEPTH) * KVBLK); SBAR();
    pv_d0(o, vb0, pa0, pa1, pa2, pa3); partialSM(pB0, pB1, m_reg, mnB, alB);
    __syncthreads(); SWAIT(); SWRITE(0, SE);
    RESC(alB); __syncthreads();
    SBAR(); qkt(pA0, pA1, K_lds, qr, r32, hi);
    finishSM(pB0, pB1, alB, l_reg, pa0, pa1, pa2, pa3); SBAR();
    if (SDEPTH == 1 || j + 3 < NT) SLOAD(SE, (j + 1 + SDEPTH) * KVBLK); SBAR();
    pv_d0(o, vb0 + (int)SHM_V, pa0, pa1, pa2, pa3); partialSM(pA0, pA1, m_reg, mnA, alA);
    __syncthreads(); SWAIT(); SWRITE(1, SO);
    RESC(alA); __syncthreads();
  }
  SBAR(); qkt(pB0, pB1, (bf16*)((char*)K_lds + SHM_K), qr, r32, hi);
  finishSM(pA0, pA1, alA, l_reg, pa0, pa1, pa2, pa3); SBAR();
  pv_d0(o, vb0, pa0, pa1, pa2, pa3); partialSM(pB0, pB1, m_reg, mnB, alB);
  __syncthreads(); RESC(alB);
  finishSM(pB0, pB1, alB, l_reg, pa0, pa1, pa2, pa3); SBAR();
  pv_d0(o, vb0 + (int)SHM_V, pa0, pa1, pa2, pa3);
  if (hi == 0) li_l[r32] = l_reg; asm volatile("s_waitcnt lgkmcnt(0)" ::: "memory");
  float rli[16];
#pragma unroll
  for (int r = 0; r < 16; ++r) rli[r] = __builtin_amdgcn_rcpf(li_l[crow(r, hi)]);
  bf16* Ow = Ob + (long)(wid * QBLK) * LDO;
#pragma unroll
  for (int r = 0; r < 16; ++r) { int orow = crow(r, hi);
    for (int d0 = 0; d0 < 4; ++d0) Ow[(long)orow * LDO + d0 * 32 + r32] = __float2bfloat16(o[d0][r] * rli[r]); }
#undef SLOAD
#undef SWRITE
#undef SWAIT
#undef RESC
}
}
#define GAS __attribute__((address_space(1)))
#define LAS __attribute__((address_space(3)))
typedef unsigned short bf16;
typedef unsigned v4u __attribute__((ext_vector_type(4)));
typedef float f32x4 __attribute__((ext_vector_type(4)));
typedef short bf16x8 __attribute__((ext_vector_type(8)));
typedef GAS unsigned gu32;
typedef GAS unsigned long long gu64;
#define RLX_AGENT __ATOMIC_RELAXED, __HIP_MEMORY_SCOPE_AGENT
#define LDS_WAIT() asm volatile("s_waitcnt lgkmcnt(0)" ::: "memory")
#define VM_WAIT() asm volatile("s_waitcnt vmcnt(0)" ::: "memory")
__device__ __forceinline__ unsigned long long rt() { return __builtin_amdgcn_s_memrealtime(); }
__device__ __forceinline__ unsigned f2bf(float f) { unsigned u = __builtin_bit_cast(unsigned, f); return (u + 0x7fffu + ((u >> 16) & 1u)) >> 16; }
__device__ __forceinline__ unsigned pk2(float lo, float hi) { return f2bf(lo) | (f2bf(hi) << 16); }

#define XB_TMO      128
#define XB_XCNT(j)  (256  + 64 * (j))
#define XB_XSUB(j)  (1280 + 64 * (j))
#define XB_XGEN(j)  (2304 + 64 * (j))
#define XB_TOP      3328
#define XB_TOPGEN   3392
#define XCD_BAR_WORDS 3456
#define XB_SPIN_CAP (1u << 18)

__device__ __forceinline__ unsigned xb_ld(unsigned* p)              { return __hip_atomic_load(p, __ATOMIC_RELAXED, __HIP_MEMORY_SCOPE_AGENT); }
__device__ __forceinline__ unsigned xb_add(unsigned* p, unsigned v) { return __hip_atomic_fetch_add(p, v, __ATOMIC_RELAXED, __HIP_MEMORY_SCOPE_AGENT); }
__device__ __forceinline__ unsigned xb_xcc_id() { return (unsigned)__builtin_amdgcn_s_getreg((3 << 11) | 20) & 0xFu; }
#define XB_SPIN(cond, bar) do { unsigned _sp = 0; while (cond) { __builtin_amdgcn_s_sleep(1); \
    if ((++_sp & 255u) == 0u) { if (xb_ld(&(bar)[XB_TMO])) break; if (_sp > XB_SPIN_CAP) { atomicAdd(&(bar)[XB_TMO], 1u); break; } } } } while (0)

struct XcdBarrier {
    unsigned* bar; unsigned x;
    volatile LAS unsigned* st;
};

__device__ __forceinline__ XcdBarrier xcd_barrier_post(unsigned* bar, volatile LAS unsigned* st) {
    XcdBarrier b; b.bar = bar; b.x = xb_xcc_id(); b.st = st;
    if (threadIdx.x == 0) (void)xb_add(&bar[XB_XCNT(b.x)], 1u);
    return b;
}
__device__ __forceinline__ void xcd_barrier_complete(unsigned* bar, unsigned x, unsigned& nloc, unsigned& nx) {
    const unsigned G = gridDim.x * gridDim.y * gridDim.z;
    unsigned sum, cnt, mine, sp = 0u;
    for (;;) {
        sum = 0u; cnt = 0u; mine = 0u;
#pragma unroll
        for (unsigned j = 0; j < 16; ++j) { const unsigned c = xb_ld(&bar[XB_XCNT(j)]); sum += c; cnt += (c > 0u) ? 1u : 0u; mine = (j == x) ? c : mine; }
        if (sum == G) break;
        __builtin_amdgcn_s_sleep(1);
        if ((++sp & 255u) == 0u) { if (xb_ld(&bar[XB_TMO])) break; if (sp > XB_SPIN_CAP) { atomicAdd(&bar[XB_TMO], 1u); break; } }
    }
    nloc = mine > 0u ? mine : 1u; nx = cnt > 0u ? cnt : 1u;
}

__device__ __forceinline__ void xcd_barrier(const XcdBarrier& b) {
    asm volatile("s_waitcnt vmcnt(0)" ::: "memory");
    __syncthreads();
    if (threadIdx.x == 0) {
        unsigned* bar = b.bar;
        __builtin_amdgcn_s_waitcnt(0);
        unsigned nloc = b.st[0], nx = b.st[1];
        if (nloc == 0u) { xcd_barrier_complete(bar, b.x, nloc, nx); b.st[0] = nloc; b.st[1] = nx; }
        const unsigned old = xb_add(&bar[XB_XSUB(b.x)], 1u);
        const unsigned gen = old / nloc;
        if (old + 1u == (gen + 1u) * nloc) {
            __builtin_amdgcn_fence(__ATOMIC_RELEASE, "agent");
            asm volatile("s_waitcnt vmcnt(0)" ::: "memory");
            const unsigned og = xb_add(&bar[XB_TOP], 1u);
            const unsigned tg = og / nx;
            if (og + 1u == (tg + 1u) * nx) xb_add(&bar[XB_TOPGEN], 1u);
            else XB_SPIN(xb_ld(&bar[XB_TOPGEN]) == tg, bar);
            __builtin_amdgcn_fence(__ATOMIC_ACQUIRE, "agent");
            xb_add(&bar[XB_XGEN(b.x)], 1u);
            asm volatile("s_waitcnt vmcnt(0)" ::: "memory");
        } else {
            XB_SPIN(xb_ld(&bar[XB_XGEN(b.x)]) == gen, bar);
            __builtin_amdgcn_fence(__ATOMIC_ACQUIRE, "agent");
            asm volatile("s_waitcnt vmcnt(0)" ::: "memory");
        }
    }
    __syncthreads();
}

constexpr int NWAVES = 8, NTHR = NWAVES * 64;
constexpr int BATCH = 8, SEQ = 2048, M = BATCH * SEQ, DM = 4096, NU = 10240, FF = 11008, NG = 2 * FF, HD = 128;
constexpr int AW = 1024, BW = 1024;
constexpr int UA_Q = 0, UA_FF = 1024, UA_FB = 2048, UA_I = 3072, UA_G = 4096, UB_X = 5120, UB_GATE = 6144, UC_Q = 7168, UC_K = 9216, UC_V = 9728;
constexpr float LN_EPS = 1e-5f, RMS_EPS = 1e-6f, DN_ALPHA = 1.41421356237309515f;
#ifndef MK_SINGLE
#define MK_SINGLE 1
#endif
constexpr int PH_PER_LAYER = 11, NPH = 1 + 2 * PH_PER_LAYER;

constexpr size_t MiB = 1u << 20;
constexpr size_t WS_CTL = 0, CTL_ZERO_BYTES = 1 * MiB;
constexpr size_t SZ_WIN = (size_t)NU * DM * 2, SZ_WOUT = (size_t)DM * DM * 2, SZ_WUP = (size_t)NG * DM * 2, SZ_WDN = (size_t)DM * FF * 2, SZ_WRG = (size_t)4096 * 1024 * 2;
constexpr size_t WS_WIN = 1 * MiB, WS_WOUT = WS_WIN + 2 * SZ_WIN, WS_WUP = WS_WOUT + 2 * SZ_WOUT, WS_WDN = WS_WUP + 2 * SZ_WUP, WS_WRG = WS_WDN + 2 * SZ_WDN, WS_TAB = WS_WRG + 2 * SZ_WRG;
constexpr size_t WS_ST = WS_TAB + 65536;
constexpr size_t WS_GU = WS_TAB + 1 * MiB;
constexpr size_t SZ_GU = (size_t)M * NG * 2;
constexpr size_t WS_U = WS_GU;
constexpr size_t WS_R = WS_GU + 384 * MiB;
constexpr size_t WS_ACT = WS_GU + SZ_GU;
constexpr size_t SZ_ACT = (size_t)M * FF * 2;
constexpr size_t WS_XC = WS_ACT, WS_G = WS_XC + 32 * MiB, WS_HF = WS_G + 128 * MiB, WS_OF = WS_HF + 64 * MiB, WS_OB = WS_OF + 64 * MiB, WS_HBK = WS_OB + 64 * MiB;
constexpr size_t WS_Y = WS_ACT + ((SZ_ACT > 416 * MiB) ? SZ_ACT : 416 * MiB);
constexpr size_t WS_HB = WS_Y + 128 * MiB;
constexpr size_t WS_END = WS_HB + 128 * MiB;
static_assert(WS_HBK + 64 * MiB <= WS_Y && WS_R + 256 * MiB <= WS_ACT && WS_U + (size_t)M * NU * 2 <= WS_R, "d_ws map");
constexpr int CW_BAR = 4096;
constexpr int CW_QUEUE = 8192;

constexpr int RING_BYTES = 131072, MISC_OFF = RING_BYTES + 320, LDS_BYTES = 147456;

__device__ __forceinline__ float bf2f(bf16 b) { return __uint_as_float((unsigned)b << 16); }
__device__ __forceinline__ float sigm(float x) { return __builtin_amdgcn_rcpf(1.f + __expf(-x)); }
__device__ __forceinline__ float gelu_tanh(float x) { const float y = 0.7978845608028654f * (x + 0.044715f * x * x * x); const float t = 1.f - 2.f * __builtin_amdgcn_rcpf(1.f + __expf(2.f * y)); return 0.5f * x * (1.f + t); }
__device__ __forceinline__ int fresh_tid() { int t = threadIdx.x; asm volatile("" : "+v"(t)); return t; }
__device__ __forceinline__ float wave_sum(float v) {
#pragma unroll
    for (int o = 1; o < 64; o <<= 1) v += __shfl_xor(v, o);
    return v;
}

struct Args { const float* in[24]; float* out; unsigned char* ws; int ph_lo, ph_hi, pad0, pad1; };
struct Frame {
    LAS unsigned char* lds;
    volatile LAS unsigned* MISC;
    gu32* ctl;
    int tid, lane, wave, G, gw, NGW;
    float* H;
    unsigned char* ws;
};
#define WSP(T, off) ((T*)(F.ws + (off)))

template <bool GLU> __device__ __forceinline__ void p0_transpose_item(const float* W, int K, int N, bf16* WT, LAS float* scr, int item, int lane) {
    const int nblk = N / 32, kb = item / nblk, nb = item % nblk, k0 = 64 * kb, n0 = 32 * nb;
    const int nd0 = GLU ? ((n0 < FF) ? ((n0 >> 7) * 256 + (n0 & 127)) : (((n0 - FF) >> 7) * 256 + 128 + ((n0 - FF) & 127))) : n0;
    { f32x4 v[8]; const int kr = lane >> 3, n4 = (lane & 7) * 4;
#pragma unroll
      for (int i = 0; i < 8; ++i) v[i] = __builtin_nontemporal_load((const GAS f32x4*)(W + (size_t)(k0 + 8 * i + kr) * N + n0 + n4));
#pragma unroll
      for (int i = 0; i < 8; ++i) { LAS float* d = scr + (8 * i + kr) * 33 + n4; d[0] = v[i].x; d[1] = v[i].y; d[2] = v[i].z; d[3] = v[i].w; } }
    LDS_WAIT(); asm volatile("" ::: "memory");
    const int c = lane & 7;
#pragma unroll
    for (int j = 0; j < 4; ++j) { const int n = (lane >> 3) + 8 * j; const LAS float* s = scr + (8 * c) * 33 + n;
        v4u o; o.x = pk2(s[0 * 33], s[1 * 33]); o.y = pk2(s[2 * 33], s[3 * 33]); o.z = pk2(s[4 * 33], s[5 * 33]); o.w = pk2(s[6 * 33], s[7 * 33]);
        *(GAS v4u*)(WT + (size_t)(nd0 + n) * K + k0 + 8 * c) = o; }
    LDS_WAIT(); asm volatile("" ::: "memory");
}

__device__ __forceinline__ void ln_row(const float* src, const float* w, const float* b, float* dstF, bf16* dstB, float* st, int lane) {
    const GAS f32x4* xr = (const GAS f32x4*)src + lane;
    f32x4 v[16]; float s = 0.f;
#pragma unroll
    for (int j = 0; j < 16; ++j) { v[j] = xr[64 * j]; s += (v[j].x + v[j].y) + (v[j].z + v[j].w); }
    const float mean = wave_sum(s) * (1.f / DM); float s2 = 0.f;
#pragma unroll
    for (int j = 0; j < 16; ++j) { v[j] = v[j] - mean; s2 += (v[j].x * v[j].x + v[j].y * v[j].y) + (v[j].z * v[j].z + v[j].w * v[j].w); }
    const float rstd = 1.f / sqrtf(wave_sum(s2) * (1.f / DM) + LN_EPS);
    if (st && lane == 0) { st[0] = mean; st[1] = rstd; }
    GAS f32x4* of = (GAS f32x4*)dstF + lane; GAS unsigned long long* ob = (GAS unsigned long long*)dstB + lane;
    const GAS f32x4* wv = (const GAS f32x4*)w + lane; const GAS f32x4* bv = (const GAS f32x4*)b + lane;
#pragma unroll
    for (int j = 0; j < 16; ++j) { const f32x4 o = v[j] * rstd * wv[64 * j] + bv[64 * j]; if (dstF) of[64 * j] = o;
        if (dstB) ob[64 * j] = (unsigned long long)pk2(o.x, o.y) | ((unsigned long long)pk2(o.z, o.w) << 32); }
}
__device__ __forceinline__ void ln_row_bf(const bf16* src, const float* w, const float* b, float* dstF, bf16* dstB, float* st, int lane) {
    const GAS v4u* xr = (const GAS v4u*)src + lane;
    f32x4 v[16]; float s = 0.f;
#pragma unroll
    for (int j = 0; j < 8; ++j) { const v4u pw = xr[64 * j];
        v[2 * j] = (f32x4){__uint_as_float(pw.x << 16), __uint_as_float(pw.x & 0xffff0000u), __uint_as_float(pw.y << 16), __uint_as_float(pw.y & 0xffff0000u)};
        v[2 * j + 1] = (f32x4){__uint_as_float(pw.z << 16), __uint_as_float(pw.z & 0xffff0000u), __uint_as_float(pw.w << 16), __uint_as_float(pw.w & 0xffff0000u)};
        s += ((v[2 * j].x + v[2 * j].y) + (v[2 * j].z + v[2 * j].w)) + ((v[2 * j + 1].x + v[2 * j + 1].y) + (v[2 * j + 1].z + v[2 * j + 1].w)); }
    const float mean = wave_sum(s) * (1.f / DM); float s2 = 0.f;
#pragma unroll
    for (int j = 0; j < 16; ++j) { v[j] = v[j] - mean; s2 += (v[j].x * v[j].x + v[j].y * v[j].y) + (v[j].z * v[j].z + v[j].w * v[j].w); }
    const float rstd = 1.f / sqrtf(wave_sum(s2) * (1.f / DM) + LN_EPS);
    if (st && lane == 0) { st[0] = mean; st[1] = rstd; }
    GAS f32x4* of = (GAS f32x4*)dstF + 2 * lane; GAS v4u* ob = (GAS v4u*)dstB + lane;
    const GAS f32x4* wv = (const GAS f32x4*)w + 2 * lane; const GAS f32x4* bv = (const GAS f32x4*)b + 2 * lane;
#pragma unroll
    for (int j = 0; j < 8; ++j) { const f32x4 o0 = v[2 * j] * rstd * wv[128 * j] + bv[128 * j], o1 = v[2 * j + 1] * rstd * wv[128 * j + 1] + bv[128 * j + 1];
        if (dstF) { of[128 * j] = o0; of[128 * j + 1] = o1; }
        if (dstB) ob[64 * j] = (v4u){pk2(o0.x, o0.y), pk2(o0.z, o0.w), pk2(o1.x, o1.y), pk2(o1.z, o1.w)}; }
}
__device__ __forceinline__ void ln_phase_bf(Frame& F, const bf16* src, const float* w, const float* b, float* dstF, bf16* dstB, float* st) {
    const int lane = fresh_tid() & 63;
    for (int m = F.gw; m < M; m += F.NGW) ln_row_bf(src + (size_t)m * DM, w, b, dstF ? dstF + (size_t)m * DM : nullptr, dstB ? dstB + (size_t)m * DM : nullptr, st ? st + 2 * m : nullptr, lane);
}
__device__ __forceinline__ void ln_phase(Frame& F, const float* src, const float* w, const float* b, float* dstF, bf16* dstB, float* st) {
    const int lane = fresh_tid() & 63;
    for (int m = F.gw; m < M; m += F.NGW) ln_row(src + (size_t)m * DM, w, b, dstF ? dstF + (size_t)m * DM : nullptr, dstB ? dstB + (size_t)m * DM : nullptr, st ? st + 2 * m : nullptr, lane);
}

constexpr int CV_I_IN = (DM / 64) * (NU / 32), CV_I_OUT = (DM / 64) * (DM / 32), CV_I_UP = (DM / 64) * (NG / 32), CV_I_DN = (FF / 64) * (DM / 32);
constexpr int CV_L0 = CV_I_OUT + CV_I_UP + CV_I_DN, CV_ALL = CV_L0 + CV_I_IN + CV_L0, CV_CHUNK = 128, CV_NCHUNK = (CV_ALL + CV_CHUNK - 1) / CV_CHUNK;
__device__ __forceinline__ void conv_item(const Args& A, Frame& F, int idx, LAS float* scr, int lane) {
    int l = 0, r = idx;
    if (r >= CV_L0) { l = 1; r -= CV_L0;
        if (r < CV_I_IN) { p0_transpose_item<false>(A.in[3] + (size_t)DM * NU, DM, NU, WSP(bf16, WS_WIN + SZ_WIN), scr, r, lane); return; } r -= CV_I_IN; }
    if (r < CV_I_OUT) { p0_transpose_item<false>(A.in[15] + (size_t)l * DM * DM, DM, DM, WSP(bf16, WS_WOUT + l * SZ_WOUT), scr, r, lane); return; } r -= CV_I_OUT;
    if (r < CV_I_UP) { p0_transpose_item<true>(A.in[18] + (size_t)l * DM * NG, DM, NG, WSP(bf16, WS_WUP + l * SZ_WUP), scr, r, lane); return; } r -= CV_I_UP;
    p0_transpose_item<false>(A.in[21] + (size_t)l * FF * DM, FF, DM, WSP(bf16, WS_WDN + l * SZ_WDN), scr, r, lane);
}
__device__ __forceinline__ void conv_chunk(const Args& A, Frame& F, int chunk) {
    const int lane = fresh_tid() & 63; LAS float* scr = (LAS float*)(F.lds + F.wave * 16384);
    for (int k = 0; k < CV_CHUNK / NWAVES; ++k) { const int idx = chunk * CV_CHUNK + F.wave * (CV_CHUNK / NWAVES) + k; if (idx < CV_ALL) conv_item(A, F, idx, scr, lane); }
}

__device__ __forceinline__ void p0_prologue(const Args& A, Frame& F) {
    const int ftid = fresh_tid(), flane = ftid & 63;
    LAS float* scr = (LAS float*)(F.lds + F.wave * 16384);
    for (int it = F.gw; it < CV_I_IN; it += F.NGW) p0_transpose_item<false>(A.in[3], DM, NU, WSP(bf16, WS_WIN), scr, it, flane);
    const int gtid = blockIdx.x * NTHR + ftid, NT = F.G * NTHR;
    for (int it = gtid; it < 2 * 4096 * 32; it += NT) {
        const int l = it / (4096 * 32), r = it % (4096 * 32), col = r >> 5, k0 = (r & 31) * 8;
        const int gt = col >> 10, n = (col >> 7) & 7, e = col & 127, half = (col >> 7) & 1, d0 = k0 & 127;
        v4u o = {0u, 0u, 0u, 0u};
        if ((k0 >> 7) == half) { const float* W = ((gt & 1) ? A.in[10] : A.in[8]) + ((size_t)((l * 2 + (gt >> 1)) * 8 + n)) * 16384 + e;
            float x[8];
#pragma unroll
            for (int i = 0; i < 8; ++i) x[i] = W[(d0 + i) * 128];
            o.x = pk2(x[0], x[1]); o.y = pk2(x[2], x[3]); o.z = pk2(x[4], x[5]); o.w = pk2(x[6], x[7]); }
        *(GAS v4u*)(WSP(bf16, WS_WRG + l * SZ_WRG) + (size_t)col * 256 + k0) = o;
    }
    if (gtid < 64 * 32) {
        const int pos = gtid >> 5, j = gtid & 31;
        double invf = 1.0; for (int i = 0; i < j; ++i) invf *= 0.7498942093324559;
        const double ang = (double)pos * invf;
        const double kq = __builtin_rint(ang * 0.6366197723675814);
        const double r = (ang - kq * 1.5707963267948966) - kq * 6.123233995736766e-17, r2 = r * r;
        double sn = r * (1.0 + r2 * (-1.0 / 6 + r2 * (1.0 / 120 + r2 * (-1.0 / 5040 + r2 * (1.0 / 362880 + r2 * (-1.0 / 39916800 + r2 * (1.0 / 6227020800.0)))))));
        double cs = 1.0 + r2 * (-0.5 + r2 * (1.0 / 24 + r2 * (-1.0 / 720 + r2 * (1.0 / 40320 + r2 * (-1.0 / 3628800 + r2 * (1.0 / 479001600.0 + r2 * (-1.0 / 87178291200.0)))))));
        const int q = ((int)kq) & 3; double c, s;
        if (q == 0) { c = cs; s = sn; } else if (q == 1) { c = -sn; s = cs; } else if (q == 2) { c = -cs; s = -sn; } else { c = sn; s = -cs; }
        float* tab = WSP(float, WS_TAB); tab[2 * gtid] = (float)c; tab[2 * gtid + 1] = (float)s;
    }
    ln_phase(F, A.in[0], A.in[1], A.in[2], nullptr, WSP(bf16, WS_HB), WSP(float, WS_ST));
}

__device__ __forceinline__ void prep_phase(const Args& A, Frame& F, int l, int rep) {
    const int ftid = fresh_tid(), flane = ftid & 63;
    bf16* U = WSP(bf16, WS_U); const float* tab = WSP(float, WS_TAB);
    const float* qn = A.in[13] + l * HD; const float* kn = A.in[14] + l * HD;
    const int L = flane, d1 = (L & 31) + 64 * (L >> 5), d2 = d1 + 32;
    const float wq1 = qn[d1], wq2 = qn[d2], wk1 = kn[d1], wk2 = kn[d2];
    for (int m = F.gw; m < M; m += F.NGW) {
        bf16* p = U + (size_t)m * NU + UC_Q;
        const int t = m & (SEQ - 1), pos = (L < 32) ? (t >> 6) : (t & 63);
        const float c = tab[2 * (pos * 32 + (L & 31))], s = tab[2 * (pos * 32 + (L & 31)) + 1];
        float x1[20], x2[20];
#pragma unroll
        for (int j = 0; j < 20; ++j) { x1[j] = bf2f(p[j * HD + d1]); x2[j] = bf2f(p[j * HD + d2]); }
#pragma unroll
        for (int j = 0; j < 20; ++j) {
            const float rstd = 1.f / sqrtf(wave_sum(x1[j] * x1[j] + x2[j] * x2[j]) * (1.f / HD) + RMS_EPS);
            const float n1 = x1[j] * rstd * (j < 16 ? wq1 : wk1), n2 = x2[j] * rstd * (j < 16 ? wq2 : wk2);
            const float o1 = n1 * c - n2 * s, o2 = n2 * c + n1 * s;
            if (rep == 0 || o1 != o1) { p[j * HD + d1] = (bf16)f2bf(o1); p[j * HD + d2] = (bf16)f2bf(o2); } }
    }
    const float* cw = A.in[6] + l * 4 * BW; const float* cb = A.in[7] + l * BW; bf16* XC = WSP(bf16, WS_XC);
    const int gtid = blockIdx.x * NTHR + ftid, NT = F.G * NTHR;
    for (int it = gtid; it < M * 128; it += NT) {
        const int m = it >> 7, c = (it & 127) * 8, t = m & (SEQ - 1);
        float acc[8];
#pragma unroll
        for (int i = 0; i < 8; ++i) acc[i] = cb[c + i];
#pragma unroll
        for (int k = 0; k < 4; ++k) { const int tt = t + k - 2;
            if (tt >= 0 && tt < SEQ) { const v4u xv = *(const GAS v4u*)(U + (size_t)(m + k - 2) * NU + UB_X + c); const unsigned xw[4] = {xv.x, xv.y, xv.z, xv.w};
#pragma unroll
                for (int i = 0; i < 4; ++i) { acc[2 * i] += cw[k * BW + c + 2 * i] * __uint_as_float(xw[i] << 16); acc[2 * i + 1] += cw[k * BW + c + 2 * i + 1] * __uint_as_float(xw[i] & 0xffff0000u); } } }
        v4u o; o.x = pk2(acc[0], acc[1]); o.y = pk2(acc[2], acc[3]); o.z = pk2(acc[4], acc[5]); o.w = pk2(acc[6], acc[7]);
        *(GAS v4u*)(XC + (size_t)m * BW + c) = o;
    }
}

namespace hg {
constexpr int PQ = 136, PK = 72;
constexpr int O_QM = 0, O_KM = O_QM + 64 * PQ * 2, O_KMT = O_KM + 64 * PQ * 2, O_VT = O_KMT + 128 * PK * 2, O_ST = O_VT + 128 * PK * 2, O_P = O_ST + 128 * PQ * 2;
constexpr int O_QS = O_P + 64 * PK * 2, O_EBM = O_QS + 4 * 128 * 4, O_ELM = O_EBM + 512, O_LB = O_ELM + 512, O_END = O_LB + 512;
static_assert(O_END <= 131072, "hgrn LDS");
}
__device__ __forceinline__ void hgrn_item(const Args& A, Frame& F, int l, int id) {
    using namespace hg;
    const int dir = id & 1, h = (id >> 1) & 7, b = id >> 4, tid = fresh_tid(), lane = tid & 63, w = tid >> 6, fr = lane & 15, fq = lane >> 4;
    LAS unsigned char* L = F.lds;
    LAS float* QS = (LAS float*)(L + O_QS); LAS float* EBM = (LAS float*)(L + O_EBM); LAS float* ELM = (LAS float*)(L + O_ELM); LAS float* LB = (LAS float*)(L + O_LB);
    const bf16* U = WSP(bf16, WS_U); bf16* O = WSP(bf16, dir ? WS_OB : WS_OF);
    if (tid < 128) { float lb = 0.f;
        if (l == 1) { const float* lg = A.in[4]; const float l0 = lg[(0 * 2 + dir) * AW + h * HD + tid], l1 = lg[(1 * 2 + dir) * AW + h * HD + tid]; lb = 1.f / (1.f + expf(l0 - l1)); }
        LB[tid] = lb; }
    __syncthreads();
    const int d = tid & 127, iq = tid >> 7;
    const float lb = LB[d];
    const int zc = (dir ? UA_FB : UA_FF) + h * HD + d, qc = UA_Q + h * HD + d, vc = UA_I + h * HD + d;
    f32x4 S[8];
#pragma unroll
    for (int et = 0; et < 8; ++et) S[et] = (f32x4){0.f, 0.f, 0.f, 0.f};
    bf16 zr[16], qr[16], vr[16];
#define HG_LOAD(c) do { _Pragma("unroll") for (int r = 0; r < 16; ++r) { const int s_ = 64 * (c) + 16 * iq + r, t_ = dir ? (SEQ - 1 - s_) : s_; const bf16* row_ = U + (size_t)(b * SEQ + t_) * NU; \
        zr[r] = row_[zc]; qr[r] = row_[qc]; vr[r] = row_[vc]; } } while (0)
    HG_LOAD(0);
    const int it = w >> 1, jt0 = 2 * (w & 1), et0 = 4 * (w & 1);
    for (int c = 0; c < SEQ / 64; ++c) {
        float lf[16], kk[16]; float run = 0.f;
#pragma unroll
        for (int r = 0; r < 16; ++r) { const float z = bf2f(zr[r]);
            const float ez = __expf(-fabsf(z)), rc = __builtin_amdgcn_rcpf(1.f + ez);
            const float sg = z >= 0.f ? rc : ez * rc, sn = z >= 0.f ? ez * rc : rc;
            lf[r] = (lb > 0.f) ? __logf(lb + (1.f - lb) * sg) : (fminf(z, 0.f) - __logf(1.f + ez));
            kk[r] = (1.f - lb) * sn;
            run += lf[r]; lf[r] = run; }
        QS[iq * 128 + d] = run;
        __syncthreads();
        { const float q0 = QS[d], q1 = QS[128 + d], q2 = QS[256 + d], q3 = QS[384 + d];
          const float off = (iq > 0 ? q0 : 0.f) + (iq > 1 ? q1 : 0.f) + (iq > 2 ? q2 : 0.f);
          const float bmid = q0 + q1, blast = (q0 + q1) + (q2 + q3);
          if (iq == 0) { EBM[d] = __expf(bmid); ELM[d] = __expf(blast - bmid); }
          unsigned kt[8], vt[8];
#pragma unroll
          for (int r = 0; r < 16; r += 2) {
              const float x0 = lf[r] + off - bmid, x1 = lf[r + 1] + off - bmid;
              const float e0 = __expf(fminf(fmaxf(x0, -80.f), 80.f)), e1 = __expf(fminf(fmaxf(x1, -80.f), 80.f));
              const float qm0 = bf2f(qr[r]) * e0, qm1 = bf2f(qr[r + 1]) * e1;
              const float km0 = kk[r] * __builtin_amdgcn_rcpf(e0), km1 = kk[r + 1] * __builtin_amdgcn_rcpf(e1);
              const unsigned k0 = f2bf(km0), k1 = f2bf(km1);
              *(LAS bf16*)(L + O_QM + ((16 * iq + r) * PQ + d) * 2) = (bf16)f2bf(qm0); *(LAS bf16*)(L + O_QM + ((16 * iq + r + 1) * PQ + d) * 2) = (bf16)f2bf(qm1);
              *(LAS bf16*)(L + O_KM + ((16 * iq + r) * PQ + d) * 2) = (bf16)k0;        *(LAS bf16*)(L + O_KM + ((16 * iq + r + 1) * PQ + d) * 2) = (bf16)k1;
              kt[r >> 1] = k0 | (k1 << 16); vt[r >> 1] = (unsigned)vr[r] | ((unsigned)vr[r + 1] << 16); }
          *(LAS v4u*)(L + O_KMT + (d * PK + 16 * iq) * 2) = (v4u){kt[0], kt[1], kt[2], kt[3]}; *(LAS v4u*)(L + O_KMT + (d * PK + 16 * iq + 8) * 2) = (v4u){kt[4], kt[5], kt[6], kt[7]};
          *(LAS v4u*)(L + O_VT + (d * PK + 16 * iq) * 2) = (v4u){vt[0], vt[1], vt[2], vt[3]};  *(LAS v4u*)(L + O_VT + (d * PK + 16 * iq + 8) * 2) = (v4u){vt[4], vt[5], vt[6], vt[7]}; }
        if (c + 1 < SEQ / 64) HG_LOAD(c + 1);
        __syncthreads();
        { const f32x4 eb = *(const LAS f32x4*)(EBM + 16 * w + 4 * fq);
#pragma unroll
          for (int et = 0; et < 8; ++et) { S[et] = S[et] * eb;
              typedef unsigned u32x2 __attribute__((ext_vector_type(2)));
              *(LAS u32x2*)(L + O_ST + ((16 * et + fr) * PQ + 16 * w + 4 * fq) * 2) = (u32x2){pk2(S[et].x, S[et].y), pk2(S[et].z, S[et].w)}; } }
        bf16x8 aq[4];
#pragma unroll
        for (int k4 = 0; k4 < 4; ++k4) aq[k4] = *(const LAS bf16x8*)(L + O_QM + ((16 * it + fr) * PQ + 32 * k4 + 8 * fq) * 2);
#pragma unroll
        for (int jj = 0; jj < 2; ++jj) { const int jt = jt0 + jj; f32x4 sc = {0.f, 0.f, 0.f, 0.f};
#pragma unroll
            for (int k4 = 0; k4 < 4; ++k4) { const bf16x8 bk = *(const LAS bf16x8*)(L + O_KM + ((16 * jt + fr) * PQ + 32 * k4 + 8 * fq) * 2);
                sc = __builtin_amdgcn_mfma_f32_16x16x32_bf16(aq[k4], bk, sc, 0, 0, 0); }
            const int jcol = 16 * jt + fr;
#pragma unroll
            for (int r = 0; r < 4; ++r) { const int irow = 16 * it + 4 * fq + r; *(LAS bf16*)(L + O_P + (irow * PK + jcol) * 2) = (bf16)f2bf(jcol <= irow ? sc[r] : 0.f); } }
        __syncthreads();
        { bf16x8 ap[2];
#pragma unroll
          for (int k2 = 0; k2 < 2; ++k2) ap[k2] = *(const LAS bf16x8*)(L + O_P + ((16 * it + fr) * PK + 32 * k2 + 8 * fq) * 2);
#pragma unroll
          for (int ee = 0; ee < 4; ++ee) { const int et = et0 + ee; f32x4 o = {0.f, 0.f, 0.f, 0.f};
#pragma unroll
              for (int k4 = 0; k4 < 4; ++k4) { const bf16x8 bs = *(const LAS bf16x8*)(L + O_ST + ((16 * et + fr) * PQ + 32 * k4 + 8 * fq) * 2);
                  o = __builtin_amdgcn_mfma_f32_16x16x32_bf16(aq[k4], bs, o, 0, 0, 0); }
#pragma unroll
              for (int k2 = 0; k2 < 2; ++k2) { const bf16x8 bv = *(const LAS bf16x8*)(L + O_VT + ((16 * et + fr) * PK + 32 * k2 + 8 * fq) * 2);
                  o = __builtin_amdgcn_mfma_f32_16x16x32_bf16(ap[k2], bv, o, 0, 0, 0); }
#pragma unroll
              for (int r = 0; r < 4; ++r) { const int s_ = 64 * c + 16 * it + 4 * fq + r, t_ = dir ? (SEQ - 1 - s_) : s_;
                  O[(size_t)(b * SEQ + t_) * AW + h * HD + 16 * et + fr] = (bf16)f2bf(o[r]); } } }
        { bf16x8 ak[2];
#pragma unroll
          for (int k2 = 0; k2 < 2; ++k2) ak[k2] = *(const LAS bf16x8*)(L + O_KMT + ((16 * w + fr) * PK + 32 * k2 + 8 * fq) * 2);
          const f32x4 el = *(const LAS f32x4*)(ELM + 16 * w + 4 * fq);
#pragma unroll
          for (int et = 0; et < 8; ++et) {
#pragma unroll
              for (int k2 = 0; k2 < 2; ++k2) { const bf16x8 bv = *(const LAS bf16x8*)(L + O_VT + ((16 * et + fr) * PK + 32 * k2 + 8 * fq) * 2);
                  S[et] = __builtin_amdgcn_mfma_f32_16x16x32_bf16(ak[k2], bv, S[et], 0, 0, 0); }
              S[et] = S[et] * el; } }
    }
#undef HG_LOAD
}

__device__ __forceinline__ void hgrn_final_phase(const Args& A, Frame& F, int l) {
    const int ftid = fresh_tid(), flane = ftid & 63;
    const bf16* OFp = WSP(bf16, WS_OF); const bf16* OBp = WSP(bf16, WS_OB); const bf16* U = WSP(bf16, WS_U); bf16* Y = WSP(bf16, WS_Y);
    const float* nw = A.in[5] + l * AW; typedef float f32x2 __attribute__((ext_vector_type(2)));
    for (int m = F.gw; m < M; m += F.NGW) {
        unsigned a[8], bq[8], gw2[8];
#pragma unroll
        for (int h = 0; h < 8; ++h) { const int c = h * HD + 2 * flane;
            a[h] = *(const GAS unsigned*)(OFp + (size_t)m * AW + c); bq[h] = *(const GAS unsigned*)(OBp + (size_t)m * AW + c); gw2[h] = *(const GAS unsigned*)(U + (size_t)m * NU + UA_G + c); }
#pragma unroll
        for (int h = 0; h < 8; ++h) { const int c = h * HD + 2 * flane;
            const float o0 = __uint_as_float(a[h] << 16) + __uint_as_float(bq[h] << 16), o1 = __uint_as_float(a[h] & 0xffff0000u) + __uint_as_float(bq[h] & 0xffff0000u);
            const float rstd = 1.f / sqrtf(wave_sum(o0 * o0 + o1 * o1) * (1.f / HD) + RMS_EPS);
            const float g0 = __uint_as_float(gw2[h] << 16), g1 = __uint_as_float(gw2[h] & 0xffff0000u);
            const float y0 = o0 * rstd * nw[c] * (g0 * sigm(g0)), y1 = o1 * rstd * nw[c + 1] * (g1 * sigm(g1));
            *(GAS unsigned*)(Y + (size_t)m * DM + c) = pk2(y0, y1); }
    }
    const bf16* HFp = WSP(bf16, WS_HF); const bf16* HBp = WSP(bf16, WS_HBK);
    const int gtid = blockIdx.x * NTHR + ftid, NT = F.G * NTHR;
    for (int it = gtid; it < M * 128; it += NT) { const int m = it >> 7, c = (it & 127) * 8;
        const v4u av = *(const GAS v4u*)(HFp + (size_t)m * BW + c), bv = *(const GAS v4u*)(HBp + (size_t)m * BW + c);
        const v4u gv = *(const GAS v4u*)(U + (size_t)m * NU + UB_GATE + c); const unsigned gw4[4] = {gv.x, gv.y, gv.z, gv.w}, aw4[4] = {av.x, av.y, av.z, av.w}, bw4[4] = {bv.x, bv.y, bv.z, bv.w};
        float hs[8];
#pragma unroll
        for (int i = 0; i < 4; ++i) { hs[2 * i] = __uint_as_float(aw4[i] << 16) + __uint_as_float(bw4[i] << 16); hs[2 * i + 1] = __uint_as_float(aw4[i] & 0xffff0000u) + __uint_as_float(bw4[i] & 0xffff0000u); }
        unsigned o[4];
#pragma unroll
        for (int i = 0; i < 4; ++i) o[i] = pk2(gelu_tanh(__uint_as_float(gw4[i] << 16)) * hs[2 * i], gelu_tanh(__uint_as_float(gw4[i] & 0xffff0000u)) * hs[2 * i + 1]);
        *(GAS v4u*)(Y + (size_t)m * DM + AW + c) = (v4u){o[0], o[1], o[2], o[3]}; }
}

__device__ __forceinline__ void rg_item(const Args& A, Frame& F, int l, int id) {
    const int tid = fresh_tid(), dir = id & 1, cg = (id >> 1) & 15, b = id >> 5;
    const bf16* G = WSP(bf16, WS_G); const bf16* XC = WSP(bf16, WS_XC); bf16* HO = WSP(bf16, dir ? WS_HBK : WS_HF);
    LAS float* As = (LAS float*)F.lds; LAS float* Bs = As + 128 * 64; LAS float* XP = Bs + 128 * 64; LAS float* XH = XP + 512; LAS float* Cs = XH + 512;
    const int srow = tid >> 3, sc8 = (tid & 7) * 8, cc = cg * 64 + sc8;
    float ba[8], bx[8], sp[8];
#pragma unroll
    for (int i = 0; i < 8; ++i) { ba[i] = A.in[9][(l * 2 + dir) * BW + cc + i]; bx[i] = A.in[11][(l * 2 + dir) * BW + cc + i]; sp[i] = -8.f * log1pf(expf(-A.in[12][(l * 2 + dir) * BW + cc + i])); }
    const int ch = tid & 63, sub = tid >> 6;
    if (tid < 64) Cs[tid] = 0.f;
    v4u gr[2], gi[2], gx[2];
#define RG_LOAD(k) do { _Pragma("unroll") for (int p2 = 0; p2 < 2; ++p2) { const int p_ = 64 * p2 + srow, s_ = 128 * (k) + p_, t_ = dir ? (SEQ - 1 - s_) : s_; const size_t m_ = (size_t)b * SEQ + t_; \
        gr[p2] = *(const GAS v4u*)(G + m_ * 4096 + dir * 2048 + cc); gi[p2] = *(const GAS v4u*)(G + m_ * 4096 + dir * 2048 + 1024 + cc); gx[p2] = *(const GAS v4u*)(XC + m_ * BW + cc); } } while (0)
    RG_LOAD(0);
    for (int k = 0; k < SEQ / 128; ++k) {
#pragma unroll
        for (int p2 = 0; p2 < 2; ++p2) { const unsigned rw[4] = {gr[p2].x, gr[p2].y, gr[p2].z, gr[p2].w}, iw[4] = {gi[p2].x, gi[p2].y, gi[p2].z, gi[p2].w}, xw[4] = {gx[p2].x, gx[p2].y, gx[p2].z, gx[p2].w};
            float av[8], bv[8];
#pragma unroll
            for (int i = 0; i < 8; ++i) { const float rp = (i & 1) ? __uint_as_float(rw[i >> 1] & 0xffff0000u) : __uint_as_float(rw[i >> 1] << 16);
                const float ip = (i & 1) ? __uint_as_float(iw[i >> 1] & 0xffff0000u) : __uint_as_float(iw[i >> 1] << 16);
                const float xv = (i & 1) ? __uint_as_float(xw[i >> 1] & 0xffff0000u) : __uint_as_float(xw[i >> 1] << 16);
                const float la = sp[i] * sigm(rp + ba[i]); av[i] = __expf(la); const float y2 = 2.f * la, om = (y2 > -0.25f) ? -y2 * (1.f + y2 * (0.5f + y2 * (0.16666667f + y2 * (0.041666668f + y2 * (0.008333334f + y2 * 0.0013888889f))))) : 1.f - __expf(y2);
                bv[i] = sqrtf(om) * sigm(ip + bx[i]) * xv; }
            LAS f32x4* ap = (LAS f32x4*)(As + (64 * p2 + srow) * 64 + sc8); LAS f32x4* bp = (LAS f32x4*)(Bs + (64 * p2 + srow) * 64 + sc8);
            ap[0] = (f32x4){av[0], av[1], av[2], av[3]}; ap[1] = (f32x4){av[4], av[5], av[6], av[7]}; bp[0] = (f32x4){bv[0], bv[1], bv[2], bv[3]}; bp[1] = (f32x4){bv[4], bv[5], bv[6], bv[7]}; }
        if (k + 1 < SEQ / 128) RG_LOAD(k + 1);
        __syncthreads();
        float hh = 0.f, pp = 1.f;
#pragma unroll
        for (int j = 0; j < 16; ++j) { const float a = As[(16 * sub + j) * 64 + ch], bt = Bs[(16 * sub + j) * 64 + ch]; hh = a * hh + bt; pp *= a; }
        XP[sub * 64 + ch] = pp; XH[sub * 64 + ch] = hh;
        __syncthreads();
        float cin = Cs[ch];
        for (int s2 = 0; s2 < sub; ++s2) cin = XP[s2 * 64 + ch] * cin + XH[s2 * 64 + ch];
#pragma unroll
        for (int j = 0; j < 16; ++j) { const float a = As[(16 * sub + j) * 64 + ch], bt = Bs[(16 * sub + j) * 64 + ch]; cin = a * cin + bt;
            const int s_ = 128 * k + 16 * sub + j, t_ = dir ? (SEQ - 1 - s_) : s_; HO[((size_t)b * SEQ + t_) * BW + cg * 64 + ch] = (bf16)f2bf(cin); }
        __syncthreads();
        if (sub == 7) Cs[ch] = cin;
    }
#undef RG_LOAD
}

constexpr int Q_HGRN = 128, Q_RG = 256, Q_ATT = BATCH * 16 * (SEQ / 256), Q_ALL = Q_HGRN + Q_RG + Q_ATT;
__device__ __forceinline__ void mixer_phase(const Args& A, Frame& F, int l, char* lds_generic, int rep) {
#ifndef MIX_DIS
#define MIX_DIS 0
#endif
#ifndef MIX_REP_DIS
#define MIX_REP_DIS 0
#endif
    for (;;) {
        __syncthreads();
        if (F.tid == 0) F.MISC[0] = __hip_atomic_fetch_add(F.ctl + CW_QUEUE + 128 * l + 512 * rep, 1u, RLX_AGENT);
        __syncthreads();
        const int id = (int)F.MISC[0];
        if (id >= Q_HGRN + Q_RG) break;
        if (id < Q_HGRN) { if (!(MIX_DIS & 1) && !(rep && (MIX_REP_DIS & 1))) hgrn_item(A, F, l, id); }
        else { if (!(MIX_DIS & 2) && !(rep && (MIX_REP_DIS & 2))) rg_item(A, F, l, id - Q_HGRN); }
    }
    const attn::bf16* U = (const attn::bf16*)WSP(bf16, WS_U); attn::bf16* Y = (attn::bf16*)WSP(bf16, WS_Y);
    constexpr int QB_GROUPS = (CV_NCHUNK + 8) / 9;
    static_assert(QB_GROUPS * 7 >= Q_ATT, "queue B covers every attention unit");
    const int nqb = (l == 0) ? QB_GROUPS * 16 : Q_ATT;
    for (;;) {
        __syncthreads();
        if (F.tid == 0) F.MISC[0] = __hip_atomic_fetch_add(F.ctl + CW_QUEUE + 128 * l + 64 + 512 * rep, 1u, RLX_AGENT);
        __syncthreads();
        const int id = (int)F.MISC[0];
        if (id >= nqb) break;
        int a = id;
        if (l == 0) { const int g = id >> 4, p = id & 15;
            if (p < 9) { const int c = g * 9 + p; if (c < CV_NCHUNK && rep == 0) conv_chunk(A, F, c); continue; }
            a = g * 7 + (p - 9); }
        if (a < Q_ATT && !(MIX_DIS & 4) && !(rep && (MIX_REP_DIS & 4))) { const int qb = a & 7, h = (a >> 3) & 15, b = a >> 7;
            const size_t r0 = (size_t)b * SEQ;
            attn::attn_dense_body<attn::bf16>(U + (r0 + qb * 256) * NU + UC_Q + h * HD, U + r0 * NU + UC_K + (h >> 2) * HD, U + r0 * NU + UC_V + (h >> 2) * HD,
                                              Y + (r0 + qb * 256) * DM + AW + BW + h * HD, SEQ, lds_generic); }
    }
}

__device__ __forceinline__ void act_phase(const Args& A, Frame& F, int l) {
    const int ftid = fresh_tid(), flane = ftid & 63;
    const bf16* GU = WSP(bf16, WS_GU); bf16* ACT = WSP(bf16, WS_ACT);
    const float* cw = A.in[19] + (size_t)l * 3 * FF; const float* cb = A.in[20] + (size_t)l * FF;
    const int gtid = blockIdx.x * NTHR + ftid, NT = F.G * NTHR; constexpr int C8 = FF / 8;
    for (long it = gtid; it < (long)M * C8; it += NT) {
        const int m = (int)(it / C8), c = (int)(it % C8) * 8, t = m & (SEQ - 1);
        float acc[8];
#pragma unroll
        for (int i = 0; i < 8; ++i) acc[i] = cb[c + i];
#pragma unroll
        for (int k = 0; k < 3; ++k) { const int tt = t + k - 1;
            if (tt >= 0 && tt < SEQ) { const v4u xv = *(const GAS v4u*)(GU + (size_t)(m + k - 1) * NG + c); const unsigned xw[4] = {xv.x, xv.y, xv.z, xv.w};
#pragma unroll
                for (int i = 0; i < 4; ++i) { acc[2 * i] += cw[(size_t)k * FF + c + 2 * i] * __uint_as_float(xw[i] << 16); acc[2 * i + 1] += cw[(size_t)k * FF + c + 2 * i + 1] * __uint_as_float(xw[i] & 0xffff0000u); } } }
        const v4u uv = *(const GAS v4u*)(GU + (size_t)m * NG + FF + c); const unsigned uw[4] = {uv.x, uv.y, uv.z, uv.w};
        float o[8];
#pragma unroll
        for (int i = 0; i < 4; ++i) { o[2 * i] = acc[2 * i] * sigm(acc[2 * i]) * __uint_as_float(uw[i] << 16); o[2 * i + 1] = acc[2 * i + 1] * sigm(acc[2 * i + 1]) * __uint_as_float(uw[i] & 0xffff0000u); }
        v4u ov; ov.x = pk2(o[0], o[1]); ov.y = pk2(o[2], o[3]); ov.z = pk2(o[4], o[5]); ov.w = pk2(o[6], o[7]);
        *(GAS v4u*)(ACT + (size_t)m * FF + c) = ov;
    }
}

__global__ void __launch_bounds__(NTHR, 2) fwd_kernel(Args args) {
    extern __shared__ __attribute__((aligned(16))) unsigned char lds[];
    Frame F;
    F.lds = (LAS unsigned char*)lds;
    F.MISC = (volatile LAS unsigned*)(F.lds + MISC_OFF);
    F.tid = threadIdx.x; F.lane = F.tid & 63; F.wave = __builtin_amdgcn_readfirstlane(F.tid >> 6);
    F.G = gridDim.x; F.gw = blockIdx.x * NWAVES + F.wave; F.NGW = F.G * NWAVES;
    F.ws = args.ws; F.ctl = (gu32*)(args.ws + WS_CTL); F.H = args.out;
    for (int u = F.tid; u < (LDS_BYTES - RING_BYTES) / 4; u += NTHR) ((LAS unsigned*)(F.lds + RING_BYTES))[u] = 0u;
    __syncthreads();
    const int lo = args.ph_lo, hi = args.ph_hi;
    XcdBarrier bar; bar.bar = (unsigned*)(F.ctl + CW_BAR); bar.x = 0; bar.st = nullptr;
    if (hi - lo > 1) bar = xcd_barrier_post((unsigned*)(F.ctl + CW_BAR), F.MISC + 8);
#ifndef DIS
#define DIS 0
#endif
#define EN(j) (!((DIS >> (j)) & 1))
#ifndef DBL
#define DBL 0
#endif
#define REPS(j, l) ((((DBL >> (j)) & 1) && (l) == 0) ? 2 : 1)
#define IN(k) (lo <= (k) && (k) < hi)
#define SEAM(k) do { if (IN(k) && IN((k) + 1)) xcd_barrier(bar); } while (0)
    LAS unsigned char* ring = F.lds;

    if (EN(0) && IN(0)) { for (int rep = 0; rep < REPS(0, 0); ++rep) { p0_prologue(args, F); if (rep + 1 < REPS(0, 0)) xcd_barrier(bar); } } SEAM(0);

    for (int l = 0; l < 2; ++l) {
        const int pb = 1 + PH_PER_LAYER * l;
        bf16* HB = WSP(bf16, WS_HB); bf16* U = WSP(bf16, WS_U); bf16* Y = WSP(bf16, WS_Y); bf16* RBUF = WSP(bf16, WS_R);
        if (EN(1) && IN(pb + 0)) for (int rep = 0; rep < REPS(1, l); ++rep) { if (rep) xcd_barrier(bar); pg8::Gemm g{HB, WSP(bf16, WS_WIN + l * SZ_WIN), M, NU, DM}; pg8::StaticOrder S; S.init(M, NU, F.G, (int)blockIdx.x);
            pg8::EpiBf16<0> E{U, NU, nullptr, 0, 0, 1.f};
            pg8::gemm_phase<pg8::EpiBf16<0>, pg8::StaticOrder, true, true>(ring, g, S, E); } SEAM(pb + 0);
        if (EN(2) && IN(pb + 1)) for (int rep = 0; rep < REPS(2, l); ++rep) { if (rep) xcd_barrier(bar); prep_phase(args, F, l, rep); } SEAM(pb + 1);
        if (EN(3) && IN(pb + 2)) for (int rep = 0; rep < REPS(3, l); ++rep) { if (rep) xcd_barrier(bar); pg8::Gemm g{WSP(bf16, WS_XC), WSP(bf16, WS_WRG + l * SZ_WRG), M, 4096, 256, 0, 1024, 4}; pg8::StaticOrder S; S.init(M, 4096, F.G, (int)blockIdx.x);
            pg8::EpiBf16<0> E{WSP(bf16, WS_G), 4096, nullptr, 0, 0, 1.f};
            pg8::gemm_phase<pg8::EpiBf16<0>, pg8::StaticOrder, true, true>(ring, g, S, E); } SEAM(pb + 2);
        if (EN(4) && IN(pb + 3)) for (int rep = 0; rep < REPS(4, l); ++rep) { if (rep) xcd_barrier(bar); mixer_phase(args, F, l, (char*)lds, rep); } SEAM(pb + 3);
        if (EN(5) && IN(pb + 4)) for (int rep = 0; rep < REPS(5, l); ++rep) { if (rep) xcd_barrier(bar); hgrn_final_phase(args, F, l); } SEAM(pb + 4);
        if (EN(6) && IN(pb + 5)) for (int rep = 0; rep < REPS(6, l); ++rep) { if (rep) xcd_barrier(bar); pg8::Gemm g{Y, WSP(bf16, WS_WOUT + l * SZ_WOUT), M, DM, DM}; pg8::StaticOrder S; S.init(M, DM, F.G, (int)blockIdx.x);
            if (l == 0) { pg8::EpiResBf<true> E{args.in[0], WSP(float, WS_ST), args.in[1], args.in[2], RBUF}; pg8::gemm_phase<pg8::EpiResBf<true>, pg8::StaticOrder, true, true>(ring, g, S, E); }
            else { pg8::EpiResBf<false> E{nullptr, WSP(float, WS_ST), args.in[22], args.in[23], RBUF}; pg8::gemm_phase<pg8::EpiResBf<false>, pg8::StaticOrder, true, true>(ring, g, S, E); } } SEAM(pb + 5);
        if (EN(7) && IN(pb + 6)) for (int rep = 0; rep < REPS(7, l); ++rep) { if (rep) xcd_barrier(bar); ln_phase_bf(F, RBUF, args.in[16] + l * DM, args.in[17] + l * DM, nullptr, HB, WSP(float, WS_ST)); } SEAM(pb + 6);
        if (EN(8) && IN(pb + 7)) for (int rep = 0; rep < REPS(8, l); ++rep) { if (rep) xcd_barrier(bar); pg8::Gemm g{HB - DM, WSP(bf16, WS_WUP + l * SZ_WUP), 65 * 256, NG, DM, 254}; pg8::StaticOrder S; S.init(65 * 256, NG, F.G, (int)blockIdx.x);
            pg8::EpiConvGlu E{WSP(bf16, WS_ACT), FF, args.in[19] + (size_t)l * 3 * FF, args.in[20] + (size_t)l * FF, (PG8_LAS float*)(F.lds + RING_BYTES + 1024), SEQ, M};
            pg8::gemm_phase<pg8::EpiConvGlu, pg8::StaticOrder, true, true>(ring, g, S, E); } SEAM(pb + 7);
        if (EN(10) && IN(pb + 9)) for (int rep = 0; rep < REPS(10, l); ++rep) { if (rep) xcd_barrier(bar); pg8::Gemm g{WSP(bf16, WS_ACT), WSP(bf16, WS_WDN + l * SZ_WDN), M, DM, FF}; pg8::StaticOrder S; S.init(M, DM, F.G, (int)blockIdx.x);
            pg8::EpiResBf<false> E{nullptr, WSP(float, WS_ST), args.in[16] + l * DM, args.in[17] + l * DM, RBUF};
            pg8::gemm_phase<pg8::EpiResBf<false>, pg8::StaticOrder, true, true>(ring, g, S, E); } SEAM(pb + 9);
        if (EN(11) && IN(pb + 10)) for (int rep = 0; rep < REPS(11, l); ++rep) { if (rep) xcd_barrier(bar);
            ln_phase_bf(F, RBUF, args.in[22] + l * DM, args.in[23] + l * DM, l == 1 ? F.H : nullptr, l == 1 ? nullptr : HB, l == 1 ? nullptr : WSP(float, WS_ST)); } SEAM(pb + 10);
    }
#undef IN
#undef SEAM
}

extern "C" void kernel_launch(void* const* d_in, const int* in_sizes, int n_in, void* d_out, int out_size, void* d_ws, size_t ws_size, hipStream_t stream) {
    static int grid = 0;
    if (grid == 0) {
        if (n_in != 24 || in_sizes[0] != M * DM || out_size != M * DM || ws_size < WS_END) { fprintf(stderr, "kernel_launch: unexpected shapes: n_in %d in0 %d out %d ws %zu (need %zu)\n", n_in, n_in > 0 ? in_sizes[0] : -1, out_size, ws_size, (size_t)WS_END); grid = -1; return; }
        int dev = 0, cus = 0, per_cu = 0;
        if (hipGetDevice(&dev) != hipSuccess || hipDeviceGetAttribute(&cus, hipDeviceAttributeMultiprocessorCount, dev) != hipSuccess) { grid = -1; return; }
        if (hipFuncSetAttribute((const void*)fwd_kernel, hipFuncAttributeMaxDynamicSharedMemorySize, LDS_BYTES) != hipSuccess) { fprintf(stderr, "kernel_launch: hipFuncSetAttribute failed\n"); grid = -1; return; }
        if (hipOccupancyMaxActiveBlocksPerMultiprocessor(&per_cu, (const void*)fwd_kernel, NTHR, LDS_BYTES) != hipSuccess || per_cu < 1) fprintf(stderr, "kernel_launch: occupancy query reports %d\n", per_cu);
        (void)hipGetLastError();
        grid = cus;
    }
    if (grid < 0) return;
    if (hipMemsetAsync((char*)d_ws + WS_CTL, 0, CTL_ZERO_BYTES, stream) != hipSuccess) return;
    Args a{};
    for (int i = 0; i < 24; ++i) a.in[i] = (const float*)d_in[i];
    a.out = (float*)d_out; a.ws = (unsigned char*)d_ws;
#if MK_SINGLE
    a.ph_lo = 0; a.ph_hi = NPH;
    hipLaunchKernelGGL(fwd_kernel, dim3(grid), dim3(NTHR), LDS_BYTES, stream, a);
#else
    for (int p = 0; p < NPH; ++p) { a.ph_lo = p; a.ph_hi = p + 1; hipLaunchKernelGGL(fwd_kernel, dim3(grid), dim3(NTHR), LDS_BYTES, stream, a); }
#endif
    const hipError_t le = hipPeekAtLastError();
    if (le != hipSuccess) fprintf(stderr, "kernel_launch: launch failed: %s\n", hipGetErrorName(le));
}
```

```cpp
#include <hip/hip_runtime.h>
#include <hip/hip_bf16.h>
#include <cstdio>
#include <cstdint>
#define MK_SINGLE 1
namespace pg8 {
#define PG8_LAS __attribute__((address_space(3)))
typedef unsigned short bf16_t;
typedef short bf16x8 __attribute__((ext_vector_type(8)));
typedef float f32x4 __attribute__((ext_vector_type(4)));
typedef unsigned u32x4 __attribute__((ext_vector_type(4)));
constexpr int BM = 256, BK = 64, HALF = 128, HTB = HALF * BK * 2  , STAGE_BYTES = 8 * HTB, NXCD = 8, WGM = 8;

__host__ __device__ __forceinline__ int lds_byte(int r, int c) { const int st = (r >> 4) * 2 + (c >> 5), rr = r & 15, cc = c & 31, ob = rr * 64 + cc * 2; return st * 1024 + (ob ^ (((ob >> 9) & 1) << 5)); }
__host__ __device__ __forceinline__ void stage_rc(int b, int& R, int& C) { const int st = b / 1024, sb = b % 1024, swz = sb ^ (((sb >> 9) & 1) << 5); R = (st >> 1) * 16 + swz / 64; C = (st & 1) * 32 + (swz % 64) / 2; }
__host__ __device__ __forceinline__ int perm32(int rho) { const int n = rho >> 4, i = rho & 15; return 8 * (i >> 2) + 4 * n + (i & 3); }

struct Unit { int pm, pn; };
struct Gemm { const bf16_t* A; const bf16_t* Bt; int M, N, K; int a_rstep, lda, kwin; };

struct StaticOrder {
    int nM, nN, nwg, G, c;
    __host__ __device__ void init(int M, int N, int G_, int c_) { nM = M / BM; nN = N / BM; nwg = nM * nN; G = G_; c = c_; }
    __host__ __device__ bool next(int i, Unit& u) const {
        const long L = (long)i * G + c; if (L >= nwg) return false;
        int wgid = (int)L; { const int q = nwg / NXCD, r = nwg % NXCD, xcd = wgid % NXCD, off = wgid / NXCD; wgid = (xcd < r ? xcd * (q + 1) : r * (q + 1) + (xcd - r) * q) + off; }
        const int nig = WGM * nN, gid = wgid / nig, fm = gid * WGM, gsz = (nM - fm) < WGM ? (nM - fm) : WGM;
        u.pm = fm + ((wgid % nig) % gsz); u.pn = (wgid % nig) / gsz; return true;
    }
    __device__ __forceinline__ void a_ready(const Unit&) const {}
    __device__ __forceinline__ void done(const Unit&) const {}
};

__device__ __forceinline__ unsigned cvt_pk_bf16(float lo, float hi) { unsigned r; asm volatile("v_cvt_pk_bf16_f32 %0, %1, %2" : "=v"(r) : "v"(lo), "v"(hi)); return r; }
typedef float f32x2 __attribute__((ext_vector_type(2)));
__device__ __forceinline__ f32x2 gelu_pk(f32x2 v) {
    const f32x2 av = __builtin_elementwise_abs(v), d = av * 0.2316418882f + 1.0f;
    f32x2 t; t.x = __builtin_amdgcn_rcpf(d.x); t.y = __builtin_amdgcn_rcpf(d.y);
    f32x2 q = t * 0.5307027145f + (-0.7265760135f); q = q * t + 0.7107068705f; q = q * t + (-0.142248368f); q = q * t + 0.127414796f; q = q * t;
    const f32x2 s = (v * v) * (-0.72134752044f);
    f32x2 e; e.x = __builtin_amdgcn_exp2f(s.x); e.y = __builtin_amdgcn_exp2f(s.y);
    const f32x2 m = v * (q * e), r = v - m;
    f32x2 o; o.x = v.x < 0.f ? m.x : r.x; o.y = v.y < 0.f ? m.y : r.y; return o;
}

template <int ACT  > struct EpiBf16 {
    static constexpr bool PERM = true, AFTER_DRAIN = false; static_assert(ACT == 0 || ACT == 1, "EpiBf16: ACT is 0 (none) or 1 (gelu_pk)");
    bf16_t* O; int ldc; const float* bias; int split_cols; size_t split_stride; float scale0;
    __device__ __forceinline__ void operator()(const f32x4 (&acc)[2][2][4][2], const Unit& u, int wr, int wc, int fr, int fq) const {
        const int row0 = u.pm * BM + wr * 64 + fr; int colt = u.pn * BM; bf16_t* base = O;
        float sc = 1.f; if (split_cols) { const int t = colt / split_cols; base += (size_t)t * split_stride; colt -= t * split_cols; if (t == 0) sc = scale0; }
        const int col0 = colt + wc * 32 + 8 * fq, bcol0 = u.pn * BM + wc * 32 + 8 * fq;
        f32x4 bv[2][2];
#pragma unroll
        for (int bj = 0; bj < 2; ++bj)
#pragma unroll
            for (int n = 0; n < 2; ++n) bv[bj][n] = bias ? *(const f32x4*)(bias + bcol0 + bj * HALF + 4 * n) : (f32x4){0.f, 0.f, 0.f, 0.f};
#pragma unroll
        for (int ai = 0; ai < 2; ++ai)
#pragma unroll
            for (int m = 0; m < 4; ++m) { bf16_t* rowp = base + (size_t)(row0 + ai * HALF + m * 16) * ldc + col0;
#pragma unroll
                for (int bj = 0; bj < 2; ++bj) { f32x4 v0 = acc[ai][bj][m][0] + bv[bj][0], v1 = acc[ai][bj][m][1] + bv[bj][1];
                    if (ACT == 1) { f32x2 a = gelu_pk((f32x2){v0[0], v0[1]}), b = gelu_pk((f32x2){v0[2], v0[3]}), c = gelu_pk((f32x2){v1[0], v1[1]}), d = gelu_pk((f32x2){v1[2], v1[3]});
                        v0 = (f32x4){a.x, a.y, b.x, b.y}; v1 = (f32x4){c.x, c.y, d.x, d.y}; }
                    v0 = v0 * sc; v1 = v1 * sc; u32x4 w; w.x = cvt_pk_bf16(v0[0], v0[1]); w.y = cvt_pk_bf16(v0[2], v0[3]); w.z = cvt_pk_bf16(v1[0], v1[1]); w.w = cvt_pk_bf16(v1[2], v1[3]);
                    *(u32x4*)(rowp + bj * HALF) = w; } }
    }
};
struct EpiResF32 {
    static constexpr bool PERM = false, AFTER_DRAIN = false;
    const float* base; float* C; int ldc; float alpha;
    __device__ __forceinline__ void operator()(const f32x4 (&acc)[2][2][4][2], const Unit& u, int wr, int wc, int fr, int fq) const {
        const int row0 = u.pm * BM + wr * 64 + fr, col0 = u.pn * BM + wc * 32 + 4 * fq;
#pragma unroll
        for (int ai = 0; ai < 2; ++ai)
#pragma unroll
            for (int m = 0; m < 4; ++m) { const size_t off = (size_t)(row0 + ai * HALF + m * 16) * ldc + col0;
#pragma unroll
                for (int bj = 0; bj < 2; ++bj)
#pragma unroll
                    for (int n = 0; n < 2; ++n) { const f32x4 bs = *(const f32x4*)(base + off + bj * HALF + n * 16);
                        *(f32x4*)(C + off + bj * HALF + n * 16) = acc[ai][bj][m][n] + alpha * bs; } }
    }
};
struct EpiConvGlu {
    static constexpr bool PERM = true, AFTER_DRAIN = false;
    bf16_t* ACT; int ldo; const float* cw; const float* cb; PG8_LAS float* xch; int seq, mtok;
    __device__ __forceinline__ void operator()(const f32x4 (&acc)[2][2][4][2], const Unit& u, int wr, int wc, int fr, int fq) const {
        const int lane = fq * 16 + fr, cl = wc * 32 + 8 * fq;
#pragma unroll
        for (int ai = 0; ai < 2; ++ai)
#pragma unroll
            for (int n = 0; n < 2; ++n) {
                if (fr == 0)  *(PG8_LAS f32x4*)(xch + ((ai * 2 + wr) * 2 + 0) * 128 + cl + 4 * n) = acc[ai][0][0][n];
                if (fr == 15) *(PG8_LAS f32x4*)(xch + ((ai * 2 + wr) * 2 + 1) * 128 + cl + 4 * n) = acc[ai][0][3][n]; }
        asm volatile("s_waitcnt lgkmcnt(0)" ::: "memory"); __builtin_amdgcn_s_barrier(); asm volatile("" ::: "memory");
        const int ch0 = u.pn * 128 + cl;
        f32x4 w0[2], w1[2], w2[2], bb[2];
#pragma unroll
        for (int n = 0; n < 2; ++n) { w0[n] = *(const f32x4*)(cw + ch0 + 4 * n); w1[n] = *(const f32x4*)(cw + ldo + ch0 + 4 * n); w2[n] = *(const f32x4*)(cw + 2 * ldo + ch0 + 4 * n); bb[n] = *(const f32x4*)(cb + ch0 + 4 * n); }
        const int srcU = fr > 0 ? lane - 1 : lane + 15, srcD = fr < 15 ? lane + 1 : lane - 15;
#pragma unroll
        for (int ai = 0; ai < 2; ++ai)
#pragma unroll
            for (int m = 0; m < 4; ++m) {
                const int r = ai * HALF + wr * 64 + m * 16 + fr, tok = 254 * u.pm - 1 + r, t = tok & (seq - 1);
                unsigned ow[4];
#pragma unroll
                for (int n = 0; n < 2; ++n) {
                    const f32x4 g = acc[ai][0][m][n], gm = acc[ai][0][m > 0 ? m - 1 : 0][n], gp = acc[ai][0][m < 3 ? m + 1 : 3][n];
                    const f32x4 sU = (fr == 15) ? gm : g, sD = (fr == 0) ? gp : g;
                    f32x4 up, dn;
#pragma unroll
                    for (int j = 0; j < 4; ++j) { up[j] = __shfl(sU[j], srcU, 64); dn[j] = __shfl(sD[j], srcD, 64); }
                    if (m == 0) { const int pa = wr ? ai : ai - 1, pw = wr ^ 1;
                        if (pa >= 0) { const f32x4 e = *(const PG8_LAS f32x4*)(xch + ((pa * 2 + pw) * 2 + 1) * 128 + cl + 4 * n); if (fr == 0) up = e; } }
                    if (m == 3) { const int pa = wr ? ai + 1 : ai, pw = wr ^ 1;
                        if (pa <= 1) { const f32x4 e = *(const PG8_LAS f32x4*)(xch + ((pa * 2 + pw) * 2 + 0) * 128 + cl + 4 * n); if (fr == 15) dn = e; } }
                    if (t == 0) up = (f32x4){0.f, 0.f, 0.f, 0.f};
                    if (t == seq - 1) dn = (f32x4){0.f, 0.f, 0.f, 0.f};
                    const f32x4 cv = bb[n] + w0[n] * up + w1[n] * g + w2[n] * dn, uu = acc[ai][1][m][n];
                    float o[4];
#pragma unroll
                    for (int j = 0; j < 4; ++j) o[j] = cv[j] * __builtin_amdgcn_rcpf(1.f + __expf(-cv[j])) * uu[j];
                    ow[2 * n] = cvt_pk_bf16(o[0], o[1]); ow[2 * n + 1] = cvt_pk_bf16(o[2], o[3]); }
                if (r >= 1 && r <= 254 && tok < mtok) *(u32x4*)(ACT + (size_t)tok * ldo + ch0) = (u32x4){ow[0], ow[1], ow[2], ow[3]};
            }
    }
};
struct EpiResLazy {
    static constexpr bool PERM = false, AFTER_DRAIN = false;
    const float* Rp; const float* st; const float* w; const float* b; float* C; int ldc; float alpha;
    __device__ __forceinline__ void operator()(const f32x4 (&acc)[2][2][4][2], const Unit& u, int wr, int wc, int fr, int fq) const {
        typedef float f32x2v __attribute__((ext_vector_type(2)));
        const int row0 = u.pm * BM + wr * 64 + fr, col0 = u.pn * BM + wc * 32 + 4 * fq;
        f32x4 wv[2][2], bv[2][2];
#pragma unroll
        for (int bj = 0; bj < 2; ++bj)
#pragma unroll
            for (int n = 0; n < 2; ++n) { wv[bj][n] = *(const f32x4*)(w + col0 + bj * HALF + n * 16) * alpha; bv[bj][n] = *(const f32x4*)(b + col0 + bj * HALF + n * 16) * alpha; }
#pragma unroll
        for (int ai = 0; ai < 2; ++ai)
#pragma unroll
            for (int m = 0; m < 4; ++m) { const int row = row0 + ai * HALF + m * 16; const size_t off = (size_t)row * ldc + col0; const f32x2v s = *(const f32x2v*)(st + 2 * row);
#pragma unroll
                for (int bj = 0; bj < 2; ++bj)
#pragma unroll
                    for (int n = 0; n < 2; ++n) { const f32x4 rp = *(const f32x4*)(Rp + off + bj * HALF + n * 16);
                        *(f32x4*)(C + off + bj * HALF + n * 16) = acc[ai][bj][m][n] + ((rp - s.x) * s.y) * wv[bj][n] + bv[bj][n]; } }
    }
};

template <bool RPF32> struct EpiResBf {
    static constexpr bool PERM = true, AFTER_DRAIN = false;
    static constexpr int ldc = 4096; static constexpr float alpha = 1.41421356237309515f;
    const float* RpF; const float* st; const float* w; const float* b; bf16_t* RB;
    __device__ __forceinline__ void operator()(const f32x4 (&acc)[2][2][4][2], const Unit& u, int wr, int wc, int fr, int fq) const {
        typedef float f32x2v __attribute__((ext_vector_type(2)));
        const int row0 = u.pm * BM + wr * 64 + fr, col0 = u.pn * BM + wc * 32 + 8 * fq;
        f32x4 wv[2][2], bv[2][2];
#pragma unroll
        for (int bj = 0; bj < 2; ++bj)
#pragma unroll
            for (int n = 0; n < 2; ++n) { wv[bj][n] = *(const f32x4*)(w + col0 + bj * HALF + 4 * n) * alpha; bv[bj][n] = *(const f32x4*)(b + col0 + bj * HALF + 4 * n) * alpha; }
#pragma unroll
        for (int ai = 0; ai < 2; ++ai)
#pragma unroll
            for (int m = 0; m < 4; ++m) { const int row = row0 + ai * HALF + m * 16; const size_t off = (size_t)row * ldc + col0; const f32x2v s = *(const f32x2v*)(st + 2 * row);
#pragma unroll
                for (int bj = 0; bj < 2; ++bj) { f32x4 r0, r1;
                    if constexpr (RPF32) { r0 = *(const f32x4*)(RpF + off + bj * HALF); r1 = *(const f32x4*)(RpF + off + bj * HALF + 4); }
                    else { const u32x4 pw = *(const u32x4*)(RB + off + bj * HALF);
                        r0 = (f32x4){__uint_as_float(pw.x << 16), __uint_as_float(pw.x & 0xffff0000u), __uint_as_float(pw.y << 16), __uint_as_float(pw.y & 0xffff0000u)};
                        r1 = (f32x4){__uint_as_float(pw.z << 16), __uint_as_float(pw.z & 0xffff0000u), __uint_as_float(pw.w << 16), __uint_as_float(pw.w & 0xffff0000u)}; }
                    const f32x4 v0 = acc[ai][bj][m][0] + ((r0 - s.x) * s.y) * wv[bj][0] + bv[bj][0], v1 = acc[ai][bj][m][1] + ((r1 - s.x) * s.y) * wv[bj][1] + bv[bj][1];
                    u32x4 wd; wd.x = cvt_pk_bf16(v0[0], v0[1]); wd.y = cvt_pk_bf16(v0[2], v0[3]); wd.z = cvt_pk_bf16(v1[0], v1[1]); wd.w = cvt_pk_bf16(v1[2], v1[3]);
                    *(u32x4*)(RB + off + bj * HALF) = wd; } }
    }
};
template <class Epi, class Sched, bool ALIGN_EPI = false, bool SP2 = false>
__device__ __forceinline__ void gemm_phase(PG8_LAS unsigned char* lds, const Gemm g, const Sched& S, const Epi& E) {
    int tid_ = threadIdx.x; asm volatile("" : "+v"(tid_));
    const int tid = tid_, wid = __builtin_amdgcn_readfirstlane(tid >> 6), lane = tid & 63, wr = wid >> 2, wc = wid & 3, fr = lane & 15, fq = lane >> 4;
    const int K = g.K, nt = K / BK, lda = g.lda ? g.lda : g.K;
    unsigned voffA[2], voffB[2];
#pragma unroll
    for (int i = 0; i < 2; ++i) { int R, C; stage_rc(tid * 16 + i * 8192, R, C); const int Rb = Epi::PERM ? ((R & ~31) + perm32(R & 31)) : R;
        voffA[i] = (unsigned)(R * lda + C) * 2u; voffB[i] = (unsigned)(Rb * K + C) * 2u; }
    const size_t kstep = (size_t)(BK * 2);
    const size_t hstep = (size_t)HALF * K * 2;
    const size_t hstepA = (size_t)HALF * lda * 2;
    const size_t tstep = 2 * hstep;
    const size_t tstepA = (size_t)(g.a_rstep ? g.a_rstep : BM) * lda * 2;
    const unsigned ldsw = (unsigned)wid * 1024u;
    const int aoff = lds_byte(wr * 64 + fr, fq * 8), boff = lds_byte(wc * 32 + fr, fq * 8);
#define PG8_SA(b, h) (((b) * 2 + (h)) * HTB)
#define PG8_SB(b, h) ((4 + (b) * 2 + (h)) * HTB)
#define PG8_STAGE(bufoff, gbase, voff) do { _Pragma("unroll") for (int _i = 0; _i < 2; ++_i) \
        __builtin_amdgcn_global_load_lds((const unsigned*)((const char*)(gbase) + (voff)[_i]), (PG8_LAS unsigned*)(lds + (bufoff) + ldsw + _i * 8192), 16, 0, 0); } while (0)
#define PG8_LDA(dst, b, h) do { _Pragma("unroll") for (int m = 0; m < 4; ++m) _Pragma("unroll") for (int k = 0; k < 2; ++k) dst[m][k] = *(const PG8_LAS bf16x8*)(lds + PG8_SA(b, h) + aoff + m * 2048 + k * 1024); } while (0)
#define PG8_LDB(dst, b, h) do { _Pragma("unroll") for (int n = 0; n < 2; ++n) _Pragma("unroll") for (int k = 0; k < 2; ++k) dst[n][k] = *(const PG8_LAS bf16x8*)(lds + PG8_SB(b, h) + boff + n * 2048 + k * 1024); } while (0)
#define PG8_MMA(ai, bj, At, Bt) do { __builtin_amdgcn_s_setprio(1); _Pragma("unroll") for (int m = 0; m < 4; ++m) _Pragma("unroll") for (int n = 0; n < 2; ++n) _Pragma("unroll") for (int k = 0; k < 2; ++k) \
        acc[ai][bj][m][n] = __builtin_amdgcn_mfma_f32_16x16x32_bf16(Bt[n][k], At[m][k], acc[ai][bj][m][n], 0, 0, 0); __builtin_amdgcn_s_setprio(0); } while (0)
#define PG8_WAIT_V(n) asm volatile("s_waitcnt vmcnt(" #n ")" ::: "memory")
#define PG8_WAIT_L(n) asm volatile("s_waitcnt lgkmcnt(" #n ")" ::: "memory")
#define PG8_BAR __builtin_amdgcn_s_barrier()
#define PG8_SCHED __builtin_amdgcn_sched_barrier(0)
    Unit cur, nxt; int ui = 0;
    if (!S.next(0, cur)) return;
    f32x4 acc[2][2][4][2];
#pragma unroll
    for (int a = 0; a < 2; ++a)
#pragma unroll
        for (int b = 0; b < 2; ++b)
#pragma unroll
            for (int m = 0; m < 4; ++m)
#pragma unroll
                for (int n = 0; n < 2; ++n) acc[a][b][m][n] = (f32x4){0.f, 0.f, 0.f, 0.f};
    bf16x8 At[4][2], B0[2][2], B1[2][2];
    const char* cA = (const char*)g.A + (size_t)cur.pm * tstepA + (g.kwin ? (size_t)(cur.pn % g.kwin) * K * 2 : 0); const char* cB = (const char*)g.Bt + (size_t)cur.pn * tstep;
    S.a_ready(cur);
    if constexpr (SP2) {
        PG8_STAGE(PG8_SB(0, 0), cB, voffB); PG8_STAGE(PG8_SB(0, 1), cB + hstep, voffB); PG8_STAGE(PG8_SA(0, 0), cA, voffA); PG8_STAGE(PG8_SA(0, 1), cA + hstepA, voffA);
        if (wr == 1) PG8_BAR;
        PG8_WAIT_V(2); PG8_BAR;
        PG8_STAGE(PG8_SB(1, 0), cB + kstep, voffB); PG8_STAGE(PG8_SA(1, 0), cA + kstep, voffA); PG8_STAGE(PG8_SB(1, 1), cB + hstep + kstep, voffB);
        PG8_WAIT_V(6); PG8_BAR;
    } else {
        PG8_STAGE(PG8_SB(0, 0), cB, voffB); PG8_STAGE(PG8_SA(0, 0), cA, voffA); PG8_STAGE(PG8_SB(0, 1), cB + hstep, voffB); PG8_STAGE(PG8_SA(0, 1), cA + hstepA, voffA);
        if (wr == 1) PG8_BAR;
        PG8_WAIT_V(4); PG8_BAR;
        PG8_STAGE(PG8_SB(1, 0), cB + kstep, voffB); PG8_STAGE(PG8_SA(1, 0), cA + kstep, voffA); PG8_STAGE(PG8_SB(1, 1), cB + hstep + kstep, voffB);
        PG8_WAIT_V(6); PG8_BAR;
    }
    for (;;) {
        const bool has_next = S.next(ui + 1, nxt);
        const char* nA = has_next ? (const char*)g.A + (size_t)nxt.pm * tstepA + (g.kwin ? (size_t)(nxt.pn % g.kwin) * K * 2 : 0) : cA; const char* nB = has_next ? (const char*)g.Bt + (size_t)nxt.pn * tstep : cB;
        for (int t = 0; t < nt; t += 2) {
            const bool last = (t == nt - 2);
            const char* a1 = cA + (size_t)(t + 1) * kstep;
            const char* a2 = last ? nA : cA + (size_t)(t + 2) * kstep; const char* b2 = last ? nB : cB + (size_t)(t + 2) * kstep;
            const char* a3 = a2 + kstep; const char* b3 = b2 + kstep;
            if (last && has_next) S.a_ready(nxt);
            if constexpr (SP2) {
            PG8_LDB(B0, 0, 0); PG8_LDB(B1, 0, 1); PG8_SCHED; PG8_LDA(At, 0, 0); PG8_STAGE(PG8_SA(1, 1), a1 + hstepA, voffA);
            PG8_WAIT_V(8); PG8_WAIT_L(0); PG8_BAR; PG8_MMA(0, 0, At, B0); PG8_MMA(0, 1, At, B1); PG8_BAR; PG8_SCHED;
            PG8_LDA(At, 0, 1); PG8_STAGE(PG8_SB(0, 0), b2, voffB); PG8_STAGE(PG8_SB(0, 1), b2 + hstep, voffB); PG8_STAGE(PG8_SA(0, 0), a2, voffA);
            PG8_WAIT_V(8); PG8_WAIT_L(0); PG8_BAR; PG8_MMA(1, 0, At, B0); PG8_MMA(1, 1, At, B1); PG8_BAR; PG8_SCHED;
            PG8_LDB(B0, 1, 0); PG8_LDB(B1, 1, 1); PG8_SCHED; PG8_LDA(At, 1, 0); PG8_STAGE(PG8_SA(0, 1), a2 + hstepA, voffA);
            PG8_WAIT_V(8); PG8_WAIT_L(0); PG8_BAR; PG8_MMA(0, 0, At, B0); PG8_MMA(0, 1, At, B1); PG8_BAR; PG8_SCHED;
            PG8_LDA(At, 1, 1); PG8_STAGE(PG8_SB(1, 0), b3, voffB); PG8_STAGE(PG8_SB(1, 1), b3 + hstep, voffB); PG8_STAGE(PG8_SA(1, 0), a3, voffA);
            PG8_WAIT_V(8); PG8_WAIT_L(0); PG8_BAR; PG8_MMA(1, 0, At, B0); PG8_MMA(1, 1, At, B1); PG8_BAR; PG8_SCHED;
            } else {
            PG8_LDB(B0, 0, 0); PG8_SCHED; PG8_LDA(At, 0, 0); PG8_STAGE(PG8_SA(1, 1), a1 + hstepA, voffA);
            PG8_WAIT_L(8); PG8_BAR; PG8_WAIT_L(0); PG8_MMA(0, 0, At, B0); PG8_BAR; PG8_SCHED;
            PG8_LDB(B1, 0, 1); PG8_STAGE(PG8_SB(0, 0), b2, voffB);
            PG8_BAR; PG8_WAIT_L(0); PG8_MMA(0, 1, At, B1); PG8_BAR;
            PG8_LDA(At, 0, 1); PG8_STAGE(PG8_SA(0, 0), a2, voffA);
            PG8_BAR; PG8_WAIT_L(0); PG8_MMA(1, 0, At, B0); PG8_BAR; PG8_SCHED;
            PG8_STAGE(PG8_SB(0, 1), b2 + hstep, voffB);
            PG8_WAIT_V(6); PG8_BAR; PG8_MMA(1, 1, At, B1); PG8_BAR;
            PG8_LDB(B0, 1, 0); PG8_SCHED; PG8_LDA(At, 1, 0); PG8_STAGE(PG8_SA(0, 1), a2 + hstepA, voffA);
            PG8_WAIT_L(8); PG8_BAR; PG8_WAIT_L(0); PG8_MMA(0, 0, At, B0); PG8_BAR; PG8_SCHED;
            PG8_LDB(B1, 1, 1); PG8_STAGE(PG8_SB(1, 0), b3, voffB);
            PG8_BAR; PG8_WAIT_L(0); PG8_MMA(0, 1, At, B1); PG8_BAR;
            PG8_LDA(At, 1, 1); PG8_STAGE(PG8_SA(1, 0), a3, voffA);
            PG8_BAR; PG8_WAIT_L(0); PG8_MMA(1, 0, At, B0); PG8_BAR; PG8_SCHED;
            PG8_STAGE(PG8_SB(1, 1), b3 + hstep, voffB);
            PG8_WAIT_V(6); PG8_BAR; PG8_MMA(1, 1, At, B1); PG8_BAR;
            }
        }
        if constexpr (ALIGN_EPI) { if (wr == 0) PG8_BAR; }
        if constexpr (!Epi::AFTER_DRAIN) { E(acc, cur, wr, wc, fr, fq); S.done(cur); }
        if (!has_next) break;
#pragma unroll
        for (int a = 0; a < 2; ++a)
#pragma unroll
            for (int b = 0; b < 2; ++b)
#pragma unroll
                for (int m = 0; m < 4; ++m)
#pragma unroll
                    for (int n = 0; n < 2; ++n) acc[a][b][m][n] = (f32x4){0.f, 0.f, 0.f, 0.f};
        cur = nxt; cA = nA; cB = nB; ++ui;
        if constexpr (ALIGN_EPI) { if (wr == 1) PG8_BAR; }
    }
    PG8_WAIT_V(0);
    if constexpr (!ALIGN_EPI) { if (wr == 0) PG8_BAR; }
    PG8_BAR;
    if constexpr (Epi::AFTER_DRAIN) { E.fused(acc, cur, wr, wc, fr, fq, lds, wid, lane); S.done(cur); }
#undef PG8_SA
#undef PG8_SB
#undef PG8_STAGE
#undef PG8_LDA
#undef PG8_LDB
#undef PG8_MMA
#undef PG8_WAIT_V
#undef PG8_WAIT_L
#undef PG8_BAR
#undef PG8_SCHED
}
}
namespace attn {
using bf16 = __hip_bfloat16;
constexpr int   D = 128, NW = 8, QBLK = 32, KVBLK = 64;
constexpr float SCALE = 0.088388347648318440f;
constexpr float THR = 8.f;
constexpr int SDEPTH = 2;
constexpr int LDQ = 10240, LDK = 10240, LDO = 4096;
constexpr size_t SHM_V = KVBLK * D * 2, SHM_K = KVBLK * D * 2, SHM_ATTN = 2 * SHM_V + 2 * SHM_K + NW * 64 * 4;
using bf16x8 = __attribute__((ext_vector_type(8))) short;
using s16x4  = __attribute__((ext_vector_type(4))) short;
using f32x16 = __attribute__((ext_vector_type(16))) float;
using f32x8  = __attribute__((ext_vector_type(8))) float;
using u32x4  = __attribute__((ext_vector_type(4))) unsigned;
#define KSWZ(row, colB) ((row) * 256 + ((colB) ^ (((row) & 7) << 4)))
#define SBAR() __builtin_amdgcn_sched_barrier(0)
__device__ __forceinline__ int crow(int r, int hi) { return (r & 3) + 8 * (r >> 2) + 4 * hi; }
__device__ __forceinline__ unsigned cvtpk(float lo, float hi) {
  unsigned r; asm volatile("v_cvt_pk_bf16_f32 %0, %1, %2" : "=v"(r) : "v"(lo), "v"(hi)); return r;
}
template <typename TIn> struct Stage;
template <> struct Stage<bf16>  { using T = bf16x8;
  __device__ static __forceinline__ T ld8(const bf16* p) { return *reinterpret_cast<const bf16x8*>(p); }
  __device__ static __forceinline__ bf16x8 tobf(T x) { return x; } };
template <> struct Stage<float> { using T = f32x8;
  __device__ static __forceinline__ T ld8(const float* p) { return *reinterpret_cast<const f32x8*>(p); }
  __device__ static __forceinline__ bf16x8 tobf(T x) {
    u32x4 w = {cvtpk(x[0], x[1]), cvtpk(x[2], x[3]), cvtpk(x[4], x[5]), cvtpk(x[6], x[7])}; return *reinterpret_cast<bf16x8*>(&w); } };

__device__ __forceinline__ void partialSM(f32x16& p0, f32x16& p1, float& m_reg, float& mn, float& alpha) {
  constexpr float C = SCALE * 1.4426950408889634f;
  float pmax = p0[0]; for (int r = 1; r < 16; ++r) pmax = fmaxf(pmax, p0[r]); for (int r = 0; r < 16; ++r) pmax = fmaxf(pmax, p1[r]);
  { auto rr = __builtin_amdgcn_permlane32_swap(__float_as_uint(pmax), __float_as_uint(pmax), false, false);
    pmax = fmaxf(__uint_as_float(rr[0]), __uint_as_float(rr[1])); }
  if (__builtin_expect(__all(pmax - m_reg <= THR / SCALE), 1)) { mn = m_reg; alpha = 1.f; }
  else { mn = fmaxf(m_reg, pmax); alpha = __builtin_amdgcn_exp2f((m_reg - mn) * C); m_reg = mn; }
  float mnC = -mn * C;
  for (int r = 0; r < 16; ++r) p0[r] = fmaf(p0[r], C, mnC); for (int r = 0; r < 16; ++r) p1[r] = fmaf(p1[r], C, mnC);
  for (int r = 0; r < 16; ++r) p0[r] = __builtin_amdgcn_exp2f(p0[r]);
}
__device__ __forceinline__ void finishSM(f32x16& p0, f32x16& p1, float alpha, float& l_reg, bf16x8& pa0, bf16x8& pa1, bf16x8& pa2, bf16x8& pa3) {
  for (int r = 0; r < 16; ++r) p1[r] = __builtin_amdgcn_exp2f(p1[r]);
  float ps = 0; for (int r = 0; r < 16; ++r) ps += p0[r]; for (int r = 0; r < 16; ++r) ps += p1[r];
  { auto rr = __builtin_amdgcn_permlane32_swap(__float_as_uint(ps), __float_as_uint(ps), false, false);
    ps = __uint_as_float(rr[0]) + __uint_as_float(rr[1]); }
  l_reg = l_reg * alpha + ps;
#define PK4(P, BASE, OUT) do { unsigned a0 = cvtpk(P[BASE + 0], P[BASE + 1]), a1 = cvtpk(P[BASE + 2], P[BASE + 3]);   \
    unsigned b0 = cvtpk(P[BASE + 4], P[BASE + 5]), b1 = cvtpk(P[BASE + 6], P[BASE + 7]);                              \
    auto r0 = __builtin_amdgcn_permlane32_swap(a0, b0, false, false); auto r1 = __builtin_amdgcn_permlane32_swap(a1, b1, false, false); \
    u32x4 w = {r0[0], r1[0], r0[1], r1[1]}; OUT = *reinterpret_cast<bf16x8*>(&w); } while (0)
  PK4(p0, 0, pa0); PK4(p0, 8, pa1); PK4(p1, 0, pa2); PK4(p1, 8, pa3);
#undef PK4
}
__device__ __forceinline__ void qkt(f32x16& p0, f32x16& p1, const bf16* Ks, const bf16x8* qr, int r32, int hi) {
  p0 = f32x16{}; p1 = f32x16{};
  for (int d0 = 0; d0 < 8; ++d0) { int cb = (d0 * 16 + hi * 8) * 2;
    bf16x8 b0 = *reinterpret_cast<const bf16x8*>((const char*)Ks + KSWZ(r32, cb));
    bf16x8 b1 = *reinterpret_cast<const bf16x8*>((const char*)Ks + KSWZ(32 + r32, cb));
    p0 = __builtin_amdgcn_mfma_f32_32x32x16_bf16(b0, qr[d0], p0, 0, 0, 0);
    p1 = __builtin_amdgcn_mfma_f32_32x32x16_bf16(b1, qr[d0], p1, 0, 0, 0); }
}
__device__ __forceinline__ int v_st(int k, int c) { const int kk = (k & ~0xC) | ((k & 4) << 1) | ((k & 8) >> 1); return ((kk >> 3) * 4 + (c >> 5)) * 512 + ((kk & 7) * 32 + (c & 31)) * 2; }
__device__ __forceinline__ int v_rd_base(int lane) { return ((lane & 3) << 3) | (((lane >> 2) & 3) << 6) | (((lane >> 4) & 1) << 5) | (((lane >> 5) & 1) << 8); }
constexpr int v_rd_off(int d0, int ks, int half) { return d0 * 512 + ks * 4096 + half * 2048; }
template <int OFF> __device__ __forceinline__ s16x4 tr_read(int vb) {
  s16x4 r; asm volatile("ds_read_b64_tr_b16 %0, %1 offset:%2" : "=&v"(r) : "v"(vb), "i"(OFF) : "memory"); return r;
}
template <int D0> __device__ __forceinline__ void pv_one(f32x16& od, int vb, bf16x8 pa0, bf16x8 pa1, bf16x8 pa2, bf16x8 pa3) {
  const s16x4 l0 = tr_read<v_rd_off(D0, 0, 0)>(vb), h0 = tr_read<v_rd_off(D0, 0, 1)>(vb), l1 = tr_read<v_rd_off(D0, 1, 0)>(vb), h1 = tr_read<v_rd_off(D0, 1, 1)>(vb);
  const s16x4 l2 = tr_read<v_rd_off(D0, 2, 0)>(vb), h2 = tr_read<v_rd_off(D0, 2, 1)>(vb), l3 = tr_read<v_rd_off(D0, 3, 0)>(vb), h3 = tr_read<v_rd_off(D0, 3, 1)>(vb);
  asm volatile("s_waitcnt lgkmcnt(0)" ::: "memory"); SBAR();
#define PK(L, H) (bf16x8){L[0], L[1], L[2], L[3], H[0], H[1], H[2], H[3]}
  od = __builtin_amdgcn_mfma_f32_32x32x16_bf16(pa0, PK(l0, h0), od, 0, 0, 0);
  od = __builtin_amdgcn_mfma_f32_32x32x16_bf16(pa1, PK(l1, h1), od, 0, 0, 0);
  od = __builtin_amdgcn_mfma_f32_32x32x16_bf16(pa2, PK(l2, h2), od, 0, 0, 0);
  od = __builtin_amdgcn_mfma_f32_32x32x16_bf16(pa3, PK(l3, h3), od, 0, 0, 0);
#undef PK
}
__device__ __forceinline__ void pv_d0(f32x16* o, int vb, bf16x8 pa0, bf16x8 pa1, bf16x8 pa2, bf16x8 pa3) {
  pv_one<0>(o[0], vb, pa0, pa1, pa2, pa3); pv_one<1>(o[1], vb, pa0, pa1, pa2, pa3); pv_one<2>(o[2], vb, pa0, pa1, pa2, pa3); pv_one<3>(o[3], vb, pa0, pa1, pa2, pa3);
}

template <typename TQ>
__device__ __forceinline__ void attn_dense_body(const TQ* __restrict__ Qb, const bf16* __restrict__ Kh, const bf16* __restrict__ Vh,
                                                bf16* __restrict__ Ob, int seq, char* lds) {
  using St = Stage<bf16>; using SQ = Stage<TQ>;
  int tid_ = threadIdx.x; asm volatile("" : "+v"(tid_));
  const int tid = tid_, wid = tid >> 6, lane = tid & 63, r32 = lane & 31, hi = lane >> 5;
  bf16* V_lds = (bf16*)lds; bf16* K_lds = (bf16*)(lds + 2 * SHM_V);
  float* ws = (float*)(lds + 2 * SHM_V + 2 * SHM_K) + wid * 64; float* li_l = ws; float* al_l = ws + 32;
  float m_reg = -1e30f, l_reg = 0; f32x16 o[4] = {}; bf16x8 qr[8];
  const TQ* Qw = Qb + (long)(wid * QBLK + r32) * LDQ + hi * 8;
#pragma unroll
  for (int d0 = 0; d0 < 8; ++d0) qr[d0] = SQ::tobf(SQ::ld8(Qw + d0 * 16));
  const int sr = tid >> 4, sc = (tid & 15) * 8, vst0 = v_st(sr, sc), vst1 = v_st(32 + sr, sc);
  const int vb0 = (int)(uintptr_t)V_lds + v_rd_base(lane);
  struct { typename St::T vs0, vs1, ks0, ks1; } sr_[SDEPTH];
#define SLOAD(i, k0) do { sr_[i].vs0 = St::ld8(&Vh[(long)((k0) + sr) * LDK + sc]); sr_[i].vs1 = St::ld8(&Vh[(long)((k0) + 32 + sr) * LDK + sc]); \
    sr_[i].ks0 = St::ld8(&Kh[(long)((k0) + sr) * LDK + sc]); sr_[i].ks1 = St::ld8(&Kh[(long)((k0) + 32 + sr) * LDK + sc]); } while (0)
#define SWRITE(b, i) do { *(bf16x8*)((char*)V_lds + (b) * SHM_V + vst0) = St::tobf(sr_[i].vs0);          \
    *(bf16x8*)((char*)V_lds + (b) * SHM_V + vst1) = St::tobf(sr_[i].vs1); int kc = sc * 2;               \
    *(bf16x8*)((char*)K_lds + (b) * SHM_K + KSWZ(sr, kc)) = St::tobf(sr_[i].ks0);                       \
    *(bf16x8*)((char*)K_lds + (b) * SHM_K + KSWZ(32 + sr, kc)) = St::tobf(sr_[i].ks1); } while (0)
#define SWAIT() do { if constexpr (SDEPTH == 2) asm volatile("s_waitcnt vmcnt(4)" ::: "memory"); else asm volatile("s_waitcnt vmcnt(0)" ::: "memory"); } while (0)
#define RESC(a) do { if (__any((a) < 1.f)) { if (hi == 0) al_l[r32] = (a); asm volatile("s_waitcnt lgkmcnt(0)" ::: "memory"); \
    for (int d = 0; d < 4; ++d) for (int r = 0; r < 16; ++r) o[d][r] *= al_l[crow(r, hi)]; } } while (0)
  f32x16 pA0, pA1, pB0, pB1; float mnA, mnB, alA, alB; bf16x8 pa0, pa1, pa2, pa3; const int NT = seq / KVBLK;
  constexpr int SE = 0, SO = SDEPTH - 1;
  SLOAD(SE, 0); asm volatile("s_waitcnt vmcnt(0)" ::: "memory"); SWRITE(0, SE); __syncthreads();
  qkt(pA0, pA1, K_lds, qr, r32, hi); partialSM(pA0, pA1, m_reg, mnA, alA);
  SLOAD(SO, KVBLK); if constexpr (SDEPTH == 2) { if (2 < NT) SLOAD(SE, 2 * KVBLK); }
  SWAIT(); SWRITE(1, SO); __syncthreads();
  for (int j = 1; j + 1 < NT; j += 2) {
    SBAR(); qkt(pB0, pB1, (bf16*)((char*)K_lds + SHM_K), qr, r32, hi);
    finishSM(pA0, pA1, alA, l_reg, pa0, pa1, pa2, pa3); SBAR();
    SLOAD(SO, (j + SDEPTH) * KVBLK); SBAR();
    pv_d0(o, vb0, pa0, pa1, pa2, pa3); partialSM(pB0, pB1, m_reg, mnB, alB);
    __syncthreads(); SWAIT(); SWRITE(0, SE);
    RESC(alB); __syncthreads();
    SBAR(); qkt(pA0, pA1, K_lds, qr, r32, hi);
    finishSM(pB0, pB1, alB, l_reg, pa0, pa1, pa2, pa3); SBAR();
    if (SDEPTH == 1 || j + 3 < NT) SLOAD(SE, (j + 1 + SDEPTH) * KVBLK); SBAR();
    pv_d0(o, vb0 + (int)SHM_V, pa0, pa1, pa2, pa3); partialSM(pA0, pA1, m_reg, mnA, alA);
    __syncthreads(); SWAIT(); SWRITE(1, SO);
    RESC(alA); __syncthreads();
  }
  SBAR(); qkt(pB0, pB1, (bf16*)((char*)K_lds + SHM_K), qr, r32, hi);
  finishSM(pA0, pA1, alA, l_reg, pa0, pa1, pa2, pa3); SBAR();
  pv_d0(o, vb0, pa0, pa1, pa2, pa3); partialSM(pB0, pB1, m_reg, mnB, alB);
  __syncthreads(); RESC(alB);
  finishSM(pB0, pB1, alB, l_reg, pa0, pa1, pa2, pa3); SBAR();
  pv_d0(o, vb0 + (int)SHM_V, pa0, pa1, pa2, pa3);
  if (hi == 0) li_l[r32] = l_reg; asm volatile("s_waitcnt lgkmcnt(0)" ::: "memory");
  float rli[16];
#pragma unroll
  for (int r = 0; r < 16; ++r) rli[r] = __builtin_amdgcn_rcpf(li_l[crow(r, hi)]);
  bf16* Ow = Ob + (long)(wid * QBLK) * LDO;
#pragma unroll
  for (int r = 0; r < 16; ++r) { int orow = crow(r, hi);
    for (int d0 = 0; d0 < 4; ++d0) Ow[(long)orow * LDO + d0 * 32 + r32] = __float2bfloat16(o[d0][r] * rli[r]); }
#undef SLOAD
#undef SWRITE
#undef SWAIT
#undef RESC
}
}
#define GAS __attribute__((address_space(1)))
#define LAS __attribute__((address_space(3)))
typedef unsigned short bf16;
typedef unsigned v4u __attribute__((ext_vector_type(4)));
typedef float f32x4 __attribute__((ext_vector_type(4)));
typedef short bf16x8 __attribute__((ext_vector_type(8)));
typedef GAS unsigned gu32;
typedef GAS unsigned long long gu64;
#define RLX_AGENT __ATOMIC_RELAXED, __HIP_MEMORY_SCOPE_AGENT
#define LDS_WAIT() asm volatile("s_waitcnt lgkmcnt(0)" ::: "memory")
#define VM_WAIT() asm volatile("s_waitcnt vmcnt(0)" ::: "memory")
__device__ __forceinline__ unsigned long long rt() { return __builtin_amdgcn_s_memrealtime(); }
__device__ __forceinline__ unsigned f2bf(float f) { unsigned u = __builtin_bit_cast(unsigned, f); return (u + 0x7fffu + ((u >> 16) & 1u)) >> 16; }
__device__ __forceinline__ unsigned pk2(float lo, float hi) { return f2bf(lo) | (f2bf(hi) << 16); }

#define XB_TMO      128
#define XB_XCNT(j)  (256  + 64 * (j))
#define XB_XSUB(j)  (1280 + 64 * (j))
#define XB_XGEN(j)  (2304 + 64 * (j))
#define XB_TOP      3328
#define XB_TOPGEN   3392
#define XCD_BAR_WORDS 3456
#define XB_SPIN_CAP (1u << 18)

__device__ __forceinline__ unsigned xb_ld(unsigned* p)              { return __hip_atomic_load(p, __ATOMIC_RELAXED, __HIP_MEMORY_SCOPE_AGENT); }
__device__ __forceinline__ unsigned xb_add(unsigned* p, unsigned v) { return __hip_atomic_fetch_add(p, v, __ATOMIC_RELAXED, __HIP_MEMORY_SCOPE_AGENT); }
__device__ __forceinline__ unsigned xb_xcc_id() { return (unsigned)__builtin_amdgcn_s_getreg((3 << 11) | 20) & 0xFu; }
#define XB_SPIN(cond, bar) do { unsigned _sp = 0; while (cond) { __builtin_amdgcn_s_sleep(1); \
    if ((++_sp & 255u) == 0u) { if (xb_ld(&(bar)[XB_TMO])) break; if (_sp > XB_SPIN_CAP) { atomicAdd(&(bar)[XB_TMO], 1u); break; } } } } while (0)

struct XcdBarrier {
    unsigned* bar; unsigned x;
    volatile LAS unsigned* st;
};

__device__ __forceinline__ XcdBarrier xcd_barrier_post(unsigned* bar, volatile LAS unsigned* st) {
    XcdBarrier b; b.bar = bar; b.x = xb_xcc_id(); b.st = st;
    if (threadIdx.x == 0) (void)xb_add(&bar[XB_XCNT(b.x)], 1u);
    return b;
}
__device__ __forceinline__ void xcd_barrier_complete(unsigned* bar, unsigned x, unsigned& nloc, unsigned& nx) {
    const unsigned G = gridDim.x * gridDim.y * gridDim.z;
    unsigned sum, cnt, mine, sp = 0u;
    for (;;) {
        sum = 0u; cnt = 0u; mine = 0u;
#pragma unroll
        for (unsigned j = 0; j < 16; ++j) { const unsigned c = xb_ld(&bar[XB_XCNT(j)]); sum += c; cnt += (c > 0u) ? 1u : 0u; mine = (j == x) ? c : mine; }
        if (sum == G) break;
        __builtin_amdgcn_s_sleep(1);
        if ((++sp & 255u) == 0u) { if (xb_ld(&bar[XB_TMO])) break; if (sp > XB_SPIN_CAP) { atomicAdd(&bar[XB_TMO], 1u); break; } }
    }
    nloc = mine > 0u ? mine : 1u; nx = cnt > 0u ? cnt : 1u;
}

__device__ __forceinline__ void xcd_barrier(const XcdBarrier& b) {
    asm volatile("s_waitcnt vmcnt(0)" ::: "memory");
    __syncthreads();
    if (threadIdx.x == 0) {
        unsigned* bar = b.bar;
        __builtin_amdgcn_s_waitcnt(0);
        unsigned nloc = b.st[0], nx = b.st[1];
        if (nloc == 0u) { xcd_barrier_complete(bar, b.x, nloc, nx); b.st[0] = nloc; b.st[1] = nx; }
        const unsigned old = xb_add(&bar[XB_XSUB(b.x)], 1u);
        const unsigned gen = old / nloc;
        if (old + 1u == (gen + 1u) * nloc) {
            __builtin_amdgcn_fence(__ATOMIC_RELEASE, "agent");
            asm volatile("s_waitcnt vmcnt(0)" ::: "memory");
            const unsigned og = xb_add(&bar[XB_TOP], 1u);
            const unsigned tg = og / nx;
            if (og + 1u == (tg + 1u) * nx) xb_add(&bar[XB_TOPGEN], 1u);
            else XB_SPIN(xb_ld(&bar[XB_TOPGEN]) == tg, bar);
            __builtin_amdgcn_fence(__ATOMIC_ACQUIRE, "agent");
            xb_add(&bar[XB_XGEN(b.x)], 1u);
            asm volatile("s_waitcnt vmcnt(0)" ::: "memory");
        } else {
            XB_SPIN(xb_ld(&bar[XB_XGEN(b.x)]) == gen, bar);
            __builtin_amdgcn_fence(__ATOMIC_ACQUIRE, "agent");
            asm volatile("s_waitcnt vmcnt(0)" ::: "memory");
        }
    }
    __syncthreads();
}

constexpr int NWAVES = 8, NTHR = NWAVES * 64;
constexpr int BATCH = 8, SEQ = 2048, M = BATCH * SEQ, DM = 4096, NU = 10240, FF = 11008, NG = 2 * FF, HD = 128;
constexpr int AW = 1024, BW = 1024;
constexpr int UA_Q = 0, UA_FF = 1024, UA_FB = 2048, UA_I = 3072, UA_G = 4096, UB_X = 5120, UB_GATE = 6144, UC_Q = 7168, UC_K = 9216, UC_V = 9728;
constexpr float LN_EPS = 1e-5f, RMS_EPS = 1e-6f, DN_ALPHA = 1.41421356237309515f;
#ifndef MK_SINGLE
#define MK_SINGLE 1
#endif
constexpr int PH_PER_LAYER = 11, NPH = 1 + 2 * PH_PER_LAYER;

constexpr size_t MiB = 1u << 20;
constexpr size_t WS_CTL = 0, CTL_ZERO_BYTES = 1 * MiB;
constexpr size_t SZ_WIN = (size_t)NU * DM * 2, SZ_WOUT = (size_t)DM * DM * 2, SZ_WUP = (size_t)NG * DM * 2, SZ_WDN = (size_t)DM * FF * 2, SZ_WRG = (size_t)4096 * 1024 * 2;
constexpr size_t WS_WIN = 1 * MiB, WS_WOUT = WS_WIN + 2 * SZ_WIN, WS_WUP = WS_WOUT + 2 * SZ_WOUT, WS_WDN = WS_WUP + 2 * SZ_WUP, WS_WRG = WS_WDN + 2 * SZ_WDN, WS_TAB = WS_WRG + 2 * SZ_WRG;
constexpr size_t WS_ST = WS_TAB + 65536;
constexpr size_t WS_GU = WS_TAB + 1 * MiB;
constexpr size_t SZ_GU = (size_t)M * NG * 2;
constexpr size_t WS_U = WS_GU;
constexpr size_t WS_R = WS_GU + 384 * MiB;
constexpr size_t WS_ACT = WS_GU + SZ_GU;
constexpr size_t SZ_ACT = (size_t)M * FF * 2;
constexpr size_t WS_XC = WS_ACT, WS_G = WS_XC + 32 * MiB, WS_HF = WS_G + 128 * MiB, WS_OF = WS_HF + 64 * MiB, WS_OB = WS_OF + 64 * MiB, WS_HBK = WS_OB + 64 * MiB;
constexpr size_t WS_Y = WS_ACT + ((SZ_ACT > 416 * MiB) ? SZ_ACT : 416 * MiB);
constexpr size_t WS_HB = WS_Y + 128 * MiB;
constexpr size_t WS_END = WS_HB + 128 * MiB;
static_assert(WS_HBK + 64 * MiB <= WS_Y && WS_R + 256 * MiB <= WS_ACT && WS_U + (size_t)M * NU * 2 <= WS_R, "d_ws map");
constexpr int CW_BAR = 4096;
constexpr int CW_QUEUE = 8192;

constexpr int RING_BYTES = 131072, MISC_OFF = RING_BYTES + 320, LDS_BYTES = 147456;

__device__ __forceinline__ float bf2f(bf16 b) { return __uint_as_float((unsigned)b << 16); }
__device__ __forceinline__ float sigm(float x) { return __builtin_amdgcn_rcpf(1.f + __expf(-x)); }
__device__ __forceinline__ float gelu_tanh(float x) { const float y = 0.7978845608028654f * (x + 0.044715f * x * x * x); const float t = 1.f - 2.f * __builtin_amdgcn_rcpf(1.f + __expf(2.f * y)); return 0.5f * x * (1.f + t); }
__device__ __forceinline__ int fresh_tid() { int t = threadIdx.x; asm volatile("" : "+v"(t)); return t; }
__device__ __forceinline__ float wave_sum(float v) {
#pragma unroll
    for (int o = 1; o < 64; o <<= 1) v += __shfl_xor(v, o);
    return v;
}

struct Args { const float* in[24]; float* out; unsigned char* ws; int ph_lo, ph_hi, pad0, pad1; };
struct Frame {
    LAS unsigned char* lds;
    volatile LAS unsigned* MISC;
    gu32* ctl;
    int tid, lane, wave, G, gw, NGW;
    float* H;
    unsigned char* ws;
};
#define WSP(T, off) ((T*)(F.ws + (off)))

template <bool GLU> __device__ __forceinline__ void p0_transpose_item(const float* W, int K, int N, bf16* WT, LAS float* scr, int item, int lane) {
    const int nblk = N / 32, kb = item / nblk, nb = item % nblk, k0 = 64 * kb, n0 = 32 * nb;
    const int nd0 = GLU ? ((n0 < FF) ? ((n0 >> 7) * 256 + (n0 & 127)) : (((n0 - FF) >> 7) * 256 + 128 + ((n0 - FF) & 127))) : n0;
    { f32x4 v[8]; const int kr = lane >> 3, n4 = (lane & 7) * 4;
#pragma unroll
      for (int i = 0; i < 8; ++i) v[i] = __builtin_nontemporal_load((const GAS f32x4*)(W + (size_t)(k0 + 8 * i + kr) * N + n0 + n4));
#pragma unroll
      for (int i = 0; i < 8; ++i) { LAS float* d = scr + (8 * i + kr) * 33 + n4; d[0] = v[i].x; d[1] = v[i].y; d[2] = v[i].z; d[3] = v[i].w; } }
    LDS_WAIT(); asm volatile("" ::: "memory");
    const int c = lane & 7;
#pragma unroll
    for (int j = 0; j < 4; ++j) { const int n = (lane >> 3) + 8 * j; const LAS float* s = scr + (8 * c) * 33 + n;
        v4u o; o.x = pk2(s[0 * 33], s[1 * 33]); o.y = pk2(s[2 * 33], s[3 * 33]); o.z = pk2(s[4 * 33], s[5 * 33]); o.w = pk2(s[6 * 33], s[7 * 33]);
        *(GAS v4u*)(WT + (size_t)(nd0 + n) * K + k0 + 8 * c) = o; }
    LDS_WAIT(); asm volatile("" ::: "memory");
}

__device__ __forceinline__ void ln_row(const float* src, const float* w, const float* b, float* dstF, bf16* dstB, float* st, int lane) {
    const GAS f32x4* xr = (const GAS f32x4*)src + lane;
    f32x4 v[16]; float s = 0.f;
#pragma unroll
    for (int j = 0; j < 16; ++j) { v[j] = xr[64 * j]; s += (v[j].x + v[j].y) + (v[j].z + v[j].w); }
    const float mean = wave_sum(s) * (1.f / DM); float s2 = 0.f;
#pragma unroll
    for (int j = 0; j < 16; ++j) { v[j] = v[j] - mean; s2 += (v[j].x * v[j].x + v[j].y * v[j].y) + (v[j].z * v[j].z + v[j].w * v[j].w); }
    const float rstd = 1.f / sqrtf(wave_sum(s2) * (1.f / DM) + LN_EPS);
    if (st && lane == 0) { st[0] = mean; st[1] = rstd; }
    GAS f32x4* of = (GAS f32x4*)dstF + lane; GAS unsigned long long* ob = (GAS unsigned long long*)dstB + lane;
    const GAS f32x4* wv = (const GAS f32x4*)w + lane; const GAS f32x4* bv = (const GAS f32x4*)b + lane;
#pragma unroll
    for (int j = 0; j < 16; ++j) { const f32x4 o = v[j] * rstd * wv[64 * j] + bv[64 * j]; if (dstF) of[64 * j] = o;
        if (dstB) ob[64 * j] = (unsigned long long)pk2(o.x, o.y) | ((unsigned long long)pk2(o.z, o.w) << 32); }
}
__device__ __forceinline__ void ln_row_bf(const bf16* src, const float* w, const float* b, float* dstF, bf16* dstB, float* st, int lane) {
    const GAS v4u* xr = (const GAS v4u*)src + lane;
    f32x4 v[16]; float s = 0.f;
#pragma unroll
    for (int j = 0; j < 8; ++j) { const v4u pw = xr[64 * j];
        v[2 * j] = (f32x4){__uint_as_float(pw.x << 16), __uint_as_float(pw.x & 0xffff0000u), __uint_as_float(pw.y << 16), __uint_as_float(pw.y & 0xffff0000u)};
        v[2 * j + 1] = (f32x4){__uint_as_float(pw.z << 16), __uint_as_float(pw.z & 0xffff0000u), __uint_as_float(pw.w << 16), __uint_as_float(pw.w & 0xffff0000u)};
        s += ((v[2 * j].x + v[2 * j].y) + (v[2 * j].z + v[2 * j].w)) + ((v[2 * j + 1].x + v[2 * j + 1].y) + (v[2 * j + 1].z + v[2 * j + 1].w)); }
    const float mean = wave_sum(s) * (1.f / DM); float s2 = 0.f;
#pragma unroll
    for (int j = 0; j < 16; ++j) { v[j] = v[j] - mean; s2 += (v[j].x * v[j].x + v[j].y * v[j].y) + (v[j].z * v[j].z + v[j].w * v[j].w); }
    const float rstd = 1.f / sqrtf(wave_sum(s2) * (1.f / DM) + LN_EPS);
    if (st && lane == 0) { st[0] = mean; st[1] = rstd; }
    GAS f32x4* of = (GAS f32x4*)dstF + 2 * lane; GAS v4u* ob = (GAS v4u*)dstB + lane;
    const GAS f32x4* wv = (const GAS f32x4*)w + 2 * lane; const GAS f32x4* bv = (const GAS f32x4*)b + 2 * lane;
#pragma unroll
    for (int j = 0; j < 8; ++j) { const f32x4 o0 = v[2 * j] * rstd * wv[128 * j] + bv[128 * j], o1 = v[2 * j + 1] * rstd * wv[128 * j + 1] + bv[128 * j + 1];
        if (dstF) { of[128 * j] = o0; of[128 * j + 1] = o1; }
        if (dstB) ob[64 * j] = (v4u){pk2(o0.x, o0.y), pk2(o0.z, o0.w), pk2(o1.x, o1.y), pk2(o1.z, o1.w)}; }
}
__device__ __forceinline__ void ln_phase_bf(Frame& F, const bf16* src, const float* w, const float* b, float* dstF, bf16* dstB, float* st) {
    const int lane = fresh_tid() & 63;
    for (int m = F.gw; m < M; m += F.NGW) ln_row_bf(src + (size_t)m * DM, w, b, dstF ? dstF + (size_t)m * DM : nullptr, dstB ? dstB + (size_t)m * DM : nullptr, st ? st + 2 * m : nullptr, lane);
}
__device__ __forceinline__ void ln_phase(Frame& F, const float* src, const float* w, const float* b, float* dstF, bf16* dstB, float* st) {
    const int lane = fresh_tid() & 63;
    for (int m = F.gw; m < M; m += F.NGW) ln_row(src + (size_t)m * DM, w, b, dstF ? dstF + (size_t)m * DM : nullptr, dstB ? dstB + (size_t)m * DM : nullptr, st ? st + 2 * m : nullptr, lane);
}

constexpr int CV_I_IN = (DM / 64) * (NU / 32), CV_I_OUT = (DM / 64) * (DM / 32), CV_I_UP = (DM / 64) * (NG / 32), CV_I_DN = (FF / 64) * (DM / 32);
constexpr int CV_L0 = CV_I_OUT + CV_I_UP + CV_I_DN, CV_ALL = CV_L0 + CV_I_IN + CV_L0, CV_CHUNK = 128, CV_NCHUNK = (CV_ALL + CV_CHUNK - 1) / CV_CHUNK;
__device__ __forceinline__ void conv_item(const Args& A, Frame& F, int idx, LAS float* scr, int lane) {
    int l = 0, r = idx;
    if (r >= CV_L0) { l = 1; r -= CV_L0;
        if (r < CV_I_IN) { p0_transpose_item<false>(A.in[3] + (size_t)DM * NU, DM, NU, WSP(bf16, WS_WIN + SZ_WIN), scr, r, lane); return; } r -= CV_I_IN; }
    if (r < CV_I_OUT) { p0_transpose_item<false>(A.in[15] + (size_t)l * DM * DM, DM, DM, WSP(bf16, WS_WOUT + l * SZ_WOUT), scr, r, lane); return; } r -= CV_I_OUT;
    if (r < CV_I_UP) { p0_transpose_item<true>(A.in[18] + (size_t)l * DM * NG, DM, NG, WSP(bf16, WS_WUP + l * SZ_WUP), scr, r, lane); return; } r -= CV_I_UP;
    p0_transpose_item<false>(A.in[21] + (size_t)l * FF * DM, FF, DM, WSP(bf16, WS_WDN + l * SZ_WDN), scr, r, lane);
}
__device__ __forceinline__ void conv_chunk(const Args& A, Frame& F, int chunk) {
    const int lane = fresh_tid() & 63; LAS float* scr = (LAS float*)(F.lds + F.wave * 16384);
    for (int k = 0; k < CV_CHUNK / NWAVES; ++k) { const int idx = chunk * CV_CHUNK + k * NWAVES + F.wave; if (idx < CV_ALL) conv_item(A, F, idx, scr, lane); }
}

__device__ __forceinline__ void p0_prologue(const Args& A, Frame& F) {
    const int ftid = fresh_tid(), flane = ftid & 63;
    LAS float* scr = (LAS float*)(F.lds + F.wave * 16384);
    for (int it = F.gw; it < CV_I_IN; it += F.NGW) p0_transpose_item<false>(A.in[3], DM, NU, WSP(bf16, WS_WIN), scr, it, flane);
    const int gtid = blockIdx.x * NTHR + ftid, NT = F.G * NTHR;
    for (int it = gtid; it < 2 * 4096 * 32; it += NT) {
        const int l = it / (4096 * 32), r = it % (4096 * 32), col = r >> 5, k0 = (r & 31) * 8;
        const int gt = col >> 10, n = (col >> 7) & 7, e = col & 127, half = (col >> 7) & 1, d0 = k0 & 127;
        v4u o = {0u, 0u, 0u, 0u};
        if ((k0 >> 7) == half) { const float* W = ((gt & 1) ? A.in[10] : A.in[8]) + ((size_t)((l * 2 + (gt >> 1)) * 8 + n)) * 16384 + e;
            float x[8];
#pragma unroll
            for (int i = 0; i < 8; ++i) x[i] = W[(d0 + i) * 128];
            o.x = pk2(x[0], x[1]); o.y = pk2(x[2], x[3]); o.z = pk2(x[4], x[5]); o.w = pk2(x[6], x[7]); }
        *(GAS v4u*)(WSP(bf16, WS_WRG + l * SZ_WRG) + (size_t)col * 256 + k0) = o;
    }
    if (gtid < 64 * 32) {
        const int pos = gtid >> 5, j = gtid & 31;
        double invf = 1.0; for (int i = 0; i < j; ++i) invf *= 0.7498942093324559;
        const double ang = (double)pos * invf;
        const double kq = __builtin_rint(ang * 0.6366197723675814);
        const double r = (ang - kq * 1.5707963267948966) - kq * 6.123233995736766e-17, r2 = r * r;
        double sn = r * (1.0 + r2 * (-1.0 / 6 + r2 * (1.0 / 120 + r2 * (-1.0 / 5040 + r2 * (1.0 / 362880 + r2 * (-1.0 / 39916800 + r2 * (1.0 / 6227020800.0)))))));
        double cs = 1.0 + r2 * (-0.5 + r2 * (1.0 / 24 + r2 * (-1.0 / 720 + r2 * (1.0 / 40320 + r2 * (-1.0 / 3628800 + r2 * (1.0 / 479001600.0 + r2 * (-1.0 / 87178291200.0)))))));
        const int q = ((int)kq) & 3; double c, s;
        if (q == 0) { c = cs; s = sn; } else if (q == 1) { c = -sn; s = cs; } else if (q == 2) { c = -cs; s = -sn; } else { c = sn; s = -cs; }
        float* tab = WSP(float, WS_TAB); tab[2 * gtid] = (float)c; tab[2 * gtid + 1] = (float)s;
    }
    ln_phase(F, A.in[0], A.in[1], A.in[2], nullptr, WSP(bf16, WS_HB), WSP(float, WS_ST));
}

__device__ __forceinline__ void prep_phase(const Args& A, Frame& F, int l, int rep) {
    const int ftid = fresh_tid(), flane = ftid & 63;
    bf16* U = WSP(bf16, WS_U); const float* tab = WSP(float, WS_TAB);
    const float* qn = A.in[13] + l * HD; const float* kn = A.in[14] + l * HD;
    const int L = flane, d1 = (L & 31) + 64 * (L >> 5), d2 = d1 + 32;
    const float wq1 = qn[d1], wq2 = qn[d2], wk1 = kn[d1], wk2 = kn[d2];
    for (int m = F.gw; m < M; m += F.NGW) {
        bf16* p = U + (size_t)m * NU + UC_Q;
        const int t = m & (SEQ - 1), pos = (L < 32) ? (t >> 6) : (t & 63);
        const float c = tab[2 * (pos * 32 + (L & 31))], s = tab[2 * (pos * 32 + (L & 31)) + 1];
        float x1[20], x2[20];
#pragma unroll
        for (int j = 0; j < 20; ++j) { x1[j] = bf2f(p[j * HD + d1]); x2[j] = bf2f(p[j * HD + d2]); }
#pragma unroll
        for (int j = 0; j < 20; ++j) {
            const float rstd = 1.f / sqrtf(wave_sum(x1[j] * x1[j] + x2[j] * x2[j]) * (1.f / HD) + RMS_EPS);
            const float n1 = x1[j] * rstd * (j < 16 ? wq1 : wk1), n2 = x2[j] * rstd * (j < 16 ? wq2 : wk2);
            const float o1 = n1 * c - n2 * s, o2 = n2 * c + n1 * s;
            if (rep == 0 || o1 != o1) { p[j * HD + d1] = (bf16)f2bf(o1); p[j * HD + d2] = (bf16)f2bf(o2); } }
    }
    const float* cw = A.in[6] + l * 4 * BW; const float* cb = A.in[7] + l * BW; bf16* XC = WSP(bf16, WS_XC);
    const int gtid = blockIdx.x * NTHR + ftid, NT = F.G * NTHR;
    for (int it = gtid; it < M * 128; it += NT) {
        const int m = it >> 7, c = (it & 127) * 8, t = m & (SEQ - 1);
        float acc[8];
#pragma unroll
        for (int i = 0; i < 8; ++i) acc[i] = cb[c + i];
#pragma unroll
        for (int k = 0; k < 4; ++k) { const int tt = t + k - 2;
            if (tt >= 0 && tt < SEQ) { const v4u xv = *(const GAS v4u*)(U + (size_t)(m + k - 2) * NU + UB_X + c); const unsigned xw[4] = {xv.x, xv.y, xv.z, xv.w};
#pragma unroll
                for (int i = 0; i < 4; ++i) { acc[2 * i] += cw[k * BW + c + 2 * i] * __uint_as_float(xw[i] << 16); acc[2 * i + 1] += cw[k * BW + c + 2 * i + 1] * __uint_as_float(xw[i] & 0xffff0000u); } } }
        v4u o; o.x = pk2(acc[0], acc[1]); o.y = pk2(acc[2], acc[3]); o.z = pk2(acc[4], acc[5]); o.w = pk2(acc[6], acc[7]);
        *(GAS v4u*)(XC + (size_t)m * BW + c) = o;
    }
}

namespace hg {
constexpr int PQ = 136, PK = 72;
constexpr int O_QM = 0, O_KM = O_QM + 64 * PQ * 2, O_KMT = O_KM + 64 * PQ * 2, O_VT = O_KMT + 128 * PK * 2, O_ST = O_VT + 128 * PK * 2, O_P = O_ST + 128 * PQ * 2;
constexpr int O_QS = O_P + 64 * PK * 2, O_EBM = O_QS + 4 * 128 * 4, O_ELM = O_EBM + 512, O_LB = O_ELM + 512, O_END = O_LB + 512;
static_assert(O_END <= 131072, "hgrn LDS");
}
__device__ __forceinline__ void hgrn_item(const Args& A, Frame& F, int l, int id) {
    using namespace hg;
    const int dir = id & 1, h = (id >> 1) & 7, b = id >> 4, tid = fresh_tid(), lane = tid & 63, w = tid >> 6, fr = lane & 15, fq = lane >> 4;
    LAS unsigned char* L = F.lds;
    LAS float* QS = (LAS float*)(L + O_QS); LAS float* EBM = (LAS float*)(L + O_EBM); LAS float* ELM = (LAS float*)(L + O_ELM); LAS float* LB = (LAS float*)(L + O_LB);
    const bf16* U = WSP(bf16, WS_U); bf16* O = WSP(bf16, dir ? WS_OB : WS_OF);
    if (tid < 128) { float lb = 0.f;
        if (l == 1) { const float* lg = A.in[4]; const float l0 = lg[(0 * 2 + dir) * AW + h * HD + tid], l1 = lg[(1 * 2 + dir) * AW + h * HD + tid]; lb = 1.f / (1.f + expf(l0 - l1)); }
        LB[tid] = lb; }
    __syncthreads();
    const int d = tid & 127, iq = tid >> 7;
    const float lb = LB[d];
    const int zc = (dir ? UA_FB : UA_FF) + h * HD + d, qc = UA_Q + h * HD + d, vc = UA_I + h * HD + d;
    f32x4 S[8];
#pragma unroll
    for (int et = 0; et < 8; ++et) S[et] = (f32x4){0.f, 0.f, 0.f, 0.f};
    bf16 zr[16], qr[16], vr[16];
#define HG_LOAD(c) do { _Pragma("unroll") for (int r = 0; r < 16; ++r) { const int s_ = 64 * (c) + 16 * iq + r, t_ = dir ? (SEQ - 1 - s_) : s_; const bf16* row_ = U + (size_t)(b * SEQ + t_) * NU; \
        zr[r] = row_[zc]; qr[r] = row_[qc]; vr[r] = row_[vc]; } } while (0)
    HG_LOAD(0);
    const int it = w >> 1, jt0 = 2 * (w & 1), et0 = 4 * (w & 1);
    for (int c = 0; c < SEQ / 64; ++c) {
        float lf[16], kk[16]; float run = 0.f;
#pragma unroll
        for (int r = 0; r < 16; ++r) { const float z = bf2f(zr[r]);
            const float ez = __expf(-fabsf(z)), rc = __builtin_amdgcn_rcpf(1.f + ez);
            const float sg = z >= 0.f ? rc : ez * rc, sn = z >= 0.f ? ez * rc : rc;
            lf[r] = (lb > 0.f) ? __logf(lb + (1.f - lb) * sg) : (fminf(z, 0.f) - __logf(1.f + ez));
            kk[r] = (1.f - lb) * sn;
            run += lf[r]; lf[r] = run; }
        QS[iq * 128 + d] = run;
        __syncthreads();
        { const float q0 = QS[d], q1 = QS[128 + d], q2 = QS[256 + d], q3 = QS[384 + d];
          const float off = (iq > 0 ? q0 : 0.f) + (iq > 1 ? q1 : 0.f) + (iq > 2 ? q2 : 0.f);
          const float bmid = q0 + q1, blast = (q0 + q1) + (q2 + q3);
          if (iq == 0) { EBM[d] = __expf(bmid); ELM[d] = __expf(blast - bmid); }
          unsigned kt[8], vt[8];
#pragma unroll
          for (int r = 0; r < 16; r += 2) {
              const float x0 = lf[r] + off - bmid, x1 = lf[r + 1] + off - bmid;
              const float e0 = __expf(fminf(fmaxf(x0, -80.f), 80.f)), e1 = __expf(fminf(fmaxf(x1, -80.f), 80.f));
              const float qm0 = bf2f(qr[r]) * e0, qm1 = bf2f(qr[r + 1]) * e1;
              const float km0 = kk[r] * __builtin_amdgcn_rcpf(e0), km1 = kk[r + 1] * __builtin_amdgcn_rcpf(e1);
              const unsigned k0 = f2bf(km0), k1 = f2bf(km1);
              *(LAS bf16*)(L + O_QM + ((16 * iq + r) * PQ + d) * 2) = (bf16)f2bf(qm0); *(LAS bf16*)(L + O_QM + ((16 * iq + r + 1) * PQ + d) * 2) = (bf16)f2bf(qm1);
              *(LAS bf16*)(L + O_KM + ((16 * iq + r) * PQ + d) * 2) = (bf16)k0;        *(LAS bf16*)(L + O_KM + ((16 * iq + r + 1) * PQ + d) * 2) = (bf16)k1;
              kt[r >> 1] = k0 | (k1 << 16); vt[r >> 1] = (unsigned)vr[r] | ((unsigned)vr[r + 1] << 16); }
          *(LAS v4u*)(L + O_KMT + (d * PK + 16 * iq) * 2) = (v4u){kt[0], kt[1], kt[2], kt[3]}; *(LAS v4u*)(L + O_KMT + (d * PK + 16 * iq + 8) * 2) = (v4u){kt[4], kt[5], kt[6], kt[7]};
          *(LAS v4u*)(L + O_VT + (d * PK + 16 * iq) * 2) = (v4u){vt[0], vt[1], vt[2], vt[3]};  *(LAS v4u*)(L + O_VT + (d * PK + 16 * iq + 8) * 2) = (v4u){vt[4], vt[5], vt[6], vt[7]}; }
        if (c + 1 < SEQ / 64) HG_LOAD(c + 1);
        __syncthreads();
        { const f32x4 eb = *(const LAS f32x4*)(EBM + 16 * w + 4 * fq);
#pragma unroll
          for (int et = 0; et < 8; ++et) { S[et] = S[et] * eb;
              typedef unsigned u32x2 __attribute__((ext_vector_type(2)));
              *(LAS u32x2*)(L + O_ST + ((16 * et + fr) * PQ + 16 * w + 4 * fq) * 2) = (u32x2){pk2(S[et].x, S[et].y), pk2(S[et].z, S[et].w)}; } }
        bf16x8 aq[4];
#pragma unroll
        for (int k4 = 0; k4 < 4; ++k4) aq[k4] = *(const LAS bf16x8*)(L + O_QM + ((16 * it + fr) * PQ + 32 * k4 + 8 * fq) * 2);
#pragma unroll
        for (int jj = 0; jj < 2; ++jj) { const int jt = jt0 + jj; f32x4 sc = {0.f, 0.f, 0.f, 0.f};
#pragma unroll
            for (int k4 = 0; k4 < 4; ++k4) { const bf16x8 bk = *(const LAS bf16x8*)(L + O_KM + ((16 * jt + fr) * PQ + 32 * k4 + 8 * fq) * 2);
                sc = __builtin_amdgcn_mfma_f32_16x16x32_bf16(aq[k4], bk, sc, 0, 0, 0); }
            const int jcol = 16 * jt + fr;
#pragma unroll
            for (int r = 0; r < 4; ++r) { const int irow = 16 * it + 4 * fq + r; *(LAS bf16*)(L + O_P + (irow * PK + jcol) * 2) = (bf16)f2bf(jcol <= irow ? sc[r] : 0.f); } }
        __syncthreads();
        { bf16x8 ap[2];
#pragma unroll
          for (int k2 = 0; k2 < 2; ++k2) ap[k2] = *(const LAS bf16x8*)(L + O_P + ((16 * it + fr) * PK + 32 * k2 + 8 * fq) * 2);
#pragma unroll
          for (int ee = 0; ee < 4; ++ee) { const int et = et0 + ee; f32x4 o = {0.f, 0.f, 0.f, 0.f};
#pragma unroll
              for (int k4 = 0; k4 < 4; ++k4) { const bf16x8 bs = *(const LAS bf16x8*)(L + O_ST + ((16 * et + fr) * PQ + 32 * k4 + 8 * fq) * 2);
                  o = __builtin_amdgcn_mfma_f32_16x16x32_bf16(aq[k4], bs, o, 0, 0, 0); }
#pragma unroll
              for (int k2 = 0; k2 < 2; ++k2) { const bf16x8 bv = *(const LAS bf16x8*)(L + O_VT + ((16 * et + fr) * PK + 32 * k2 + 8 * fq) * 2);
                  o = __builtin_amdgcn_mfma_f32_16x16x32_bf16(ap[k2], bv, o, 0, 0, 0); }
#pragma unroll
              for (int r = 0; r < 4; ++r) { const int s_ = 64 * c + 16 * it + 4 * fq + r, t_ = dir ? (SEQ - 1 - s_) : s_;
                  O[(size_t)(b * SEQ + t_) * AW + h * HD + 16 * et + fr] = (bf16)f2bf(o[r]); } } }
        { bf16x8 ak[2];
#pragma unroll
          for (int k2 = 0; k2 < 2; ++k2) ak[k2] = *(const LAS bf16x8*)(L + O_KMT + ((16 * w + fr) * PK + 32 * k2 + 8 * fq) * 2);
          const f32x4 el = *(const LAS f32x4*)(ELM + 16 * w + 4 * fq);
#pragma unroll
          for (int et = 0; et < 8; ++et) {
#pragma unroll
              for (int k2 = 0; k2 < 2; ++k2) { const bf16x8 bv = *(const LAS bf16x8*)(L + O_VT + ((16 * et + fr) * PK + 32 * k2 + 8 * fq) * 2);
                  S[et] = __builtin_amdgcn_mfma_f32_16x16x32_bf16(ak[k2], bv, S[et], 0, 0, 0); }
              S[et] = S[et] * el; } }
    }
#undef HG_LOAD
}

__device__ __forceinline__ void hgrn_final_phase(const Args& A, Frame& F, int l) {
    const int ftid = fresh_tid(), flane = ftid & 63;
    const bf16* OFp = WSP(bf16, WS_OF); const bf16* OBp = WSP(bf16, WS_OB); const bf16* U = WSP(bf16, WS_U); bf16* Y = WSP(bf16, WS_Y);
    const float* nw = A.in[5] + l * AW; typedef float f32x2 __attribute__((ext_vector_type(2)));
    for (int m = F.gw; m < M; m += F.NGW) {
        unsigned a[8], bq[8], gw2[8];
#pragma unroll
        for (int h = 0; h < 8; ++h) { const int c = h * HD + 2 * flane;
            a[h] = *(const GAS unsigned*)(OFp + (size_t)m * AW + c); bq[h] = *(const GAS unsigned*)(OBp + (size_t)m * AW + c); gw2[h] = *(const GAS unsigned*)(U + (size_t)m * NU + UA_G + c); }
#pragma unroll
        for (int h = 0; h < 8; ++h) { const int c = h * HD + 2 * flane;
            const float o0 = __uint_as_float(a[h] << 16) + __uint_as_float(bq[h] << 16), o1 = __uint_as_float(a[h] & 0xffff0000u) + __uint_as_float(bq[h] & 0xffff0000u);
            const float rstd = 1.f / sqrtf(wave_sum(o0 * o0 + o1 * o1) * (1.f / HD) + RMS_EPS);
            const float g0 = __uint_as_float(gw2[h] << 16), g1 = __uint_as_float(gw2[h] & 0xffff0000u);
            const float y0 = o0 * rstd * nw[c] * (g0 * sigm(g0)), y1 = o1 * rstd * nw[c + 1] * (g1 * sigm(g1));
            *(GAS unsigned*)(Y + (size_t)m * DM + c) = pk2(y0, y1); }
    }
    const bf16* HFp = WSP(bf16, WS_HF); const bf16* HBp = WSP(bf16, WS_HBK);
    const int gtid = blockIdx.x * NTHR + ftid, NT = F.G * NTHR;
    for (int it = gtid; it < M * 128; it += NT) { const int m = it >> 7, c = (it & 127) * 8;
        const v4u av = *(const GAS v4u*)(HFp + (size_t)m * BW + c), bv = *(const GAS v4u*)(HBp + (size_t)m * BW + c);
        const v4u gv = *(const GAS v4u*)(U + (size_t)m * NU + UB_GATE + c); const unsigned gw4[4] = {gv.x, gv.y, gv.z, gv.w}, aw4[4] = {av.x, av.y, av.z, av.w}, bw4[4] = {bv.x, bv.y, bv.z, bv.w};
        float hs[8];
#pragma unroll
        for (int i = 0; i < 4; ++i) { hs[2 * i] = __uint_as_float(aw4[i] << 16) + __uint_as_float(bw4[i] << 16); hs[2 * i + 1] = __uint_as_float(aw4[i] & 0xffff0000u) + __uint_as_float(bw4[i] & 0xffff0000u); }
        unsigned o[4];
#pragma unroll
        for (int i = 0; i < 4; ++i) o[i] = pk2(gelu_tanh(__uint_as_float(gw4[i] << 16)) * hs[2 * i], gelu_tanh(__uint_as_float(gw4[i] & 0xffff0000u)) * hs[2 * i + 1]);
        *(GAS v4u*)(Y + (size_t)m * DM + AW + c) = (v4u){o[0], o[1], o[2], o[3]}; }
}

__device__ __forceinline__ void rg_item(const Args& A, Frame& F, int l, int id) {
    const int tid = fresh_tid(), dir = id & 1, cg = (id >> 1) & 15, b = id >> 5;
    const bf16* G = WSP(bf16, WS_G); const bf16* XC = WSP(bf16, WS_XC); bf16* HO = WSP(bf16, dir ? WS_HBK : WS_HF);
    LAS float* As = (LAS float*)F.lds; LAS float* Bs = As + 128 * 64; LAS float* XP = Bs + 128 * 64; LAS float* XH = XP + 512; LAS float* Cs = XH + 512;
    const int srow = tid >> 3, sc8 = (tid & 7) * 8, cc = cg * 64 + sc8;
    float ba[8], bx[8], sp[8];
#pragma unroll
    for (int i = 0; i < 8; ++i) { ba[i] = A.in[9][(l * 2 + dir) * BW + cc + i]; bx[i] = A.in[11][(l * 2 + dir) * BW + cc + i]; sp[i] = -8.f * log1pf(expf(-A.in[12][(l * 2 + dir) * BW + cc + i])); }
    const int ch = tid & 63, sub = tid >> 6;
    if (tid < 64) Cs[tid] = 0.f;
    v4u gr[2], gi[2], gx[2];
#define RG_LOAD(k) do { _Pragma("unroll") for (int p2 = 0; p2 < 2; ++p2) { const int p_ = 64 * p2 + srow, s_ = 128 * (k) + p_, t_ = dir ? (SEQ - 1 - s_) : s_; const size_t m_ = (size_t)b * SEQ + t_; \
        gr[p2] = *(const GAS v4u*)(G + m_ * 4096 + dir * 2048 + cc); gi[p2] = *(const GAS v4u*)(G + m_ * 4096 + dir * 2048 + 1024 + cc); gx[p2] = *(const GAS v4u*)(XC + m_ * BW + cc); } } while (0)
    RG_LOAD(0);
    for (int k = 0; k < SEQ / 128; ++k) {
#pragma unroll
        for (int p2 = 0; p2 < 2; ++p2) { const unsigned rw[4] = {gr[p2].x, gr[p2].y, gr[p2].z, gr[p2].w}, iw[4] = {gi[p2].x, gi[p2].y, gi[p2].z, gi[p2].w}, xw[4] = {gx[p2].x, gx[p2].y, gx[p2].z, gx[p2].w};
            float av[8], bv[8];
#pragma unroll
            for (int i = 0; i < 8; ++i) { const float rp = (i & 1) ? __uint_as_float(rw[i >> 1] & 0xffff0000u) : __uint_as_float(rw[i >> 1] << 16);
                const float ip = (i & 1) ? __uint_as_float(iw[i >> 1] & 0xffff0000u) : __uint_as_float(iw[i >> 1] << 16);
                const float xv = (i & 1) ? __uint_as_float(xw[i >> 1] & 0xffff0000u) : __uint_as_float(xw[i >> 1] << 16);
                const float la = sp[i] * sigm(rp + ba[i]); av[i] = __expf(la); const float y2 = 2.f * la, om = (y2 > -0.25f) ? -y2 * (1.f + y2 * (0.5f + y2 * (0.16666667f + y2 * (0.041666668f + y2 * (0.008333334f + y2 * 0.0013888889f))))) : 1.f - __expf(y2);
                bv[i] = sqrtf(om) * sigm(ip + bx[i]) * xv; }
            LAS f32x4* ap = (LAS f32x4*)(As + (64 * p2 + srow) * 64 + sc8); LAS f32x4* bp = (LAS f32x4*)(Bs + (64 * p2 + srow) * 64 + sc8);
            ap[0] = (f32x4){av[0], av[1], av[2], av[3]}; ap[1] = (f32x4){av[4], av[5], av[6], av[7]}; bp[0] = (f32x4){bv[0], bv[1], bv[2], bv[3]}; bp[1] = (f32x4){bv[4], bv[5], bv[6], bv[7]}; }
        if (k + 1 < SEQ / 128) RG_LOAD(k + 1);
        __syncthreads();
        float hh = 0.f, pp = 1.f;
#pragma unroll
        for (int j = 0; j < 16; ++j) { const float a = As[(16 * sub + j) * 64 + ch], bt = Bs[(16 * sub + j) * 64 + ch]; hh = a * hh + bt; pp *= a; }
        XP[sub * 64 + ch] = pp; XH[sub * 64 + ch] = hh;
        __syncthreads();
        float cin = Cs[ch];
        for (int s2 = 0; s2 < sub; ++s2) cin = XP[s2 * 64 + ch] * cin + XH[s2 * 64 + ch];
#pragma unroll
        for (int j = 0; j < 16; ++j) { const float a = As[(16 * sub + j) * 64 + ch], bt = Bs[(16 * sub + j) * 64 + ch]; cin = a * cin + bt;
            const int s_ = 128 * k + 16 * sub + j, t_ = dir ? (SEQ - 1 - s_) : s_; HO[((size_t)b * SEQ + t_) * BW + cg * 64 + ch] = (bf16)f2bf(cin); }
        __syncthreads();
        if (sub == 7) Cs[ch] = cin;
    }
#undef RG_LOAD
}

constexpr int Q_HGRN = 128, Q_RG = 256, Q_ATT = BATCH * 16 * (SEQ / 256), Q_ALL = Q_HGRN + Q_RG + Q_ATT;
__device__ __forceinline__ void mixer_phase(const Args& A, Frame& F, int l, char* lds_generic, int rep) {
#ifndef MIX_DIS
#define MIX_DIS 0
#endif
#ifndef MIX_REP_DIS
#define MIX_REP_DIS 0
#endif
    for (;;) {
        __syncthreads();
        if (F.tid == 0) F.MISC[0] = __hip_atomic_fetch_add(F.ctl + CW_QUEUE + 128 * l + 512 * rep, 1u, RLX_AGENT);
        __syncthreads();
        const int id = (int)F.MISC[0];
        if (id >= Q_HGRN + Q_RG) break;
        if (id < Q_HGRN) { if (!(MIX_DIS & 1) && !(rep && (MIX_REP_DIS & 1))) hgrn_item(A, F, l, id); }
        else { if (!(MIX_DIS & 2) && !(rep && (MIX_REP_DIS & 2))) rg_item(A, F, l, id - Q_HGRN); }
    }
    const attn::bf16* U = (const attn::bf16*)WSP(bf16, WS_U); attn::bf16* Y = (attn::bf16*)WSP(bf16, WS_Y);
    constexpr int QB_GROUPS = (CV_NCHUNK + 8) / 9;
    static_assert(QB_GROUPS * 7 >= Q_ATT, "queue B covers every attention unit");
    const int nqb = (l == 0) ? QB_GROUPS * 16 : Q_ATT;
    for (;;) {
        __syncthreads();
        if (F.tid == 0) F.MISC[0] = __hip_atomic_fetch_add(F.ctl + CW_QUEUE + 128 * l + 64 + 512 * rep, 1u, RLX_AGENT);
        __syncthreads();
        const int id = (int)F.MISC[0];
        if (id >= nqb) break;
        int a = id;
        if (l == 0) { const int g = id >> 4, p = id & 15;
            if (p < 9) { const int c = g * 9 + p; if (c < CV_NCHUNK && rep == 0) conv_chunk(A, F, c); continue; }
            a = g * 7 + (p - 9); }
        if (a < Q_ATT && !(MIX_DIS & 4) && !(rep && (MIX_REP_DIS & 4))) { const int qb = a & 7, h = (a >> 3) & 15, b = a >> 7;
            const size_t r0 = (size_t)b * SEQ;
            attn::attn_dense_body<attn::bf16>(U + (r0 + qb * 256) * NU + UC_Q + h * HD, U + r0 * NU + UC_K + (h >> 2) * HD, U + r0 * NU + UC_V + (h >> 2) * HD,
                                              Y + (r0 + qb * 256) * DM + AW + BW + h * HD, SEQ, lds_generic); }
    }
}

__device__ __forceinline__ void act_phase(const Args& A, Frame& F, int l) {
    const int ftid = fresh_tid(), flane = ftid & 63;
    const bf16* GU = WSP(bf16, WS_GU); bf16* ACT = WSP(bf16, WS_ACT);
    const float* cw = A.in[19] + (size_t)l * 3 * FF; const float* cb = A.in[20] + (size_t)l * FF;
    const int gtid = blockIdx.x * NTHR + ftid, NT = F.G * NTHR; constexpr int C8 = FF / 8;
    for (long it = gtid; it < (long)M * C8; it += NT) {
        const int m = (int)(it / C8), c = (int)(it % C8) * 8, t = m & (SEQ - 1);
        float acc[8];
#pragma unroll
        for (int i = 0; i < 8; ++i) acc[i] = cb[c + i];
#pragma unroll
        for (int k = 0; k < 3; ++k) { const int tt = t + k - 1;
            if (tt >= 0 && tt < SEQ) { const v4u xv = *(const GAS v4u*)(GU + (size_t)(m + k - 1) * NG + c); const unsigned xw[4] = {xv.x, xv.y, xv.z, xv.w};
#pragma unroll
                for (int i = 0; i < 4; ++i) { acc[2 * i] += cw[(size_t)k * FF + c + 2 * i] * __uint_as_float(xw[i] << 16); acc[2 * i + 1] += cw[(size_t)k * FF + c + 2 * i + 1] * __uint_as_float(xw[i] & 0xffff0000u); } } }
        const v4u uv = *(const GAS v4u*)(GU + (size_t)m * NG + FF + c); const unsigned uw[4] = {uv.x, uv.y, uv.z, uv.w};
        float o[8];
#pragma unroll
        for (int i = 0; i < 4; ++i) { o[2 * i] = acc[2 * i] * sigm(acc[2 * i]) * __uint_as_float(uw[i] << 16); o[2 * i + 1] = acc[2 * i + 1] * sigm(acc[2 * i + 1]) * __uint_as_float(uw[i] & 0xffff0000u); }
        v4u ov; ov.x = pk2(o[0], o[1]); ov.y = pk2(o[2], o[3]); ov.z = pk2(o[4], o[5]); ov.w = pk2(o[6], o[7]);
        *(GAS v4u*)(ACT + (size_t)m * FF + c) = ov;
    }
}

__global__ void __launch_bounds__(NTHR, 2) fwd_kernel(Args args) {
    extern __shared__ __attribute__((aligned(16))) unsigned char lds[];
    Frame F;
    F.lds = (LAS unsigned char*)lds;
    F.MISC = (volatile LAS unsigned*)(F.lds + MISC_OFF);
    F.tid = threadIdx.x; F.lane = F.tid & 63; F.wave = __builtin_amdgcn_readfirstlane(F.tid >> 6);
    F.G = gridDim.x; F.gw = blockIdx.x * NWAVES + F.wave; F.NGW = F.G * NWAVES;
    F.ws = args.ws; F.ctl = (gu32*)(args.ws + WS_CTL); F.H = args.out;
    for (int u = F.tid; u < (LDS_BYTES - RING_BYTES) / 4; u += NTHR) ((LAS unsigned*)(F.lds + RING_BYTES))[u] = 0u;
    __syncthreads();
    const int lo = args.ph_lo, hi = args.ph_hi;
    XcdBarrier bar; bar.bar = (unsigned*)(F.ctl + CW_BAR); bar.x = 0; bar.st = nullptr;
    if (hi - lo > 1) bar = xcd_barrier_post((unsigned*)(F.ctl + CW_BAR), F.MISC + 8);
#ifndef DIS
#define DIS 0
#endif
#define EN(j) (!((DIS >> (j)) & 1))
#ifndef DBL
#define DBL 0
#endif
#define REPS(j, l) ((((DBL >> (j)) & 1) && (l) == 0) ? 2 : 1)
#define IN(k) (lo <= (k) && (k) < hi)
#define SEAM(k) do { if (IN(k) && IN((k) + 1)) xcd_barrier(bar); } while (0)
    LAS unsigned char* ring = F.lds;

    if (EN(0) && IN(0)) { for (int rep = 0; rep < REPS(0, 0); ++rep) { p0_prologue(args, F); if (rep + 1 < REPS(0, 0)) xcd_barrier(bar); } } SEAM(0);

    for (int l = 0; l < 2; ++l) {
        const int pb = 1 + PH_PER_LAYER * l;
        bf16* HB = WSP(bf16, WS_HB); bf16* U = WSP(bf16, WS_U); bf16* Y = WSP(bf16, WS_Y); bf16* RBUF = WSP(bf16, WS_R);
        if (EN(1) && IN(pb + 0)) for (int rep = 0; rep < REPS(1, l); ++rep) { if (rep) xcd_barrier(bar); pg8::Gemm g{HB, WSP(bf16, WS_WIN + l * SZ_WIN), M, NU, DM}; pg8::StaticOrder S; S.init(M, NU, F.G, (int)blockIdx.x);
            pg8::EpiBf16<0> E{U, NU, nullptr, 0, 0, 1.f};
            pg8::gemm_phase<pg8::EpiBf16<0>, pg8::StaticOrder, true, true>(ring, g, S, E); } SEAM(pb + 0);
        if (EN(2) && IN(pb + 1)) for (int rep = 0; rep < REPS(2, l); ++rep) { if (rep) xcd_barrier(bar); prep_phase(args, F, l, rep); } SEAM(pb + 1);
        if (EN(3) && IN(pb + 2)) for (int rep = 0; rep < REPS(3, l); ++rep) { if (rep) xcd_barrier(bar); pg8::Gemm g{WSP(bf16, WS_XC), WSP(bf16, WS_WRG + l * SZ_WRG), M, 4096, 256, 0, 1024, 4}; pg8::StaticOrder S; S.init(M, 4096, F.G, (int)blockIdx.x);
            pg8::EpiBf16<0> E{WSP(bf16, WS_G), 4096, nullptr, 0, 0, 1.f};
            pg8::gemm_phase<pg8::EpiBf16<0>, pg8::StaticOrder, true, true>(ring, g, S, E); } SEAM(pb + 2);
        if (EN(4) && IN(pb + 3)) for (int rep = 0; rep < REPS(4, l); ++rep) { if (rep) xcd_barrier(bar); mixer_phase(args, F, l, (char*)lds, rep); } SEAM(pb + 3);
        if (EN(5) && IN(pb + 4)) for (int rep = 0; rep < REPS(5, l); ++rep) { if (rep) xcd_barrier(bar); hgrn_final_phase(args, F, l); } SEAM(pb + 4);
        if (EN(6) && IN(pb + 5)) for (int rep = 0; rep < REPS(6, l); ++rep) { if (rep) xcd_barrier(bar); pg8::Gemm g{Y, WSP(bf16, WS_WOUT + l * SZ_WOUT), M, DM, DM}; pg8::StaticOrder S; S.init(M, DM, F.G, (int)blockIdx.x);
            if (l == 0) { pg8::EpiResBf<true> E{args.in[0], WSP(float, WS_ST), args.in[1], args.in[2], RBUF}; pg8::gemm_phase<pg8::EpiResBf<true>, pg8::StaticOrder, true, true>(ring, g, S, E); }
            else { pg8::EpiResBf<false> E{nullptr, WSP(float, WS_ST), args.in[22], args.in[23], RBUF}; pg8::gemm_phase<pg8::EpiResBf<false>, pg8::StaticOrder, true, true>(ring, g, S, E); } } SEAM(pb + 5);
        if (EN(7) && IN(pb + 6)) for (int rep = 0; rep < REPS(7, l); ++rep) { if (rep) xcd_barrier(bar); ln_phase_bf(F, RBUF, args.in[16] + l * DM, args.in[17] + l * DM, nullptr, HB, WSP(float, WS_ST)); } SEAM(pb + 6);
        if (EN(8) && IN(pb + 7)) for (int rep = 0; rep < REPS(8, l); ++rep) { if (rep) xcd_barrier(bar); pg8::Gemm g{HB - DM, WSP(bf16, WS_WUP + l * SZ_WUP), 65 * 256, NG, DM, 254}; pg8::StaticOrder S; S.init(65 * 256, NG, F.G, (int)blockIdx.x);
            pg8::EpiConvGlu E{WSP(bf16, WS_ACT), FF, args.in[19] + (size_t)l * 3 * FF, args.in[20] + (size_t)l * FF, (PG8_LAS float*)(F.lds + RING_BYTES + 1024), SEQ, M};
            pg8::gemm_phase<pg8::EpiConvGlu, pg8::StaticOrder, true, true>(ring, g, S, E); } SEAM(pb + 7);
        if (EN(10) && IN(pb + 9)) for (int rep = 0; rep < REPS(10, l); ++rep) { if (rep) xcd_barrier(bar); pg8::Gemm g{WSP(bf16, WS_ACT), WSP(bf16, WS_WDN + l * SZ_WDN), M, DM, FF}; pg8::StaticOrder S; S.init(M, DM, F.G, (int)blockIdx.x);
            pg8::EpiResBf<false> E{nullptr, WSP(float, WS_ST), args.in[16] + l * DM, args.in[17] + l * DM, RBUF};
            pg8::gemm_phase<pg8::EpiResBf<false>, pg8::StaticOrder, true, true>(ring, g, S, E); } SEAM(pb + 9);
        if (EN(11) && IN(pb + 10)) for (int rep = 0; rep < REPS(11, l); ++rep) { if (rep) xcd_barrier(bar);
            ln_phase_bf(F, RBUF, args.in[22] + l * DM, args.in[23] + l * DM, l == 1 ? F.H : nullptr, l == 1 ? nullptr : HB, l == 1 ? nullptr : WSP(float, WS_ST)); } SEAM(pb + 10);
    }
#undef IN
#undef SEAM
}

extern "C" void kernel_launch(void* const* d_in, const int* in_sizes, int n_in, void* d_out, int out_size, void* d_ws, size_t ws_size, hipStream_t stream) {
    static int grid = 0;
    if (grid == 0) {
        if (n_in != 24 || in_sizes[0] != M * DM || out_size != M * DM || ws_size < WS_END) { fprintf(stderr, "kernel_launch: unexpected shapes: n_in %d in0 %d out %d ws %zu (need %zu)\n", n_in, n_in > 0 ? in_sizes[0] : -1, out_size, ws_size, (size_t)WS_END); grid = -1; return; }
        int dev = 0, cus = 0, per_cu = 0;
        if (hipGetDevice(&dev) != hipSuccess || hipDeviceGetAttribute(&cus, hipDeviceAttributeMultiprocessorCount, dev) != hipSuccess) { grid = -1; return; }
        if (hipFuncSetAttribute((const void*)fwd_kernel, hipFuncAttributeMaxDynamicSharedMemorySize, LDS_BYTES) != hipSuccess) { fprintf(stderr, "kernel_launch: hipFuncSetAttribute failed\n"); grid = -1; return; }
        if (hipOccupancyMaxActiveBlocksPerMultiprocessor(&per_cu, (const void*)fwd_kernel, NTHR, LDS_BYTES) != hipSuccess || per_cu < 1) fprintf(stderr, "kernel_launch: occupancy query reports %d\n", per_cu);
        (void)hipGetLastError();
        grid = cus;
    }
    if (grid < 0) return;
    if (hipMemsetAsync((char*)d_ws + WS_CTL, 0, CTL_ZERO_BYTES, stream) != hipSuccess) return;
    Args a{};
    for (int i = 0; i < 24; ++i) a.in[i] = (const float*)d_in[i];
    a.out = (float*)d_out; a.ws = (unsigned char*)d_ws;
#if MK_SINGLE
    a.ph_lo = 0; a.ph_hi = NPH;
    hipLaunchKernelGGL(fwd_kernel, dim3(grid), dim3(NTHR), LDS_BYTES, stream, a);
#else
    for (int p = 0; p < NPH; ++p) { a.ph_lo = p; a.ph_hi = p + 1; hipLaunchKernelGGL(fwd_kernel, dim3(grid), dim3(NTHR), LDS_BYTES, stream, a); }
#endif
    const hipError_t le = hipPeekAtLastError();
    if (le != hipSuccess) fprintf(stderr, "kernel_launch: launch failed: %s\n", hipGetErrorName(le));
}
```
